# Optimizing an MI355X kernel written in HIP

```python
import jax, jax.numpy as jnp
from jax import lax
import numpy as np

D_MODEL = 4096
BATCH = 4
SEQ = 2048
DEPTH = 1

MEM_LEN = 256
M_HEADS = 8
M_QK_DIM = 256
M_V_DIM = 512
M_QK = M_HEADS * M_QK_DIM
M_V = M_HEADS * M_V_DIM
CHUNK = 64
F_BIAS_LO = 3.0
F_BIAS_HI = 6.0
CONV_WIDTH = 2048
CONV_K = 3
X_HEADS = 4
X_HEAD_DIM = 512
X_W = X_HEADS * X_HEAD_DIM
N_BRANCH = 3
SPLIT_SIZES = (M_QK, M_QK, M_V, M_V, M_V, M_HEADS, M_HEADS,
               CONV_WIDTH, CONV_WIDTH, CONV_WIDTH, CONV_WIDTH,
               X_W, X_W, N_BRANCH * D_MODEL)
VALUE_SLOTS = (2, 9)
F_SLOT = 6
D_IN = sum(SPLIT_SIZES)
DEEPNORM_ALPHA = (2 * DEPTH) ** 0.25
DEEPNORM_BETA = (8 * DEPTH) ** -0.25
LN_EPS = 1e-5

kernel_name = "hybrid_mlstm_shortconv_memxattn_deepnorm"


def _layernorm(x, w, b):
    xf = x.astype(jnp.float32)
    mu = xf.mean(-1, keepdims=True)
    var = jnp.mean(jnp.square(xf - mu), -1, keepdims=True)
    return ((xf - mu) * lax.rsqrt(var + LN_EPS)).astype(x.dtype) * w + b


def _mlstm_chunk(carry, inp):
    c_st, n_st, m_st = carry
    q, k, v, ig, lf = inp
    L = q.shape[2]
    b = jnp.cumsum(lf, axis=-1)
    g = b[..., -1]
    causal = jnp.tril(jnp.ones((L, L), dtype=bool))
    log_d = jnp.where(causal, b[..., :, None] - b[..., None, :] + ig[..., None, :], -jnp.inf)
    m_inter = b + m_st[..., None]
    m_t = jnp.maximum(log_d.max(-1), m_inter)
    s = jnp.einsum('bhtk,bhjk->bhtj', q, k) * jnp.exp(log_d - m_t[..., None])
    inter = jnp.exp(m_inter - m_t)
    num = jnp.einsum('bhtj,bhjv->bhtv', s, v) + inter[..., None] * jnp.einsum('bhtk,bhkv->bhtv', q, c_st)
    den = s.sum(-1) + inter * jnp.einsum('bhtk,bhk->bht', q, n_st)
    h = num / jnp.maximum(jnp.abs(den), jnp.exp(-m_t))[..., None]
    w = g[..., None] - b + ig
    m_new = jnp.maximum(g + m_st, w.max(-1))
    decay = jnp.exp(g + m_st - m_new)
    wk = jnp.exp(w - m_new[..., None])[..., None] * k
    c_new = decay[..., None, None] * c_st + jnp.einsum('bhjk,bhjv->bhkv', wk, v)
    n_new = decay[..., None] * n_st + wk.sum(2)
    return (c_new, n_new, m_new), h


def _mlstm(q, k, v, i_pre, f_pre):
    Bsz, S, H, dk = q.shape
    dv = v.shape[-1]
    nc = S // CHUNK
    f32 = jnp.float32

    def to_chunks(t):
        t = t.astype(f32).reshape((Bsz, nc, CHUNK, H) + t.shape[3:])
        return jnp.moveaxis(jnp.moveaxis(t, 1, 0), 3, 2)

    qc = to_chunks(q) * (dk ** -0.5)
    kc, vc = to_chunks(k), to_chunks(v)
    ic = to_chunks(i_pre)
    fc = jax.nn.log_sigmoid(to_chunks(f_pre))
    init = (jnp.zeros((Bsz, H, dk, dv), f32), jnp.zeros((Bsz, H, dk), f32), jnp.zeros((Bsz, H), f32))
    _, hs = lax.scan(_mlstm_chunk, init, (qc, kc, vc, ic, fc))
    hs = jnp.moveaxis(jnp.moveaxis(hs, 0, 1), 3, 2)
    return hs.reshape(Bsz, S, H, dv)


def _layer(x, mem, w_in, b_in, conv_w, mh_norm_w, w_mem_kv, w_proj_m, w_proj_c, w_proj_x, w_out, ln_w, ln_b):
    Bsz, S, _ = x.shape
    u = x @ w_in + b_in
    idx = [int(t) for t in np.cumsum(SPLIT_SIZES)[:-1]]
    mq, mk, mv, mo, mz, mi, mf, cb, cc, cx, cz, xq, xz, gates = jnp.split(u, idx, axis=-1)

    hm = _mlstm(mq.reshape(Bsz, S, M_HEADS, M_QK_DIM), mk.reshape(Bsz, S, M_HEADS, M_QK_DIM),
                mv.reshape(Bsz, S, M_HEADS, M_V_DIM), mi, mf)
    mu = hm.mean(-1, keepdims=True)
    var = jnp.mean(jnp.square(hm - mu), -1, keepdims=True)
    hm = (hm - mu) * lax.rsqrt(var + LN_EPS)
    hm = hm.reshape(Bsz, S, M_V).astype(x.dtype) * mh_norm_w
    y_m = hm * jax.nn.sigmoid(mo) * jax.nn.silu(mz)

    conv_out = lax.conv_general_dilated(cc * cx, conv_w[:, None, :], window_strides=(1,),
                                        padding=[(CONV_K - 1, 0)],
                                        dimension_numbers=('NWC', 'WIO', 'NWC'),
                                        feature_group_count=CONV_WIDTH)
    y_c = cb * conv_out * jax.nn.silu(cz)

    kv = mem @ w_mem_kv
    k_mem, v_mem = jnp.split(kv, 2, axis=-1)
    q = xq.reshape(Bsz, S, X_HEADS, X_HEAD_DIM)
    k_mem = k_mem.reshape(Bsz, -1, X_HEADS, X_HEAD_DIM)
    v_mem = v_mem.reshape(Bsz, -1, X_HEADS, X_HEAD_DIM)
    scores = jnp.einsum('bshd,bmhd->bhsm', q, k_mem).astype(jnp.float32) * (X_HEAD_DIM ** -0.5)
    p = jax.nn.softmax(scores, axis=-1).astype(x.dtype)
    attn = jnp.einsum('bhsm,bmhd->bshd', p, v_mem).reshape(Bsz, S, X_W)
    y_x = attn * jax.nn.silu(xz)

    g_m, g_c, g_x = jnp.split(jax.nn.sigmoid(gates), N_BRANCH, axis=-1)
    merged = g_m * (y_m @ w_proj_m) + g_c * (y_c @ w_proj_c) + g_x * (y_x @ w_proj_x)
    out = merged @ w_out
    return _layernorm(DEEPNORM_ALPHA * x + out, ln_w, ln_b)


def setup_inputs(seed: int = 0) -> dict:
    key = jax.random.key(seed)
    ks = jax.random.split(key, 14)
    nrm = jax.random.normal
    beta = DEEPNORM_BETA
    col_scale = jnp.concatenate([jnp.full((s,), beta if i in VALUE_SLOTS else 1.0, jnp.float32)
                                 for i, s in enumerate(SPLIT_SIZES)])
    w_in = nrm(ks[0], (DEPTH, D_MODEL, D_IN), jnp.float32) * (D_MODEL ** -0.5) * col_scale
    f_off = sum(SPLIT_SIZES[:F_SLOT])
    b_in = 0.01 * nrm(ks[1], (DEPTH, D_IN), jnp.float32)
    b_in = b_in.at[:, f_off:f_off + M_HEADS].add(jnp.linspace(F_BIAS_LO, F_BIAS_HI, M_HEADS))
    conv_w = nrm(ks[2], (DEPTH, CONV_K, CONV_WIDTH), jnp.float32) * (CONV_K ** -0.5)
    mh_norm_w = 1.0 + 0.02 * nrm(ks[3], (DEPTH, M_V), jnp.float32)
    kv_scale = jnp.concatenate([jnp.ones((X_W,), jnp.float32), jnp.full((X_W,), beta, jnp.float32)])
    w_mem_kv = nrm(ks[4], (DEPTH, D_MODEL, 2 * X_W), jnp.float32) * (D_MODEL ** -0.5) * kv_scale
    w_proj_m = nrm(ks[5], (DEPTH, M_V, D_MODEL), jnp.float32) * (M_V ** -0.5) * beta
    w_proj_c = nrm(ks[6], (DEPTH, CONV_WIDTH, D_MODEL), jnp.float32) * (CONV_WIDTH ** -0.5) * beta
    w_proj_x = nrm(ks[7], (DEPTH, X_W, D_MODEL), jnp.float32) * (X_W ** -0.5) * beta
    w_out = nrm(ks[8], (DEPTH, D_MODEL, D_MODEL), jnp.float32) * (D_MODEL ** -0.5) * beta
    ln_w = 1.0 + 0.02 * nrm(ks[9], (DEPTH, D_MODEL), jnp.float32)
    ln_b = 0.02 * nrm(ks[10], (DEPTH, D_MODEL), jnp.float32)
    x = nrm(ks[11], (BATCH, SEQ, D_MODEL), jnp.float32)
    mem = nrm(ks[12], (BATCH, MEM_LEN, D_MODEL), jnp.float32)
    return {"x": x, "mem": mem, "w_in": w_in, "b_in": b_in, "conv_w": conv_w,
            "mh_norm_w": mh_norm_w, "w_mem_kv": w_mem_kv, "w_proj_m": w_proj_m,
            "w_proj_c": w_proj_c, "w_proj_x": w_proj_x, "w_out": w_out,
            "ln_w": ln_w, "ln_b": ln_b}


def reference(x, mem, w_in, b_in, conv_w, mh_norm_w, w_mem_kv, w_proj_m, w_proj_c, w_proj_x, w_out, ln_w, ln_b):
    for l in range(DEPTH):
        x = _layer(x, mem, w_in[l], b_in[l], conv_w[l], mh_norm_w[l], w_mem_kv[l],
                   w_proj_m[l], w_proj_c[l], w_proj_x[l], w_out[l], ln_w[l], ln_b[l])
    return x
```

```cpp
#include <hip/hip_runtime.h>
#include <cstdio>
#include <cstdint>

#define LAS __attribute__((address_space(3)))
#define GAS __attribute__((address_space(1)))
typedef unsigned short bf16_t;
typedef short bf16x8 __attribute__((ext_vector_type(8)));
typedef float f32x4 __attribute__((ext_vector_type(4)));
typedef float f32x2 __attribute__((ext_vector_type(2)));
typedef unsigned u32x4 __attribute__((ext_vector_type(4)));
typedef unsigned u32x2 __attribute__((ext_vector_type(2)));

constexpr int NB = 4, SEQ = 2048, T = NB * SEQ, D = 4096;
constexpr int DIN = 40976, NU = 41216;
constexpr int MEMLEN = 256, TM = NB * MEMLEN;
constexpr int UQ = 0, UK = 2048, UV = 4096, UO = 8192, UZ = 12288, UCB = 16384, UCC = 18432, UCX = 20480, UCZ = 22528,
              UXQ = 24576, UXZ = 26624, UG = 28672, UI = 40960, UF = 40968;
constexpr float LN_EPS = 1e-5f;
constexpr float DN_ALPHA = 1.189207115002721f;

constexpr size_t MiB = 1u << 20;
constexpr size_t WS_CTL = 0, CTL_ZERO_BYTES = 1 * MiB;
constexpr size_t WS_BU = 1 * MiB;
constexpr size_t WS_XB = 2 * MiB;
constexpr size_t WS_MEMB = 66 * MiB;
constexpr size_t WS_WINT = 74 * MiB;
constexpr size_t WS_WKVT = 396 * MiB;
constexpr size_t WS_WPMT = 428 * MiB;
constexpr size_t WS_WPCXT = 460 * MiB;
constexpr size_t WS_WOT = 492 * MiB;
constexpr size_t WS_U = 524 * MiB;
constexpr size_t WS_KMEM = 1168 * MiB;
constexpr size_t WS_VT = 1172 * MiB;
constexpr size_t WS_SC = 1176 * MiB;
constexpr size_t WS_PB = 1208 * MiB;
constexpr size_t WS_HRAW = 1224 * MiB;
constexpr size_t WS_YM = 1288 * MiB;
constexpr size_t WS_YCX = 1352 * MiB;
constexpr size_t WS_MERGED = 1416 * MiB;
constexpr size_t WS_END = 1480 * MiB;
constexpr int CW_BAR = 4096;

constexpr int RING_BYTES = 131072;
constexpr int LDSCTL_OFF = RING_BYTES, MISC_OFF = LDSCTL_OFF + 320;
constexpr int LDS_BYTES = 147456;
constexpr int NWAVES = 8;

__device__ __forceinline__ unsigned cvt_pk_bf16(float lo, float hi) { unsigned r; asm("v_cvt_pk_bf16_f32 %0, %1, %2" : "=v"(r) : "v"(lo), "v"(hi)); return r; }
__device__ __forceinline__ float bf_lo(unsigned w) { return __uint_as_float(w << 16); }
__device__ __forceinline__ float bf_hi(unsigned w) { return __uint_as_float(w & 0xffff0000u); }
__device__ __forceinline__ float bf2f(bf16_t h) { return __uint_as_float(((unsigned)h) << 16); }
__device__ __forceinline__ float sigmoidf_(float x) { return __builtin_amdgcn_rcpf(1.0f + __expf(-x)); }
__device__ __forceinline__ float wave_sum(float v) {
#pragma unroll
    for (int o = 1; o < 64; o <<= 1) v += __shfl_xor(v, o);
    return v;
}
__device__ __forceinline__ float wave_max(float v) {
#pragma unroll
    for (int o = 1; o < 64; o <<= 1) v = fmaxf(v, __shfl_xor(v, o));
    return v;
}
#define LDS_WAIT() asm volatile("s_waitcnt lgkmcnt(0)" ::: "memory")
#define VM_WAIT() asm volatile("s_waitcnt vmcnt(0)" ::: "memory")

namespace pg8 {
constexpr int BM = 256, BK = 64, HALF = 128, HTB = HALF * BK * 2, STAGE_BYTES = 8 * HTB;
__host__ __device__ __forceinline__ int lds_byte(int r, int c) { const int st = (r >> 4) * 2 + (c >> 5), rr = r & 15, cc = c & 31, ob = rr * 64 + cc * 2; return st * 1024 + (ob ^ (((ob >> 9) & 1) << 5)); }
__host__ __device__ __forceinline__ void stage_rc(int b, int& R, int& C) { const int st = b / 1024, sb = b % 1024, swz = sb ^ (((sb >> 9) & 1) << 5); R = (st >> 1) * 16 + swz / 64; C = (st & 1) * 32 + (swz % 64) / 2; }
__host__ __device__ __forceinline__ int perm32(int rho) { const int n = rho >> 4, i = rho & 15; return 8 * (i >> 2) + 4 * n + (i & 3); }

struct Unit { const char* A; const char* B; int nt, pm, pn, kind; };

__device__ __forceinline__ bool tile_map(long L, int nM, int nN, int& pm, int& pn) {
    const int nwg = nM * nN; if (L >= nwg) return false;
    int wgid = (int)L; { const int q = nwg / 8, r = nwg % 8, xcd = wgid % 8, off = wgid / 8; wgid = (xcd < r ? xcd * (q + 1) : r * (q + 1) + (xcd - r) * q) + off; }
    const int nig = 8 * nN, gid = wgid / nig, fm = gid * 8, gsz = (nM - fm) < 8 ? (nM - fm) : 8;
    pm = fm + ((wgid % nig) % gsz); pn = (wgid % nig) / gsz; return true;
}

template <class Epi, class Sched, bool ALIGN_EPI, bool SP2>
__device__ __forceinline__ void gemm_phase(LAS unsigned char* lds, const int lda, const int ldb, const Sched& S, const Epi& E) {
    const int tid = threadIdx.x, wid = __builtin_amdgcn_readfirstlane(tid >> 6), lane = tid & 63, wr = wid >> 2, wc = wid & 3, fr = lane & 15, fq = lane >> 4;
    unsigned voffA[2], voffB[2];
#pragma unroll
    for (int i = 0; i < 2; ++i) { int R, C; stage_rc(tid * 16 + i * 8192, R, C); const int Rb = Epi::PERM ? ((R & ~31) + perm32(R & 31)) : R;
        voffA[i] = (unsigned)(R * lda + C * 2); voffB[i] = (unsigned)(Rb * ldb + C * 2); }
    const size_t kstep = (size_t)(BK * 2);
    const size_t hstepA = (size_t)HALF * lda, hstepB = (size_t)HALF * ldb;
    const unsigned ldsw = (unsigned)wid * 1024u;
    const int aoff = lds_byte(wr * 64 + fr, fq * 8), boff = lds_byte(wc * 32 + fr, fq * 8);
#define PG8_SA(b, h) (((b) * 2 + (h)) * HTB)
#define PG8_SB(b, h) ((4 + (b) * 2 + (h)) * HTB)
#define PG8_STAGE(bufoff, gbase, voff) do { _Pragma("unroll") for (int _i = 0; _i < 2; ++_i) \
        __builtin_amdgcn_global_load_lds((const unsigned*)((const char*)(gbase) + (voff)[_i]), (LAS unsigned*)(lds + (bufoff) + ldsw + _i * 8192), 16, 0, 0); } while (0)
#define PG8_LDA(dst, b, h) do { _Pragma("unroll") for (int m = 0; m < 4; ++m) _Pragma("unroll") for (int k = 0; k < 2; ++k) dst[m][k] = *(const LAS bf16x8*)(lds + PG8_SA(b, h) + aoff + m * 2048 + k * 1024); } while (0)
#define PG8_LDB(dst, b, h) do { _Pragma("unroll") for (int n = 0; n < 2; ++n) _Pragma("unroll") for (int k = 0; k < 2; ++k) dst[n][k] = *(const LAS bf16x8*)(lds + PG8_SB(b, h) + boff + n * 2048 + k * 1024); } while (0)
#define PG8_MMA(ai, bj, At, Bt) do { __builtin_amdgcn_s_setprio(1); _Pragma("unroll") for (int m = 0; m < 4; ++m) _Pragma("unroll") for (int n = 0; n < 2; ++n) _Pragma("unroll") for (int k = 0; k < 2; ++k) \
        acc[ai][bj][m][n] = __builtin_amdgcn_mfma_f32_16x16x32_bf16(Bt[n][k], At[m][k], acc[ai][bj][m][n], 0, 0, 0); __builtin_amdgcn_s_setprio(0); } while (0)
#define PG8_WAIT_V(n) asm volatile("s_waitcnt vmcnt(" #n ")" ::: "memory")
#define PG8_WAIT_L(n) asm volatile("s_waitcnt lgkmcnt(" #n ")" ::: "memory")
#define PG8_BAR __builtin_amdgcn_s_barrier()
#define PG8_SCHED __builtin_amdgcn_sched_barrier(0)
    Unit cur, nxt; int ui = 0;
    if (!S.next(0, cur)) return;
    f32x4 acc[2][2][4][2];
#pragma unroll
    for (int a = 0; a < 2; ++a)
#pragma unroll
        for (int b = 0; b < 2; ++b)
#pragma unroll
            for (int m = 0; m < 4; ++m)
#pragma unroll
                for (int n = 0; n < 2; ++n) acc[a][b][m][n] = (f32x4){0.f, 0.f, 0.f, 0.f};
    bf16x8 At[4][2], B0[2][2], B1[2][2];
    const char* cA = cur.A; const char* cB = cur.B;
    if constexpr (SP2) {
        PG8_STAGE(PG8_SB(0, 0), cB, voffB); PG8_STAGE(PG8_SB(0, 1), cB + hstepB, voffB); PG8_STAGE(PG8_SA(0, 0), cA, voffA); PG8_STAGE(PG8_SA(0, 1), cA + hstepA, voffA);
        if (wr == 1) PG8_BAR;
        PG8_WAIT_V(2); PG8_BAR;
        PG8_STAGE(PG8_SB(1, 0), cB + kstep, voffB); PG8_STAGE(PG8_SA(1, 0), cA + kstep, voffA); PG8_STAGE(PG8_SB(1, 1), cB + hstepB + kstep, voffB);
        PG8_WAIT_V(6); PG8_BAR;
    } else {
        PG8_STAGE(PG8_SB(0, 0), cB, voffB); PG8_STAGE(PG8_SA(0, 0), cA, voffA); PG8_STAGE(PG8_SB(0, 1), cB + hstepB, voffB); PG8_STAGE(PG8_SA(0, 1), cA + hstepA, voffA);
        if (wr == 1) PG8_BAR;
        PG8_WAIT_V(4); PG8_BAR;
        PG8_STAGE(PG8_SB(1, 0), cB + kstep, voffB); PG8_STAGE(PG8_SA(1, 0), cA + kstep, voffA); PG8_STAGE(PG8_SB(1, 1), cB + hstepB + kstep, voffB);
        PG8_WAIT_V(6); PG8_BAR;
    }
    for (;;) {
        const bool has_next = S.next(ui + 1, nxt);
        const char* nA = has_next ? nxt.A : cA; const char* nB = has_next ? nxt.B : cB;
        const int nt = cur.nt;
        for (int t = 0; t < nt; t += 2) {
            const bool last = (t == nt - 2);
            const char* a1 = cA + (size_t)(t + 1) * kstep;
            const char* a2 = last ? nA : cA + (size_t)(t + 2) * kstep; const char* b2 = last ? nB : cB + (size_t)(t + 2) * kstep;
            const char* a3 = a2 + kstep; const char* b3 = b2 + kstep;
            if constexpr (SP2) {
            PG8_LDB(B0, 0, 0); PG8_LDB(B1, 0, 1); PG8_SCHED; PG8_LDA(At, 0, 0); PG8_STAGE(PG8_SA(1, 1), a1 + hstepA, voffA);
            PG8_WAIT_V(8); PG8_WAIT_L(0); PG8_BAR; PG8_MMA(0, 0, At, B0); PG8_MMA(0, 1, At, B1); PG8_BAR; PG8_SCHED;
            PG8_LDA(At, 0, 1); PG8_STAGE(PG8_SB(0, 0), b2, voffB); PG8_STAGE(PG8_SB(0, 1), b2 + hstepB, voffB); PG8_STAGE(PG8_SA(0, 0), a2, voffA);
            PG8_WAIT_V(8); PG8_WAIT_L(0); PG8_BAR; PG8_MMA(1, 0, At, B0); PG8_MMA(1, 1, At, B1); PG8_BAR; PG8_SCHED;
            PG8_LDB(B0, 1, 0); PG8_LDB(B1, 1, 1); PG8_SCHED; PG8_LDA(At, 1, 0); PG8_STAGE(PG8_SA(0, 1), a2 + hstepA, voffA);
            PG8_WAIT_V(8); PG8_WAIT_L(0); PG8_BAR; PG8_MMA(0, 0, At, B0); PG8_MMA(0, 1, At, B1); PG8_BAR; PG8_SCHED;
            PG8_LDA(At, 1, 1); PG8_STAGE(PG8_SB(1, 0), b3, voffB); PG8_STAGE(PG8_SB(1, 1), b3 + hstepB, voffB); PG8_STAGE(PG8_SA(1, 0), a3, voffA);
            PG8_WAIT_V(8); PG8_WAIT_L(0); PG8_BAR; PG8_MMA(1, 0, At, B0); PG8_MMA(1, 1, At, B1); PG8_BAR; PG8_SCHED;
            } else {
            PG8_LDB(B0, 0, 0); PG8_SCHED; PG8_LDA(At, 0, 0); PG8_STAGE(PG8_SA(1, 1), a1 + hstepA, voffA);
            PG8_WAIT_L(8); PG8_BAR; PG8_WAIT_L(0); PG8_MMA(0, 0, At, B0); PG8_BAR; PG8_SCHED;
            PG8_LDB(B1, 0, 1); PG8_STAGE(PG8_SB(0, 0), b2, voffB);
            PG8_BAR; PG8_WAIT_L(0); PG8_MMA(0, 1, At, B1); PG8_BAR;
            PG8_LDA(At, 0, 1); PG8_STAGE(PG8_SA(0, 0), a2, voffA);
            PG8_BAR; PG8_WAIT_L(0); PG8_MMA(1, 0, At, B0); PG8_BAR; PG8_SCHED;
            PG8_STAGE(PG8_SB(0, 1), b2 + hstepB, voffB);
            PG8_WAIT_V(6); PG8_BAR; PG8_MMA(1, 1, At, B1); PG8_BAR;
            PG8_LDB(B0, 1, 0); PG8_SCHED; PG8_LDA(At, 1, 0); PG8_STAGE(PG8_SA(0, 1), a2 + hstepA, voffA);
            PG8_WAIT_L(8); PG8_BAR; PG8_WAIT_L(0); PG8_MMA(0, 0, At, B0); PG8_BAR; PG8_SCHED;
            PG8_LDB(B1, 1, 1); PG8_STAGE(PG8_SB(1, 0), b3, voffB);
            PG8_BAR; PG8_WAIT_L(0); PG8_MMA(0, 1, At, B1); PG8_BAR;
            PG8_LDA(At, 1, 1); PG8_STAGE(PG8_SA(1, 0), a3, voffA);
            PG8_BAR; PG8_WAIT_L(0); PG8_MMA(1, 0, At, B0); PG8_BAR; PG8_SCHED;
            PG8_STAGE(PG8_SB(1, 1), b3 + hstepB, voffB);
            PG8_WAIT_V(6); PG8_BAR; PG8_MMA(1, 1, At, B1); PG8_BAR;
            }
        }
        if constexpr (ALIGN_EPI) { if (wr == 0) PG8_BAR; }
        E(acc, cur, wr, wc, fr, fq);
        if (!has_next) break;
#pragma unroll
        for (int a = 0; a < 2; ++a)
#pragma unroll
            for (int b = 0; b < 2; ++b)
#pragma unroll
                for (int m = 0; m < 4; ++m)
#pragma unroll
                    for (int n = 0; n < 2; ++n) acc[a][b][m][n] = (f32x4){0.f, 0.f, 0.f, 0.f};
        cur = nxt; cA = nA; cB = nB; ++ui;
        if constexpr (ALIGN_EPI) { if (wr == 1) PG8_BAR; }
    }
    PG8_WAIT_V(0);
    if constexpr (!ALIGN_EPI) { if (wr == 0) PG8_BAR; }
    PG8_BAR;
#undef PG8_SA
#undef PG8_SB
#undef PG8_STAGE
#undef PG8_LDA
#undef PG8_LDB
#undef PG8_MMA
#undef PG8_WAIT_V
#undef PG8_WAIT_L
#undef PG8_BAR
#undef PG8_SCHED
}
}
using pg8::Unit;

#define XB_TMO      128
#define XB_XCNT(j)  (256  + 64 * (j))
#define XB_XSUB(j)  (1280 + 64 * (j))
#define XB_XGEN(j)  (2304 + 64 * (j))
#define XB_TOP      3328
#define XB_TOPGEN   3392
#define XCD_BAR_WORDS 3456
#define XB_SPIN_CAP (1u << 18)

__device__ __forceinline__ unsigned xb_ld(unsigned* p)              { return __hip_atomic_load(p, __ATOMIC_RELAXED, __HIP_MEMORY_SCOPE_AGENT); }
__device__ __forceinline__ unsigned xb_add(unsigned* p, unsigned v) { return __hip_atomic_fetch_add(p, v, __ATOMIC_RELAXED, __HIP_MEMORY_SCOPE_AGENT); }
__device__ __forceinline__ unsigned xb_xcc_id() { return (unsigned)__builtin_amdgcn_s_getreg((3 << 11) | 20) & 0xFu; }
#define XB_SPIN(cond, bar) do { unsigned _sp = 0; while (cond) { __builtin_amdgcn_s_sleep(1); \
    if ((++_sp & 255u) == 0u) { if (xb_ld(&(bar)[XB_TMO])) break; if (_sp > XB_SPIN_CAP) { atomicAdd(&(bar)[XB_TMO], 1u); break; } } } } while (0)

struct XcdBarrier { unsigned* bar; unsigned x; volatile LAS unsigned* st; };

__device__ __forceinline__ XcdBarrier xcd_barrier_post(unsigned* bar, volatile LAS unsigned* st) {
    XcdBarrier b; b.bar = bar; b.x = xb_xcc_id(); b.st = st;
    if (threadIdx.x == 0) (void)xb_add(&bar[XB_XCNT(b.x)], 1u);
    return b;
}
__device__ __forceinline__ void xcd_barrier_complete(unsigned* bar, unsigned x, unsigned& nloc, unsigned& nx) {
    const unsigned G = gridDim.x * gridDim.y * gridDim.z;
    unsigned sum, cnt, mine, sp = 0u;
    for (;;) {
        sum = 0u; cnt = 0u; mine = 0u;
#pragma unroll
        for (unsigned j = 0; j < 16; ++j) { const unsigned c = xb_ld(&bar[XB_XCNT(j)]); sum += c; cnt += (c > 0u) ? 1u : 0u; mine = (j == x) ? c : mine; }
        if (sum == G) break;
        __builtin_amdgcn_s_sleep(1);
        if ((++sp & 255u) == 0u) { if (xb_ld(&bar[XB_TMO])) break; if (sp > XB_SPIN_CAP) { atomicAdd(&bar[XB_TMO], 1u); break; } }
    }
    nloc = mine > 0u ? mine : 1u; nx = cnt > 0u ? cnt : 1u;
}
__device__ __forceinline__ void xcd_barrier(const XcdBarrier& b) {
    asm volatile("s_waitcnt vmcnt(0)" ::: "memory");
    __syncthreads();
    if (threadIdx.x == 0) {
        unsigned* bar = b.bar;
        __builtin_amdgcn_s_waitcnt(0);
        unsigned nloc = b.st[0], nx = b.st[1];
        if (nloc == 0u) { xcd_barrier_complete(bar, b.x, nloc, nx); b.st[0] = nloc; b.st[1] = nx; }
        const unsigned old = xb_add(&bar[XB_XSUB(b.x)], 1u);
        const unsigned gen = old / nloc;
        if (old + 1u == (gen + 1u) * nloc) {
            __builtin_amdgcn_fence(__ATOMIC_RELEASE, "agent");
            asm volatile("s_waitcnt vmcnt(0)" ::: "memory");
            const unsigned og = xb_add(&bar[XB_TOP], 1u);
            const unsigned tg = og / nx;
            if (og + 1u == (tg + 1u) * nx) xb_add(&bar[XB_TOPGEN], 1u);
            else XB_SPIN(xb_ld(&bar[XB_TOPGEN]) == tg, bar);
            __builtin_amdgcn_fence(__ATOMIC_ACQUIRE, "agent");
            xb_add(&bar[XB_XGEN(b.x)], 1u);
            asm volatile("s_waitcnt vmcnt(0)" ::: "memory");
        } else {
            XB_SPIN(xb_ld(&bar[XB_XGEN(b.x)]) == gen, bar);
            __builtin_amdgcn_fence(__ATOMIC_ACQUIRE, "agent");
            asm volatile("s_waitcnt vmcnt(0)" ::: "memory");
        }
    }
    __syncthreads();
}

struct Params {
    const float *x, *mem, *w_in, *b_in, *conv_w, *mh_norm_w, *w_mem_kv, *w_proj_m, *w_proj_c, *w_proj_x, *w_out, *ln_w, *ln_b;
    float* out; unsigned char* ws;
    int ph_lo, ph_hi;
};

__device__ __forceinline__ void transpose_item(const float* src, size_t src_ld, int col0, int ncv, bf16_t* dst, size_t dst_ld, int n0, int k0, LAS unsigned* scr, int lane) {
    const float* sp = src + (size_t)k0 * src_ld + col0 + lane;
    if (ncv > 0) {
#pragma unroll 8
        for (int i = 0; i < 32; ++i) {
            float a = 0.f, b = 0.f;
            if (lane < ncv) { a = sp[(size_t)(2 * i) * src_ld]; b = sp[(size_t)(2 * i + 1) * src_ld]; }
            scr[i * 65 + lane] = cvt_pk_bf16(a, b);
        }
    } else {
#pragma unroll 8
        for (int i = 0; i < 32; ++i) scr[i * 65 + lane] = 0u;
    }
    LDS_WAIT(); asm volatile("" ::: "memory");
    const int c = lane & 7;
#pragma unroll
    for (int j = 0; j < 8; ++j) {
        const int n = (lane >> 3) + 8 * j; const LAS unsigned* s = scr + (4 * c) * 65 + n;
        u32x4 o; o.x = s[0]; o.y = s[65]; o.z = s[130]; o.w = s[195];
        *(u32x4*)(dst + (size_t)(n0 + n) * dst_ld + k0 + 8 * c) = o;
    }
    LDS_WAIT(); asm volatile("" ::: "memory");
}
__device__ __forceinline__ void cvt_row(const float* src, bf16_t* dst, int lane) {
    const f32x4* s = (const f32x4*)src + lane; u32x2* d = (u32x2*)dst + lane;
#pragma unroll
    for (int j = 0; j < 16; ++j) { const f32x4 v = s[64 * j]; u32x2 o; o.x = cvt_pk_bf16(v.x, v.y); o.y = cvt_pk_bf16(v.z, v.w); d[64 * j] = o; }
}
__device__ __forceinline__ void p0_prologue(const Params& p, LAS unsigned char* lds, int gw, int NGW, int wave, int lane) {
    LAS unsigned* scr = (LAS unsigned*)(lds + wave * 8448);
    unsigned char* ws = p.ws;
    bf16_t* WINT = (bf16_t*)(ws + WS_WINT); bf16_t* WKVT = (bf16_t*)(ws + WS_WKVT); bf16_t* WPMT = (bf16_t*)(ws + WS_WPMT);
    bf16_t* WPCXT = (bf16_t*)(ws + WS_WPCXT); bf16_t* WOT = (bf16_t*)(ws + WS_WOT);
    constexpr int I_IN = 64 * 644, I_KV = 64 * 64, I_PM = 64 * 64, I_PC = 32 * 64, I_PX = 32 * 64, I_O = 64 * 64;
    constexpr int NITEMS = I_IN + I_KV + I_PM + I_PC + I_PX + I_O;
    for (int it = gw; it < NITEMS; it += NGW) {
        int r = it;
        if (r < I_IN) { const int kb = r / 644, nb = r % 644, n0 = nb * 64; int col0, ncv;
            if (n0 < 16384) { col0 = n0; ncv = 64; } else if (n0 < 40960) { col0 = n0 + 16; ncv = 64; } else if (n0 == 40960) { col0 = 16384; ncv = 16; } else { col0 = 0; ncv = 0; }
            transpose_item(p.w_in, DIN, col0, ncv, WINT, D, n0, kb * 64, scr, lane); continue; }
        r -= I_IN;
        if (r < I_KV) { transpose_item(p.w_mem_kv, 4096, (r % 64) * 64, 64, WKVT, 4096, (r % 64) * 64, (r / 64) * 64, scr, lane); continue; }
        r -= I_KV;
        if (r < I_PM) { transpose_item(p.w_proj_m, 4096, (r % 64) * 64, 64, WPMT, 4096, (r % 64) * 64, (r / 64) * 64, scr, lane); continue; }
        r -= I_PM;
        if (r < I_PC) { transpose_item(p.w_proj_c, 4096, (r % 64) * 64, 64, WPCXT, 4096, (r % 64) * 64, (r / 64) * 64, scr, lane); continue; }
        r -= I_PC;
        if (r < I_PX) { transpose_item(p.w_proj_x, 4096, (r % 64) * 64, 64, WPCXT + 2048, 4096, (r % 64) * 64, (r / 64) * 64, scr, lane); continue; }
        r -= I_PX;
        transpose_item(p.w_out, 4096, (r % 64) * 64, 64, WOT, 4096, (r % 64) * 64, (r / 64) * 64, scr, lane);
    }
    bf16_t* XB = (bf16_t*)(ws + WS_XB); bf16_t* MEMB = (bf16_t*)(ws + WS_MEMB);
    for (int m = gw; m < T; m += NGW) cvt_row(p.x + (size_t)m * D, XB + (size_t)m * D, lane);
    for (int m = gw; m < TM; m += NGW) cvt_row(p.mem + (size_t)m * D, MEMB + (size_t)m * D, lane);
    float* BU = (float*)(ws + WS_BU);
    for (int c = gw * 64 + lane; c < NU; c += NGW * 64) {
        float v = 0.f;
        if (c < 16384) v = p.b_in[c]; else if (c < 40960) v = p.b_in[c + 16]; else if (c < 40976) v = p.b_in[16384 + (c - 40960)];
        BU[c] = v;
    }
}

__device__ __forceinline__ int act_of(int c0) {
    if (c0 >= UO && c0 < UZ) return 1;
    if (c0 >= UZ && c0 < UCB) return 2;
    if (c0 >= UCZ && c0 < UXQ) return 2;
    if (c0 >= UXZ && c0 < UG) return 2;
    if (c0 >= UG && c0 < UI) return 1;
    return 0;
}
struct SchedP1 {
    int G, c; const char *xb, *memb, *wint, *wkvt;
    __device__ __forceinline__ bool next(int i, Unit& u) const {
        long L = (long)i * G + c;
        if (L < 5152) { pg8::tile_map(L, 32, 161, u.pm, u.pn); u.A = xb + (size_t)u.pm * 256 * 8192; u.B = wint + (size_t)u.pn * 256 * 8192; u.nt = 64; u.kind = 0; return true; }
        L -= 5152;
        if (L < 32) { u.pm = (int)L / 8; u.pn = (int)L % 8; u.A = memb + (size_t)u.pm * 256 * 8192; u.B = wkvt + (size_t)u.pn * 256 * 8192; u.nt = 64; u.kind = 1; return true; }
        L -= 32;
        if (L < 32) { u.pm = (int)L / 4; u.pn = (int)L % 4; u.A = wkvt + (size_t)(2048 + u.pm * 256) * 8192; u.B = memb + (size_t)u.pn * 256 * 8192; u.nt = 64; u.kind = 2; return true; }
        return false;
    }
};
struct EpiP1 {
    static constexpr bool PERM = true;
    bf16_t* U; const float* bU; bf16_t* KMEM; bf16_t* VT;
    __device__ __forceinline__ void operator()(const f32x4 (&acc)[2][2][4][2], const Unit& u, int wr, int wc, int fr, int fq) const {
        asm volatile("" : "+v"(fr), "+v"(fq));
        bf16_t* base; int ldc; const float* bias; int act = 0; float sc = 1.f;
        if (u.kind == 0) { const int c0 = u.pn * 256; base = U + (size_t)u.pm * 256 * NU + c0; ldc = NU; bias = bU + c0; act = act_of(c0); if (c0 < UK) sc = 0.0625f; }
        else if (u.kind == 1) { base = KMEM + (size_t)u.pm * 256 * 2048 + u.pn * 256; ldc = 2048; bias = nullptr; }
        else { base = VT + (size_t)u.pm * 256 * 1024 + u.pn * 256; ldc = 1024; bias = nullptr; }
        const int row0 = wr * 64 + fr, col0 = wc * 32 + 8 * fq;
        f32x4 bv[2][2];
#pragma unroll
        for (int bj = 0; bj < 2; ++bj)
#pragma unroll
            for (int n = 0; n < 2; ++n) bv[bj][n] = bias ? *(const f32x4*)(bias + col0 + bj * 128 + 4 * n) : (f32x4){0.f, 0.f, 0.f, 0.f};
#pragma unroll
        for (int ai = 0; ai < 2; ++ai)
#pragma unroll
            for (int m = 0; m < 4; ++m) { bf16_t* rowp = base + (size_t)(row0 + ai * 128 + m * 16) * ldc + col0;
#pragma unroll
                for (int bj = 0; bj < 2; ++bj) { f32x4 v0 = acc[ai][bj][m][0] + bv[bj][0], v1 = acc[ai][bj][m][1] + bv[bj][1];
                    if (act) {
#pragma unroll
                        for (int j = 0; j < 4; ++j) { const float s0 = sigmoidf_(v0[j]), s1 = sigmoidf_(v1[j]); v0[j] = (act == 1) ? s0 : v0[j] * s0; v1[j] = (act == 1) ? s1 : v1[j] * s1; } }
                    v0 = v0 * sc; v1 = v1 * sc;
                    u32x4 w; w.x = cvt_pk_bf16(v0[0], v0[1]); w.y = cvt_pk_bf16(v0[2], v0[3]); w.z = cvt_pk_bf16(v1[0], v1[1]); w.w = cvt_pk_bf16(v1[2], v1[3]);
                    *(u32x4*)(rowp + bj * 128) = w; } }
    }
};
struct SchedQK {
    int G, c; const char *u, *kmem;
    __device__ __forceinline__ bool next(int i, Unit& un) const {
        const int L = i * G + c; if (L >= 128) return false;
        const int head = L & 3, rt = L >> 2;
        un.pm = rt; un.pn = head; un.A = u + ((size_t)rt * 256 * NU + UXQ + head * 512) * 2; un.B = kmem + ((size_t)(rt >> 3) * 256 * 2048 + head * 512) * 2; un.nt = 8; un.kind = 0; return true;
    }
};
struct EpiSC {
    static constexpr bool PERM = false;
    float* SC;
    __device__ __forceinline__ void operator()(const f32x4 (&acc)[2][2][4][2], const Unit& u, int wr, int wc, int fr, int fq) const {
        asm volatile("" : "+v"(fr), "+v"(fq));
        const float sc = 0.04419417382415922f;
        float* base = SC + (size_t)u.pm * 256 * 1024 + u.pn * 256;
        const int row0 = wr * 64 + fr, col0 = wc * 32 + 4 * fq;
#pragma unroll
        for (int ai = 0; ai < 2; ++ai)
#pragma unroll
            for (int m = 0; m < 4; ++m) { float* rowp = base + (size_t)(row0 + ai * 128 + m * 16) * 1024 + col0;
#pragma unroll
                for (int bj = 0; bj < 2; ++bj)
#pragma unroll
                    for (int n = 0; n < 2; ++n) *(f32x4*)(rowp + bj * 128 + n * 16) = acc[ai][bj][m][n] * sc; }
    }
};
struct SchedPV {
    int G, c; const char *pb, *vt;
    __device__ __forceinline__ bool next(int i, Unit& un) const {
        const int L = i * G + c; if (L >= 256) return false;
        const int n2 = L & 1, head = (L >> 1) & 3, rt = L >> 3;
        un.pm = rt; un.pn = head * 2 + n2; un.A = pb + ((size_t)rt * 256 * 1024 + head * 256) * 2; un.B = vt + ((size_t)(head * 512 + n2 * 256) * 1024 + (rt >> 3) * 256) * 2; un.nt = 4; un.kind = 0; return true;
    }
};
struct EpiPV {
    static constexpr bool PERM = true;
    const bf16_t* U; bf16_t* YCX;
    __device__ __forceinline__ void operator()(const f32x4 (&acc)[2][2][4][2], const Unit& u, int wr, int wc, int fr, int fq) const {
        asm volatile("" : "+v"(fr), "+v"(fq));
        const bf16_t* zb = U + (size_t)u.pm * 256 * NU + UXZ + u.pn * 256;
        bf16_t* ob = YCX + (size_t)u.pm * 256 * 4096 + 2048 + u.pn * 256;
        const int row0 = wr * 64 + fr, col0 = wc * 32 + 8 * fq;
#pragma unroll
        for (int ai = 0; ai < 2; ++ai)
#pragma unroll
            for (int m = 0; m < 4; ++m) { const size_t r = (size_t)(row0 + ai * 128 + m * 16);
#pragma unroll
                for (int bj = 0; bj < 2; ++bj) { const u32x4 z = *(const u32x4*)(zb + r * NU + col0 + bj * 128);
                    const f32x4 v0 = acc[ai][bj][m][0], v1 = acc[ai][bj][m][1];
                    u32x4 w; w.x = cvt_pk_bf16(v0[0] * bf_lo(z.x), v0[1] * bf_hi(z.x)); w.y = cvt_pk_bf16(v0[2] * bf_lo(z.y), v0[3] * bf_hi(z.y));
                    w.z = cvt_pk_bf16(v1[0] * bf_lo(z.z), v1[1] * bf_hi(z.z)); w.w = cvt_pk_bf16(v1[2] * bf_lo(z.w), v1[3] * bf_hi(z.w));
                    *(u32x4*)(ob + r * 4096 + col0 + bj * 128) = w; }
                asm volatile("" ::: "memory"); }
    }
};
struct SchedMerge {
    int G, c; const char *ym, *ycx, *wpmt, *wpcxt;
    __device__ __forceinline__ bool next(int i, Unit& u) const {
        const int r = i / 3, br = i - 3 * r;
        if (!pg8::tile_map((long)r * G + c, 32, 16, u.pm, u.pn)) return false;
        u.kind = br;
        if (br == 0) { u.A = ym + (size_t)u.pm * 256 * 8192; u.B = wpmt + (size_t)u.pn * 256 * 8192; u.nt = 64; }
        else { u.A = ycx + (size_t)u.pm * 256 * 8192 + (br == 2 ? 4096 : 0); u.B = wpcxt + (size_t)u.pn * 256 * 8192 + (br == 2 ? 4096 : 0); u.nt = 32; }
        return true;
    }
};
struct EpiMerge {
    static constexpr bool PERM = false;
    const bf16_t* U; float* scr; bf16_t* MERGED;
    __device__ __forceinline__ void operator()(const f32x4 (&acc)[2][2][4][2], const Unit& u, int wr, int wc, int fr, int fq) const {
        asm volatile("" : "+v"(fr), "+v"(fq));
        const int br = u.kind;
        const bf16_t* gb = U + (size_t)u.pm * 256 * NU + UG + br * 4096 + u.pn * 256;
        const size_t ob = (size_t)u.pm * 256 * 4096 + u.pn * 256;
        const int row0 = wr * 64 + fr, col0 = wc * 32 + 4 * fq;
#pragma unroll
        for (int ai = 0; ai < 2; ++ai)
#pragma unroll
            for (int m = 0; m < 4; ++m) { const size_t r = (size_t)(row0 + ai * 128 + m * 16);
#pragma unroll
                for (int bj = 0; bj < 2; ++bj)
#pragma unroll
                    for (int n = 0; n < 2; ++n) { const int cc = col0 + bj * 128 + n * 16;
                        const u32x2 g = *(const u32x2*)(gb + r * NU + cc);
                        f32x4 v = acc[ai][bj][m][n]; v[0] *= bf_lo(g.x); v[1] *= bf_hi(g.x); v[2] *= bf_lo(g.y); v[3] *= bf_hi(g.y);
                        float* sp = scr + ob + r * 4096 + cc;
                        if (br != 0) v = v + *(const f32x4*)sp;
                        if (br != 2) *(f32x4*)sp = v;
                        else { u32x2 w; w.x = cvt_pk_bf16(v[0], v[1]); w.y = cvt_pk_bf16(v[2], v[3]); *(u32x2*)(MERGED + ob + r * 4096 + cc) = w; } }
                asm volatile("" ::: "memory"); }
    }
};
struct SchedOut {
    int G, c; const char *merged, *wot;
    __device__ __forceinline__ bool next(int i, Unit& u) const {
        if (!pg8::tile_map((long)i * G + c, 32, 16, u.pm, u.pn)) return false;
        u.A = merged + (size_t)u.pm * 256 * 8192; u.B = wot + (size_t)u.pn * 256 * 8192; u.nt = 64; u.kind = 0; return true;
    }
};
struct EpiOut {
    static constexpr bool PERM = false;
    const float* x; float* out;
    __device__ __forceinline__ void operator()(const f32x4 (&acc)[2][2][4][2], const Unit& u, int wr, int wc, int fr, int fq) const {
        asm volatile("" : "+v"(fr), "+v"(fq));
        const size_t ob = (size_t)u.pm * 256 * 4096 + u.pn * 256;
        const int row0 = wr * 64 + fr, col0 = wc * 32 + 4 * fq;
#pragma unroll
        for (int ai = 0; ai < 2; ++ai)
#pragma unroll
            for (int m = 0; m < 4; ++m) { const size_t r = (size_t)(row0 + ai * 128 + m * 16);
#pragma unroll
                for (int bj = 0; bj < 2; ++bj)
#pragma unroll
                    for (int n = 0; n < 2; ++n) { const size_t o = ob + r * 4096 + col0 + bj * 128 + n * 16;
                        const f32x4 xv = *(const f32x4*)(x + o);
                        *(f32x4*)(out + o) = xv * DN_ALPHA + acc[ai][bj][m][n]; }
                asm volatile("" ::: "memory"); }
    }
};

__device__ __forceinline__ void conv_phase(const Params& p, int gtid, int NGT) {
    const bf16_t* U = (const bf16_t*)(p.ws + WS_U); bf16_t* YCX = (bf16_t*)(p.ws + WS_YCX);
    for (int idx = gtid; idx < T * 256; idx += NGT) {
        const int t = idx >> 8, c = (idx & 255) * 8, tl = t & (SEQ - 1);
        const bf16_t* row = U + (size_t)t * NU;
        const u32x4 cb = *(const u32x4*)(row + UCB + c), cz = *(const u32x4*)(row + UCZ + c);
        const unsigned cbw[4] = {cb.x, cb.y, cb.z, cb.w}, czw[4] = {cz.x, cz.y, cz.z, cz.w};
        float accv[8];
#pragma unroll
        for (int j = 0; j < 8; ++j) accv[j] = 0.f;
#pragma unroll
        for (int w = 0; w < 3; ++w) {
            const int dt = 2 - w;
            if (tl >= dt) {
                const bf16_t* r2 = row - (size_t)dt * NU;
                const u32x4 a = *(const u32x4*)(r2 + UCC + c), b = *(const u32x4*)(r2 + UCX + c);
                const unsigned aw[4] = {a.x, a.y, a.z, a.w}, bw[4] = {b.x, b.y, b.z, b.w};
                const f32x4 w0 = *(const f32x4*)(p.conv_w + w * 2048 + c), w1 = *(const f32x4*)(p.conv_w + w * 2048 + c + 4);
                const float wv[8] = {w0[0], w0[1], w0[2], w0[3], w1[0], w1[1], w1[2], w1[3]};
#pragma unroll
                for (int j = 0; j < 4; ++j) { accv[2 * j] += wv[2 * j] * (bf_lo(aw[j]) * bf_lo(bw[j])); accv[2 * j + 1] += wv[2 * j + 1] * (bf_hi(aw[j]) * bf_hi(bw[j])); }
            }
        }
        u32x4 o; unsigned ow[4];
#pragma unroll
        for (int j = 0; j < 4; ++j) ow[j] = cvt_pk_bf16(bf_lo(cbw[j]) * accv[2 * j] * bf_lo(czw[j]), bf_hi(cbw[j]) * accv[2 * j + 1] * bf_hi(czw[j]));
        o.x = ow[0]; o.y = ow[1]; o.z = ow[2]; o.w = ow[3];
        *(u32x4*)(YCX + (size_t)t * 4096 + c) = o;
    }
}
__device__ __forceinline__ void softmax_phase(const Params& p, int gw, int NGW, int lane) {
    const float* SC = (const float*)(p.ws + WS_SC); bf16_t* PB = (bf16_t*)(p.ws + WS_PB);
    for (int it = gw; it < T * 4; it += NGW) {
        const f32x4 s = *(const f32x4*)(SC + (size_t)it * 256 + 4 * lane);
        const float mx = wave_max(fmaxf(fmaxf(s[0], s[1]), fmaxf(s[2], s[3])));
        const float e0 = __expf(s[0] - mx), e1 = __expf(s[1] - mx), e2 = __expf(s[2] - mx), e3 = __expf(s[3] - mx);
        const float inv = 1.0f / wave_sum((e0 + e1) + (e2 + e3));
        u32x2 o; o.x = cvt_pk_bf16(e0 * inv, e1 * inv); o.y = cvt_pk_bf16(e2 * inv, e3 * inv);
        *(u32x2*)(PB + (size_t)it * 256 + 4 * lane) = o;
    }
}
__device__ __forceinline__ void ym_phase(const Params& p, int gw, int NGW, int lane) {
    const bf16_t* U = (const bf16_t*)(p.ws + WS_U); const bf16_t* HR = (const bf16_t*)(p.ws + WS_HRAW); bf16_t* YM = (bf16_t*)(p.ws + WS_YM);
    for (int it = gw; it < T * 8; it += NGW) {
        const int t = it >> 3, h = it & 7, c = h * 512 + 8 * lane;
        const u32x4 hv = *(const u32x4*)(HR + (size_t)t * 4096 + c);
        const u32x4 mo = *(const u32x4*)(U + (size_t)t * NU + UO + c), mz = *(const u32x4*)(U + (size_t)t * NU + UZ + c);
        const f32x4 w0 = *(const f32x4*)(p.mh_norm_w + c), w1 = *(const f32x4*)(p.mh_norm_w + c + 4);
        float v[8] = {bf_lo(hv.x), bf_hi(hv.x), bf_lo(hv.y), bf_hi(hv.y), bf_lo(hv.z), bf_hi(hv.z), bf_lo(hv.w), bf_hi(hv.w)};
        float s = 0.f;
#pragma unroll
        for (int j = 0; j < 8; ++j) s += v[j];
        const float mean = wave_sum(s) * (1.0f / 512.0f);
        float q = 0.f;
#pragma unroll
        for (int j = 0; j < 8; ++j) { v[j] -= mean; q += v[j] * v[j]; }
        const float rstd = 1.0f / sqrtf(wave_sum(q) * (1.0f / 512.0f) + LN_EPS);
        const float g[8] = {bf_lo(mo.x) * bf_lo(mz.x), bf_hi(mo.x) * bf_hi(mz.x), bf_lo(mo.y) * bf_lo(mz.y), bf_hi(mo.y) * bf_hi(mz.y),
                            bf_lo(mo.z) * bf_lo(mz.z), bf_hi(mo.z) * bf_hi(mz.z), bf_lo(mo.w) * bf_lo(mz.w), bf_hi(mo.w) * bf_hi(mz.w)};
        const float wv[8] = {w0[0], w0[1], w0[2], w0[3], w1[0], w1[1], w1[2], w1[3]};
        u32x4 o; unsigned ow[4];
#pragma unroll
        for (int j = 0; j < 4; ++j) ow[j] = cvt_pk_bf16(v[2 * j] * rstd * wv[2 * j] * g[2 * j], v[2 * j + 1] * rstd * wv[2 * j + 1] * g[2 * j + 1]);
        o.x = ow[0]; o.y = ow[1]; o.z = ow[2]; o.w = ow[3];
        *(u32x4*)(YM + (size_t)t * 4096 + c) = o;
    }
}
__device__ __forceinline__ void ln_phase(const Params& p, int gw, int NGW, int lane) {
    for (int m = gw; m < T; m += NGW) {
        f32x4* r = (f32x4*)(p.out + (size_t)m * D) + lane;
        f32x4 v[16]; float s = 0.f;
#pragma unroll
        for (int j = 0; j < 16; ++j) { v[j] = r[64 * j]; s += (v[j][0] + v[j][1]) + (v[j][2] + v[j][3]); }
        const float mean = wave_sum(s) * (1.0f / D); float q = 0.f;
#pragma unroll
        for (int j = 0; j < 16; ++j) { v[j] = v[j] - mean; q += (v[j][0] * v[j][0] + v[j][1] * v[j][1]) + (v[j][2] * v[j][2] + v[j][3] * v[j][3]); }
        const float rstd = 1.0f / sqrtf(wave_sum(q) * (1.0f / D) + LN_EPS);
#pragma unroll
        for (int j = 0; j < 16; ++j) { const f32x4 w = *((const f32x4*)p.ln_w + lane + 64 * j), b = *((const f32x4*)p.ln_b + lane + 64 * j); r[64 * j] = v[j] * rstd * w + b; }
    }
}

__device__ __forceinline__ void mlstm_naive(const Params& p, LAS unsigned char* lds, int unit, int wave, int lane) {
    const int s = unit & 7, h = (unit >> 3) & 7, b = unit >> 6;
    LAS float* part = (LAS float*)lds;
    LAS float* pden = part + 2 * 8 * 64;
    const bf16_t* Ub = (const bf16_t*)(p.ws + WS_U) + (size_t)(b * SEQ) * NU;
    bf16_t* HR = (bf16_t*)(p.ws + WS_HRAW) + (size_t)(b * SEQ) * 4096 + h * 512 + s * 64 + lane;
    float C[32], n[32];
#pragma unroll
    for (int d = 0; d < 32; ++d) { C[d] = 0.f; n[d] = 0.f; }
    float m = 0.f;
    for (int t = 0; t < SEQ; ++t) {
        const bf16_t* row = Ub + (size_t)t * NU;
        u32x4 kk[4], qq[4];
#pragma unroll
        for (int j = 0; j < 4; ++j) { kk[j] = *(const u32x4*)(row + UK + h * 256 + wave * 32 + 8 * j); qq[j] = *(const u32x4*)(row + UQ + h * 256 + wave * 32 + 8 * j); }
        const float vv = bf2f(row[UV + h * 512 + s * 64 + lane]);
        const float ig = bf2f(row[UI + h]), fp = bf2f(row[UF + h]);
        const float lf = fminf(fp, 0.f) - log1pf(__expf(-fabsf(fp)));
        const float mn = fmaxf(lf + m, ig), fd = __expf(lf + m - mn), iw = __expf(ig - mn);
        m = mn;
        float num = 0.f, den = 0.f;
#pragma unroll
        for (int j = 0; j < 4; ++j) {
            const unsigned kw[4] = {kk[j].x, kk[j].y, kk[j].z, kk[j].w}, qw[4] = {qq[j].x, qq[j].y, qq[j].z, qq[j].w};
#pragma unroll
            for (int e = 0; e < 4; ++e) {
                const int d = 8 * j + 2 * e;
                const float k0 = iw * bf_lo(kw[e]), k1 = iw * bf_hi(kw[e]), q0 = bf_lo(qw[e]), q1 = bf_hi(qw[e]);
                C[d] = fd * C[d] + k0 * vv; n[d] = fd * n[d] + k0; num += q0 * C[d]; den += q0 * n[d];
                C[d + 1] = fd * C[d + 1] + k1 * vv; n[d + 1] = fd * n[d + 1] + k1; num += q1 * C[d + 1]; den += q1 * n[d + 1];
            }
        }
        const int buf = t & 1;
        part[(buf * 8 + wave) * 64 + lane] = num; if (lane == 0) pden[buf * 8 + wave] = den;
        __syncthreads();
        if (wave == (t & 7)) {
            float nt_ = 0.f, dt_ = 0.f;
#pragma unroll
            for (int w = 0; w < 8; ++w) { nt_ += part[(buf * 8 + w) * 64 + lane]; dt_ += pden[buf * 8 + w]; }
            const float hv = nt_ / fmaxf(fabsf(dt_), __expf(-m));
            HR[(size_t)t * 4096] = (bf16_t)(cvt_pk_bf16(hv, 0.f) & 0xffffu);
        }
    }
    __syncthreads();
}

__global__ void __launch_bounds__(NWAVES * 64, 2) mk_fwd(Params p) {
    extern __shared__ __attribute__((aligned(16))) unsigned char lds_raw[];
    LAS unsigned char* lds = (LAS unsigned char*)lds_raw;
    volatile LAS unsigned* MISC = (volatile LAS unsigned*)(lds + MISC_OFF);
    const int tid = threadIdx.x, lane = tid & 63, wave = __builtin_amdgcn_readfirstlane(tid >> 6);
    const int G = gridDim.x, bx = blockIdx.x;
    const int vcu = (G % 8 == 0) ? (bx % 8) * (G / 8) + bx / 8 : bx;
    const int gw = vcu * NWAVES + wave, NGW = G * NWAVES;
    unsigned char* ws = p.ws;
    unsigned* ctl = (unsigned*)(ws + WS_CTL);
    for (int u = tid; u < (LDS_BYTES - LDSCTL_OFF) / 4; u += NWAVES * 64) ((LAS unsigned*)(lds + LDSCTL_OFF))[u] = 0u;
    __syncthreads();
    const bool one_launch = (p.ph_lo == 0 && p.ph_hi >= 8);
    XcdBarrier bar; bar.bar = ctl + CW_BAR; bar.x = 0; bar.st = nullptr;
    if (one_launch) bar = xcd_barrier_post(ctl + CW_BAR, MISC + 8);
    const int lo = p.ph_lo, hi = p.ph_hi;
#define IN(k) (lo <= (k) && (k) < hi)
#define GRID_BAR() do { if (one_launch) xcd_barrier(bar); } while (0)

    if (IN(0)) { p0_prologue(p, lds, gw, NGW, wave, lane); GRID_BAR(); }
    if (IN(1)) {
        SchedP1 S{G, bx, (const char*)(ws + WS_XB), (const char*)(ws + WS_MEMB), (const char*)(ws + WS_WINT), (const char*)(ws + WS_WKVT)};
        EpiP1 E{(bf16_t*)(ws + WS_U), (const float*)(ws + WS_BU), (bf16_t*)(ws + WS_KMEM), (bf16_t*)(ws + WS_VT)};
        pg8::gemm_phase<EpiP1, SchedP1, true, true>(lds, 8192, 8192, S, E);
        GRID_BAR();
    }
    if (IN(2)) {
        { SchedQK S{G, bx, (const char*)(ws + WS_U), (const char*)(ws + WS_KMEM)}; EpiSC E{(float*)(ws + WS_SC)};
          pg8::gemm_phase<EpiSC, SchedQK, true, true>(lds, NU * 2, 4096, S, E); }
        conv_phase(p, vcu * (NWAVES * 64) + tid, G * NWAVES * 64);
        __syncthreads();
        for (int unit = bx; unit < 256; unit += G) mlstm_naive(p, lds, unit, wave, lane);
        GRID_BAR();
    }
    if (IN(3)) { softmax_phase(p, gw, NGW, lane); ym_phase(p, gw, NGW, lane); GRID_BAR(); }
    if (IN(4)) {
        SchedPV S{G, bx, (const char*)(ws + WS_PB), (const char*)(ws + WS_VT)}; EpiPV E{(const bf16_t*)(ws + WS_U), (bf16_t*)(ws + WS_YCX)};
        pg8::gemm_phase<EpiPV, SchedPV, true, true>(lds, 2048, 2048, S, E);
        GRID_BAR();
    }
    if (IN(5)) {
        SchedMerge S{G, bx, (const char*)(ws + WS_YM), (const char*)(ws + WS_YCX), (const char*)(ws + WS_WPMT), (const char*)(ws + WS_WPCXT)};
        EpiMerge E{(const bf16_t*)(ws + WS_U), p.out, (bf16_t*)(ws + WS_MERGED)};
        pg8::gemm_phase<EpiMerge, SchedMerge, true, true>(lds, 8192, 8192, S, E);
        GRID_BAR();
    }
    if (IN(6)) {
        SchedOut S{G, bx, (const char*)(ws + WS_MERGED), (const char*)(ws + WS_WOT)}; EpiOut E{p.x, p.out};
        pg8::gemm_phase<EpiOut, SchedOut, true, true>(lds, 8192, 8192, S, E);
        GRID_BAR();
    }
    if (IN(7)) ln_phase(p, gw, NGW, lane);
#undef IN
#undef GRID_BAR
}

#ifndef MK_N_LAUNCHES
#define MK_N_LAUNCHES 8
#endif
extern "C" void kernel_launch(void* const* d_in, const int* in_sizes, int n_in, void* d_out, int out_size, void* d_ws, size_t ws_size, hipStream_t stream) {
    static int grid = 0;
    if (grid == 0) {
        if (n_in != 13 || out_size != T * D || ws_size < WS_END) { fprintf(stderr, "kernel_launch: unexpected shapes (n_in %d out %d ws %zu)\n", n_in, out_size, ws_size); grid = -1; return; }
        int dev = 0, cus = 0, per_cu = 0;
        if (hipGetDevice(&dev) != hipSuccess || hipDeviceGetAttribute(&cus, hipDeviceAttributeMultiprocessorCount, dev) != hipSuccess) { grid = -1; return; }
        if (hipFuncSetAttribute((const void*)mk_fwd, hipFuncAttributeMaxDynamicSharedMemorySize, LDS_BYTES) != hipSuccess) { fprintf(stderr, "kernel_launch: hipFuncSetAttribute failed\n"); grid = -1; return; }
        if (hipOccupancyMaxActiveBlocksPerMultiprocessor(&per_cu, (const void*)mk_fwd, NWAVES * 64, LDS_BYTES) != hipSuccess || per_cu < 1)
            fprintf(stderr, "kernel_launch: note: occupancy query reports %d\n", per_cu);
        (void)hipGetLastError();
        grid = cus;
    }
    if (grid < 0) return;
    (void)hipMemsetAsync((char*)d_ws + WS_CTL, 0, CTL_ZERO_BYTES, stream);
    Params p{};
    p.x = (const float*)d_in[0]; p.mem = (const float*)d_in[1]; p.w_in = (const float*)d_in[2]; p.b_in = (const float*)d_in[3];
    p.conv_w = (const float*)d_in[4]; p.mh_norm_w = (const float*)d_in[5]; p.w_mem_kv = (const float*)d_in[6]; p.w_proj_m = (const float*)d_in[7];
    p.w_proj_c = (const float*)d_in[8]; p.w_proj_x = (const float*)d_in[9]; p.w_out = (const float*)d_in[10]; p.ln_w = (const float*)d_in[11]; p.ln_b = (const float*)d_in[12];
    p.out = (float*)d_out; p.ws = (unsigned char*)d_ws;
    if (MK_N_LAUNCHES == 1) { p.ph_lo = 0; p.ph_hi = 8; hipLaunchKernelGGL(mk_fwd, dim3(grid), dim3(NWAVES * 64), LDS_BYTES, stream, p); }
    else for (int k = 0; k < 8; ++k) { p.ph_lo = k; p.ph_hi = k + 1; hipLaunchKernelGGL(mk_fwd, dim3(grid), dim3(NWAVES * 64), LDS_BYTES, stream, p); }
}
```

```cpp
#include <hip/hip_runtime.h>
#include <cstdio>
#include <cstdint>

#define LAS __attribute__((address_space(3)))
#define GAS __attribute__((address_space(1)))
typedef unsigned short bf16_t;
typedef short bf16x8 __attribute__((ext_vector_type(8)));
typedef float f32x4 __attribute__((ext_vector_type(4)));
typedef float f32x2 __attribute__((ext_vector_type(2)));
typedef unsigned u32x4 __attribute__((ext_vector_type(4)));
typedef unsigned u32x2 __attribute__((ext_vector_type(2)));

constexpr int NB = 4, SEQ = 2048, T = NB * SEQ, D = 4096;
constexpr int DIN = 40976, NU = 41216;
constexpr int MEMLEN = 256, TM = NB * MEMLEN;
constexpr int UQ = 0, UK = 2048, UV = 4096, UO = 8192, UZ = 12288, UCB = 16384, UCC = 18432, UCX = 20480, UCZ = 22528,
              UXQ = 24576, UXZ = 26624, UG = 28672, UI = 40960, UF = 40968;
constexpr float LN_EPS = 1e-5f;
constexpr float DN_ALPHA = 1.189207115002721f;

constexpr size_t MiB = 1u << 20;
constexpr size_t WS_CTL = 0, CTL_ZERO_BYTES = 1 * MiB;
constexpr size_t WS_BU = 1 * MiB;
constexpr size_t WS_XB = 2 * MiB;
constexpr size_t WS_MEMB = 66 * MiB;
constexpr size_t WS_WINT = 74 * MiB;
constexpr size_t WS_WKVT = 396 * MiB;
constexpr size_t WS_WPMT = 428 * MiB;
constexpr size_t WS_WPCXT = 460 * MiB;
constexpr size_t WS_WOT = 492 * MiB;
constexpr size_t WS_U = 524 * MiB;
constexpr size_t WS_KMEM = 1168 * MiB;
constexpr size_t WS_VT = 1172 * MiB;
constexpr size_t WS_SC = 1176 * MiB;
constexpr size_t WS_PB = 1208 * MiB;
constexpr size_t WS_HRAW = 1224 * MiB;
constexpr size_t WS_YM = 1288 * MiB;
constexpr size_t WS_YCX = 1352 * MiB;
constexpr size_t WS_MERGED = 1416 * MiB;
constexpr size_t WS_END = 1480 * MiB;
constexpr int CW_BAR = 4096;

constexpr int RING_BYTES = 131072;
constexpr int LDSCTL_OFF = RING_BYTES, MISC_OFF = LDSCTL_OFF + 320;
constexpr int LDS_BYTES = 147456;
constexpr int NWAVES = 8;

__device__ __forceinline__ unsigned cvt_pk_bf16(float lo, float hi) { unsigned r; asm("v_cvt_pk_bf16_f32 %0, %1, %2" : "=v"(r) : "v"(lo), "v"(hi)); return r; }
__device__ __forceinline__ float bf_lo(unsigned w) { return __uint_as_float(w << 16); }
__device__ __forceinline__ float bf_hi(unsigned w) { return __uint_as_float(w & 0xffff0000u); }
__device__ __forceinline__ float bf2f(bf16_t h) { return __uint_as_float(((unsigned)h) << 16); }
__device__ __forceinline__ float sigmoidf_(float x) { return __builtin_amdgcn_rcpf(1.0f + __expf(-x)); }
__device__ __forceinline__ float wave_sum(float v) {
#pragma unroll
    for (int o = 1; o < 64; o <<= 1) v += __shfl_xor(v, o);
    return v;
}
__device__ __forceinline__ float wave_max(float v) {
#pragma unroll
    for (int o = 1; o < 64; o <<= 1) v = fmaxf(v, __shfl_xor(v, o));
    return v;
}
#define LDS_WAIT() asm volatile("s_waitcnt lgkmcnt(0)" ::: "memory")
#define VM_WAIT() asm volatile("s_waitcnt vmcnt(0)" ::: "memory")

namespace pg8 {
constexpr int BM = 256, BK = 64, HALF = 128, HTB = HALF * BK * 2, STAGE_BYTES = 8 * HTB;
__host__ __device__ __forceinline__ int lds_byte(int r, int c) { const int st = (r >> 4) * 2 + (c >> 5), rr = r & 15, cc = c & 31, ob = rr * 64 + cc * 2; return st * 1024 + (ob ^ (((ob >> 9) & 1) << 5)); }
__host__ __device__ __forceinline__ void stage_rc(int b, int& R, int& C) { const int st = b / 1024, sb = b % 1024, swz = sb ^ (((sb >> 9) & 1) << 5); R = (st >> 1) * 16 + swz / 64; C = (st & 1) * 32 + (swz % 64) / 2; }
__host__ __device__ __forceinline__ int perm32(int rho) { const int n = rho >> 4, i = rho & 15; return 8 * (i >> 2) + 4 * n + (i & 3); }

struct Unit { const char* A; const char* B; int nt, pm, pn, kind; };

__device__ __forceinline__ bool tile_map(long L, int nM, int nN, int& pm, int& pn) {
    const int nwg = nM * nN; if (L >= nwg) return false;
    int wgid = (int)L; { const int q = nwg / 8, r = nwg % 8, xcd = wgid % 8, off = wgid / 8; wgid = (xcd < r ? xcd * (q + 1) : r * (q + 1) + (xcd - r) * q) + off; }
    const int nig = 8 * nN, gid = wgid / nig, fm = gid * 8, gsz = (nM - fm) < 8 ? (nM - fm) : 8;
    pm = fm + ((wgid % nig) % gsz); pn = (wgid % nig) / gsz; return true;
}

template <class Epi, class Sched, bool ALIGN_EPI, bool SP2>
__device__ __forceinline__ void gemm_phase(LAS unsigned char* lds, const int lda, const int ldb, const Sched& S, const Epi& E) {
    const int tid = threadIdx.x, wid = __builtin_amdgcn_readfirstlane(tid >> 6), lane = tid & 63, wr = wid >> 2, wc = wid & 3, fr = lane & 15, fq = lane >> 4;
    unsigned voffA[2], voffB[2];
#pragma unroll
    for (int i = 0; i < 2; ++i) { int R, C; stage_rc(tid * 16 + i * 8192, R, C); const int Rb = Epi::PERM ? ((R & ~31) + perm32(R & 31)) : R;
        voffA[i] = (unsigned)(R * lda + C * 2); voffB[i] = (unsigned)(Rb * ldb + C * 2); }
    const size_t kstep = (size_t)(BK * 2);
    const size_t hstepA = (size_t)HALF * lda, hstepB = (size_t)HALF * ldb;
    const unsigned ldsw = (unsigned)wid * 1024u;
    const int aoff = lds_byte(wr * 64 + fr, fq * 8), boff = lds_byte(wc * 32 + fr, fq * 8);
#define PG8_SA(b, h) (((b) * 2 + (h)) * HTB)
#define PG8_SB(b, h) ((4 + (b) * 2 + (h)) * HTB)
#define PG8_STAGE(bufoff, gbase, voff) do { _Pragma("unroll") for (int _i = 0; _i < 2; ++_i) \
        __builtin_amdgcn_global_load_lds((const unsigned*)((const char*)(gbase) + (voff)[_i]), (LAS unsigned*)(lds + (bufoff) + ldsw + _i * 8192), 16, 0, 0); } while (0)
#define PG8_LDA(dst, b, h) do { _Pragma("unroll") for (int m = 0; m < 4; ++m) _Pragma("unroll") for (int k = 0; k < 2; ++k) dst[m][k] = *(const LAS bf16x8*)(lds + PG8_SA(b, h) + aoff + m * 2048 + k * 1024); } while (0)
#define PG8_LDB(dst, b, h) do { _Pragma("unroll") for (int n = 0; n < 2; ++n) _Pragma("unroll") for (int k = 0; k < 2; ++k) dst[n][k] = *(const LAS bf16x8*)(lds + PG8_SB(b, h) + boff + n * 2048 + k * 1024); } while (0)
#define PG8_MMA(ai, bj, At, Bt) do { __builtin_amdgcn_s_setprio(1); _Pragma("unroll") for (int m = 0; m < 4; ++m) _Pragma("unroll") for (int n = 0; n < 2; ++n) _Pragma("unroll") for (int k = 0; k < 2; ++k) \
        acc[ai][bj][m][n] = __builtin_amdgcn_mfma_f32_16x16x32_bf16(Bt[n][k], At[m][k], acc[ai][bj][m][n], 0, 0, 0); __builtin_amdgcn_s_setprio(0); } while (0)
#define PG8_WAIT_V(n) asm volatile("s_waitcnt vmcnt(" #n ")" ::: "memory")
#define PG8_WAIT_L(n) asm volatile("s_waitcnt lgkmcnt(" #n ")" ::: "memory")
#define PG8_BAR __builtin_amdgcn_s_barrier()
#define PG8_SCHED __builtin_amdgcn_sched_barrier(0)
    Unit cur, nxt; int ui = 0;
    if (!S.next(0, cur)) return;
    f32x4 acc[2][2][4][2];
#pragma unroll
    for (int a = 0; a < 2; ++a)
#pragma unroll
        for (int b = 0; b < 2; ++b)
#pragma unroll
            for (int m = 0; m < 4; ++m)
#pragma unroll
                for (int n = 0; n < 2; ++n) acc[a][b][m][n] = (f32x4){0.f, 0.f, 0.f, 0.f};
    bf16x8 At[4][2], B0[2][2], B1[2][2];
    const char* cA = cur.A; const char* cB = cur.B;
    if constexpr (SP2) {
        PG8_STAGE(PG8_SB(0, 0), cB, voffB); PG8_STAGE(PG8_SB(0, 1), cB + hstepB, voffB); PG8_STAGE(PG8_SA(0, 0), cA, voffA); PG8_STAGE(PG8_SA(0, 1), cA + hstepA, voffA);
        if (wr == 1) PG8_BAR;
        PG8_WAIT_V(2); PG8_BAR;
        PG8_STAGE(PG8_SB(1, 0), cB + kstep, voffB); PG8_STAGE(PG8_SA(1, 0), cA + kstep, voffA); PG8_STAGE(PG8_SB(1, 1), cB + hstepB + kstep, voffB);
        PG8_WAIT_V(6); PG8_BAR;
    } else {
        PG8_STAGE(PG8_SB(0, 0), cB, voffB); PG8_STAGE(PG8_SA(0, 0), cA, voffA); PG8_STAGE(PG8_SB(0, 1), cB + hstepB, voffB); PG8_STAGE(PG8_SA(0, 1), cA + hstepA, voffA);
        if (wr == 1) PG8_BAR;
        PG8_WAIT_V(4); PG8_BAR;
        PG8_STAGE(PG8_SB(1, 0), cB + kstep, voffB); PG8_STAGE(PG8_SA(1, 0), cA + kstep, voffA); PG8_STAGE(PG8_SB(1, 1), cB + hstepB + kstep, voffB);
        PG8_WAIT_V(6); PG8_BAR;
    }
    for (;;) {
        const bool has_next = S.next(ui + 1, nxt);
        const char* nA = has_next ? nxt.A : cA; const char* nB = has_next ? nxt.B : cB;
        const int nt = cur.nt;
        for (int t = 0; t < nt; t += 2) {
            const bool last = (t == nt - 2);
            const char* a1 = cA + (size_t)(t + 1) * kstep;
            const char* a2 = last ? nA : cA + (size_t)(t + 2) * kstep; const char* b2 = last ? nB : cB + (size_t)(t + 2) * kstep;
            const char* a3 = a2 + kstep; const char* b3 = b2 + kstep;
            if constexpr (SP2) {
            PG8_LDB(B0, 0, 0); PG8_LDB(B1, 0, 1); PG8_SCHED; PG8_LDA(At, 0, 0); PG8_STAGE(PG8_SA(1, 1), a1 + hstepA, voffA);
            PG8_WAIT_V(8); PG8_WAIT_L(0); PG8_BAR; PG8_MMA(0, 0, At, B0); PG8_MMA(0, 1, At, B1); PG8_BAR; PG8_SCHED;
            PG8_LDA(At, 0, 1); PG8_STAGE(PG8_SB(0, 0), b2, voffB); PG8_STAGE(PG8_SB(0, 1), b2 + hstepB, voffB); PG8_STAGE(PG8_SA(0, 0), a2, voffA);
            PG8_WAIT_V(8); PG8_WAIT_L(0); PG8_BAR; PG8_MMA(1, 0, At, B0); PG8_MMA(1, 1, At, B1); PG8_BAR; PG8_SCHED;
            PG8_LDB(B0, 1, 0); PG8_LDB(B1, 1, 1); PG8_SCHED; PG8_LDA(At, 1, 0); PG8_STAGE(PG8_SA(0, 1), a2 + hstepA, voffA);
            PG8_WAIT_V(8); PG8_WAIT_L(0); PG8_BAR; PG8_MMA(0, 0, At, B0); PG8_MMA(0, 1, At, B1); PG8_BAR; PG8_SCHED;
            PG8_LDA(At, 1, 1); PG8_STAGE(PG8_SB(1, 0), b3, voffB); PG8_STAGE(PG8_SB(1, 1), b3 + hstepB, voffB); PG8_STAGE(PG8_SA(1, 0), a3, voffA);
            PG8_WAIT_V(8); PG8_WAIT_L(0); PG8_BAR; PG8_MMA(1, 0, At, B0); PG8_MMA(1, 1, At, B1); PG8_BAR; PG8_SCHED;
            } else {
            PG8_LDB(B0, 0, 0); PG8_SCHED; PG8_LDA(At, 0, 0); PG8_STAGE(PG8_SA(1, 1), a1 + hstepA, voffA);
            PG8_WAIT_L(8); PG8_BAR; PG8_WAIT_L(0); PG8_MMA(0, 0, At, B0); PG8_BAR; PG8_SCHED;
            PG8_LDB(B1, 0, 1); PG8_STAGE(PG8_SB(0, 0), b2, voffB);
            PG8_BAR; PG8_WAIT_L(0); PG8_MMA(0, 1, At, B1); PG8_BAR;
            PG8_LDA(At, 0, 1); PG8_STAGE(PG8_SA(0, 0), a2, voffA);
            PG8_BAR; PG8_WAIT_L(0); PG8_MMA(1, 0, At, B0); PG8_BAR; PG8_SCHED;
            PG8_STAGE(PG8_SB(0, 1), b2 + hstepB, voffB);
            PG8_WAIT_V(6); PG8_BAR; PG8_MMA(1, 1, At, B1); PG8_BAR;
            PG8_LDB(B0, 1, 0); PG8_SCHED; PG8_LDA(At, 1, 0); PG8_STAGE(PG8_SA(0, 1), a2 + hstepA, voffA);
            PG8_WAIT_L(8); PG8_BAR; PG8_WAIT_L(0); PG8_MMA(0, 0, At, B0); PG8_BAR; PG8_SCHED;
            PG8_LDB(B1, 1, 1); PG8_STAGE(PG8_SB(1, 0), b3, voffB);
            PG8_BAR; PG8_WAIT_L(0); PG8_MMA(0, 1, At, B1); PG8_BAR;
            PG8_LDA(At, 1, 1); PG8_STAGE(PG8_SA(1, 0), a3, voffA);
            PG8_BAR; PG8_WAIT_L(0); PG8_MMA(1, 0, At, B0); PG8_BAR; PG8_SCHED;
            PG8_STAGE(PG8_SB(1, 1), b3 + hstepB, voffB);
            PG8_WAIT_V(6); PG8_BAR; PG8_MMA(1, 1, At, B1); PG8_BAR;
            }
        }
        if constexpr (ALIGN_EPI) { if (wr == 0) PG8_BAR; }
        E(acc, cur, wr, wc, fr, fq);
        if (!has_next) break;
#pragma unroll
        for (int a = 0; a < 2; ++a)
#pragma unroll
            for (int b = 0; b < 2; ++b)
#pragma unroll
                for (int m = 0; m < 4; ++m)
#pragma unroll
                    for (int n = 0; n < 2; ++n) acc[a][b][m][n] = (f32x4){0.f, 0.f, 0.f, 0.f};
        cur = nxt; cA = nA; cB = nB; ++ui;
        if constexpr (ALIGN_EPI) { if (wr == 1) PG8_BAR; }
    }
    PG8_WAIT_V(0);
    if constexpr (!ALIGN_EPI) { if (wr == 0) PG8_BAR; }
    PG8_BAR;
#undef PG8_SA
#undef PG8_SB
#undef PG8_STAGE
#undef PG8_LDA
#undef PG8_LDB
#undef PG8_MMA
#undef PG8_WAIT_V
#undef PG8_WAIT_L
#undef PG8_BAR
#undef PG8_SCHED
}
}
using pg8::Unit;

#define XB_TMO      128
#define XB_XCNT(j)  (256  + 64 * (j))
#define XB_XSUB(j)  (1280 + 64 * (j))
#define XB_XGEN(j)  (2304 + 64 * (j))
#define XB_TOP      3328
#define XB_TOPGEN   3392
#define XCD_BAR_WORDS 3456
#define XB_SPIN_CAP (1u << 18)

__device__ __forceinline__ unsigned xb_ld(unsigned* p)              { return __hip_atomic_load(p, __ATOMIC_RELAXED, __HIP_MEMORY_SCOPE_AGENT); }
__device__ __forceinline__ unsigned xb_add(unsigned* p, unsigned v) { return __hip_atomic_fetch_add(p, v, __ATOMIC_RELAXED, __HIP_MEMORY_SCOPE_AGENT); }
__device__ __forceinline__ unsigned xb_xcc_id() { return (unsigned)__builtin_amdgcn_s_getreg((3 << 11) | 20) & 0xFu; }
#define XB_SPIN(cond, bar) do { unsigned _sp = 0; while (cond) { __builtin_amdgcn_s_sleep(1); \
    if ((++_sp & 255u) == 0u) { if (xb_ld(&(bar)[XB_TMO])) break; if (_sp > XB_SPIN_CAP) { atomicAdd(&(bar)[XB_TMO], 1u); break; } } } } while (0)

struct XcdBarrier { unsigned* bar; unsigned x; volatile LAS unsigned* st; };

__device__ __forceinline__ XcdBarrier xcd_barrier_post(unsigned* bar, volatile LAS unsigned* st) {
    XcdBarrier b; b.bar = bar; b.x = xb_xcc_id(); b.st = st;
    if (threadIdx.x == 0) (void)xb_add(&bar[XB_XCNT(b.x)], 1u);
    return b;
}
__device__ __forceinline__ void xcd_barrier_complete(unsigned* bar, unsigned x, unsigned& nloc, unsigned& nx) {
    const unsigned G = gridDim.x * gridDim.y * gridDim.z;
    unsigned sum, cnt, mine, sp = 0u;
    for (;;) {
        sum = 0u; cnt = 0u; mine = 0u;
#pragma unroll
        for (unsigned j = 0; j < 16; ++j) { const unsigned c = xb_ld(&bar[XB_XCNT(j)]); sum += c; cnt += (c > 0u) ? 1u : 0u; mine = (j == x) ? c : mine; }
        if (sum == G) break;
        __builtin_amdgcn_s_sleep(1);
        if ((++sp & 255u) == 0u) { if (xb_ld(&bar[XB_TMO])) break; if (sp > XB_SPIN_CAP) { atomicAdd(&bar[XB_TMO], 1u); break; } }
    }
    nloc = mine > 0u ? mine : 1u; nx = cnt > 0u ? cnt : 1u;
}
__device__ __forceinline__ void xcd_barrier(const XcdBarrier& b) {
    asm volatile("s_waitcnt vmcnt(0)" ::: "memory");
    __syncthreads();
    if (threadIdx.x == 0) {
        unsigned* bar = b.bar;
        __builtin_amdgcn_s_waitcnt(0);
        unsigned nloc = b.st[0], nx = b.st[1];
        if (nloc == 0u) { xcd_barrier_complete(bar, b.x, nloc, nx); b.st[0] = nloc; b.st[1] = nx; }
        const unsigned old = xb_add(&bar[XB_XSUB(b.x)], 1u);
        const unsigned gen = old / nloc;
        if (old + 1u == (gen + 1u) * nloc) {
            __builtin_amdgcn_fence(__ATOMIC_RELEASE, "agent");
            asm volatile("s_waitcnt vmcnt(0)" ::: "memory");
            const unsigned og = xb_add(&bar[XB_TOP], 1u);
            const unsigned tg = og / nx;
            if (og + 1u == (tg + 1u) * nx) xb_add(&bar[XB_TOPGEN], 1u);
            else XB_SPIN(xb_ld(&bar[XB_TOPGEN]) == tg, bar);
            __builtin_amdgcn_fence(__ATOMIC_ACQUIRE, "agent");
            xb_add(&bar[XB_XGEN(b.x)], 1u);
            asm volatile("s_waitcnt vmcnt(0)" ::: "memory");
        } else {
            XB_SPIN(xb_ld(&bar[XB_XGEN(b.x)]) == gen, bar);
            __builtin_amdgcn_fence(__ATOMIC_ACQUIRE, "agent");
            asm volatile("s_waitcnt vmcnt(0)" ::: "memory");
        }
    }
    __syncthreads();
}

struct Params {
    const float *x, *mem, *w_in, *b_in, *conv_w, *mh_norm_w, *w_mem_kv, *w_proj_m, *w_proj_c, *w_proj_x, *w_out, *ln_w, *ln_b;
    float* out; unsigned char* ws;
    int ph_lo, ph_hi;
};

__device__ __forceinline__ void transpose_item(const float* src, size_t src_ld, int col0, int ncv, bf16_t* dst, size_t dst_ld, int n0, int k0, LAS unsigned* scr, int lane) {
    const float* sp = src + (size_t)k0 * src_ld + col0 + lane;
    if (ncv > 0) {
#pragma unroll 8
        for (int i = 0; i < 32; ++i) {
            float a = 0.f, b = 0.f;
            if (lane < ncv) { a = sp[(size_t)(2 * i) * src_ld]; b = sp[(size_t)(2 * i + 1) * src_ld]; }
            scr[i * 65 + lane] = cvt_pk_bf16(a, b);
        }
    } else {
#pragma unroll 8
        for (int i = 0; i < 32; ++i) scr[i * 65 + lane] = 0u;
    }
    LDS_WAIT(); asm volatile("" ::: "memory");
    const int c = lane & 7;
#pragma unroll
    for (int j = 0; j < 8; ++j) {
        const int n = (lane >> 3) + 8 * j; const LAS unsigned* s = scr + (4 * c) * 65 + n;
        u32x4 o; o.x = s[0]; o.y = s[65]; o.z = s[130]; o.w = s[195];
        *(u32x4*)(dst + (size_t)(n0 + n) * dst_ld + k0 + 8 * c) = o;
    }
    LDS_WAIT(); asm volatile("" ::: "memory");
}
__device__ __forceinline__ void cvt_row(const float* src, bf16_t* dst, int lane) {
    const f32x4* s = (const f32x4*)src + lane; u32x2* d = (u32x2*)dst + lane;
#pragma unroll
    for (int j = 0; j < 16; ++j) { const f32x4 v = s[64 * j]; u32x2 o; o.x = cvt_pk_bf16(v.x, v.y); o.y = cvt_pk_bf16(v.z, v.w); d[64 * j] = o; }
}
__device__ __forceinline__ void p0_prologue(const Params& p, LAS unsigned char* lds, int gw, int NGW, int wave, int lane) {
    LAS unsigned* scr = (LAS unsigned*)(lds + wave * 8448);
    unsigned char* ws = p.ws;
    bf16_t* WINT = (bf16_t*)(ws + WS_WINT); bf16_t* WKVT = (bf16_t*)(ws + WS_WKVT); bf16_t* WPMT = (bf16_t*)(ws + WS_WPMT);
    bf16_t* WPCXT = (bf16_t*)(ws + WS_WPCXT); bf16_t* WOT = (bf16_t*)(ws + WS_WOT);
    constexpr int I_IN = 64 * 644, I_KV = 64 * 64, I_PM = 64 * 64, I_PC = 32 * 64, I_PX = 32 * 64, I_O = 64 * 64;
    constexpr int NITEMS = I_IN + I_KV + I_PM + I_PC + I_PX + I_O;
    for (int it = gw; it < NITEMS; it += NGW) {
        int r = it;
        if (r < I_IN) { const int kb = r / 644, nb = r % 644, n0 = nb * 64; int col0, ncv;
            if (n0 < 16384) { col0 = n0; ncv = 64; } else if (n0 < 40960) { col0 = n0 + 16; ncv = 64; } else if (n0 == 40960) { col0 = 16384; ncv = 16; } else { col0 = 0; ncv = 0; }
            transpose_item(p.w_in, DIN, col0, ncv, WINT, D, n0, kb * 64, scr, lane); continue; }
        r -= I_IN;
        if (r < I_KV) { transpose_item(p.w_mem_kv, 4096, (r % 64) * 64, 64, WKVT, 4096, (r % 64) * 64, (r / 64) * 64, scr, lane); continue; }
        r -= I_KV;
        if (r < I_PM) { transpose_item(p.w_proj_m, 4096, (r % 64) * 64, 64, WPMT, 4096, (r % 64) * 64, (r / 64) * 64, scr, lane); continue; }
        r -= I_PM;
        if (r < I_PC) { transpose_item(p.w_proj_c, 4096, (r % 64) * 64, 64, WPCXT, 4096, (r % 64) * 64, (r / 64) * 64, scr, lane); continue; }
        r -= I_PC;
        if (r < I_PX) { transpose_item(p.w_proj_x, 4096, (r % 64) * 64, 64, WPCXT + 2048, 4096, (r % 64) * 64, (r / 64) * 64, scr, lane); continue; }
        r -= I_PX;
        transpose_item(p.w_out, 4096, (r % 64) * 64, 64, WOT, 4096, (r % 64) * 64, (r / 64) * 64, scr, lane);
    }
    bf16_t* XB = (bf16_t*)(ws + WS_XB); bf16_t* MEMB = (bf16_t*)(ws + WS_MEMB);
    for (int m = gw; m < T; m += NGW) cvt_row(p.x + (size_t)m * D, XB + (size_t)m * D, lane);
    for (int m = gw; m < TM; m += NGW) cvt_row(p.mem + (size_t)m * D, MEMB + (size_t)m * D, lane);
    float* BU = (float*)(ws + WS_BU);
    for (int c = gw * 64 + lane; c < NU; c += NGW * 64) {
        float v = 0.f;
        if (c < 16384) v = p.b_in[c]; else if (c < 40960) v = p.b_in[c + 16]; else if (c < 40976) v = p.b_in[16384 + (c - 40960)];
        BU[c] = v;
    }
}

__device__ __forceinline__ int act_of(int c0) {
    if (c0 >= UO && c0 < UZ) return 1;
    if (c0 >= UZ && c0 < UCB) return 2;
    if (c0 >= UCZ && c0 < UXQ) return 2;
    if (c0 >= UXZ && c0 < UG) return 2;
    if (c0 >= UG && c0 < UI) return 1;
    return 0;
}
struct SchedP1 {
    int G, c; const char *xb, *memb, *wint, *wkvt;
    __device__ __forceinline__ bool next(int i, Unit& u) const {
        long L = (long)i * G + c;
        if (L < 5152) { pg8::tile_map(L, 32, 161, u.pm, u.pn); u.A = xb + (size_t)u.pm * 256 * 8192; u.B = wint + (size_t)u.pn * 256 * 8192; u.nt = 64; u.kind = 0; return true; }
        L -= 5152;
        if (L < 32) { u.pm = (int)L / 8; u.pn = (int)L % 8; u.A = memb + (size_t)u.pm * 256 * 8192; u.B = wkvt + (size_t)u.pn * 256 * 8192; u.nt = 64; u.kind = 1; return true; }
        L -= 32;
        if (L < 32) { u.pm = (int)L / 4; u.pn = (int)L % 4; u.A = wkvt + (size_t)(2048 + u.pm * 256) * 8192; u.B = memb + (size_t)u.pn * 256 * 8192; u.nt = 64; u.kind = 2; return true; }
        return false;
    }
};
struct EpiP1 {
    static constexpr bool PERM = true;
    bf16_t* U; const float* bU; bf16_t* KMEM; bf16_t* VT;
    __device__ __forceinline__ void operator()(const f32x4 (&acc)[2][2][4][2], const Unit& u, int wr, int wc, int fr, int fq) const {
        asm volatile("" : "+v"(fr), "+v"(fq));
        bf16_t* base; int ldc; const float* bias; int act = 0; float sc = 1.f;
        if (u.kind == 0) { const int c0 = u.pn * 256; base = U + (size_t)u.pm * 256 * NU + c0; ldc = NU; bias = bU + c0; act = act_of(c0); if (c0 < UK) sc = 0.0625f; }
        else if (u.kind == 1) { base = KMEM + (size_t)u.pm * 256 * 2048 + u.pn * 256; ldc = 2048; bias = nullptr; }
        else { base = VT + (size_t)u.pm * 256 * 1024 + u.pn * 256; ldc = 1024; bias = nullptr; }
        const int row0 = wr * 64 + fr, col0 = wc * 32 + 8 * fq;
        f32x4 bv[2][2];
#pragma unroll
        for (int bj = 0; bj < 2; ++bj)
#pragma unroll
            for (int n = 0; n < 2; ++n) bv[bj][n] = bias ? *(const f32x4*)(bias + col0 + bj * 128 + 4 * n) : (f32x4){0.f, 0.f, 0.f, 0.f};
#pragma unroll
        for (int ai = 0; ai < 2; ++ai)
#pragma unroll
            for (int m = 0; m < 4; ++m) { bf16_t* rowp = base + (size_t)(row0 + ai * 128 + m * 16) * ldc + col0;
#pragma unroll
                for (int bj = 0; bj < 2; ++bj) { f32x4 v0 = acc[ai][bj][m][0] + bv[bj][0], v1 = acc[ai][bj][m][1] + bv[bj][1];
                    if (act) {
#pragma unroll
                        for (int j = 0; j < 4; ++j) { const float s0 = sigmoidf_(v0[j]), s1 = sigmoidf_(v1[j]); v0[j] = (act == 1) ? s0 : v0[j] * s0; v1[j] = (act == 1) ? s1 : v1[j] * s1; } }
                    v0 = v0 * sc; v1 = v1 * sc;
                    u32x4 w; w.x = cvt_pk_bf16(v0[0], v0[1]); w.y = cvt_pk_bf16(v0[2], v0[3]); w.z = cvt_pk_bf16(v1[0], v1[1]); w.w = cvt_pk_bf16(v1[2], v1[3]);
                    *(u32x4*)(rowp + bj * 128) = w; } }
    }
};
struct SchedQK {
    int G, c; const char *u, *kmem;
    __device__ __forceinline__ bool next(int i, Unit& un) const {
        const int L = i * G + c; if (L >= 128) return false;
        const int head = L & 3, rt = L >> 2;
        un.pm = rt; un.pn = head; un.A = u + ((size_t)rt * 256 * NU + UXQ + head * 512) * 2; un.B = kmem + ((size_t)(rt >> 3) * 256 * 2048 + head * 512) * 2; un.nt = 8; un.kind = 0; return true;
    }
};
struct EpiSC {
    static constexpr bool PERM = false;
    float* SC;
    __device__ __forceinline__ void operator()(const f32x4 (&acc)[2][2][4][2], const Unit& u, int wr, int wc, int fr, int fq) const {
        asm volatile("" : "+v"(fr), "+v"(fq));
        const float sc = 0.04419417382415922f;
        float* base = SC + (size_t)u.pm * 256 * 1024 + u.pn * 256;
        const int row0 = wr * 64 + fr, col0 = wc * 32 + 4 * fq;
#pragma unroll
        for (int ai = 0; ai < 2; ++ai)
#pragma unroll
            for (int m = 0; m < 4; ++m) { float* rowp = base + (size_t)(row0 + ai * 128 + m * 16) * 1024 + col0;
#pragma unroll
                for (int bj = 0; bj < 2; ++bj)
#pragma unroll
                    for (int n = 0; n < 2; ++n) *(f32x4*)(rowp + bj * 128 + n * 16) = acc[ai][bj][m][n] * sc; }
    }
};
struct SchedPV {
    int G, c; const char *pb, *vt;
    __device__ __forceinline__ bool next(int i, Unit& un) const {
        const int L = i * G + c; if (L >= 256) return false;
        const int n2 = L & 1, head = (L >> 1) & 3, rt = L >> 3;
        un.pm = rt; un.pn = head * 2 + n2; un.A = pb + ((size_t)rt * 256 * 1024 + head * 256) * 2; un.B = vt + ((size_t)(head * 512 + n2 * 256) * 1024 + (rt >> 3) * 256) * 2; un.nt = 4; un.kind = 0; return true;
    }
};
struct EpiPV {
    static constexpr bool PERM = true;
    const bf16_t* U; bf16_t* YCX;
    __device__ __forceinline__ void operator()(const f32x4 (&acc)[2][2][4][2], const Unit& u, int wr, int wc, int fr, int fq) const {
        asm volatile("" : "+v"(fr), "+v"(fq));
        const bf16_t* zb = U + (size_t)u.pm * 256 * NU + UXZ + u.pn * 256;
        bf16_t* ob = YCX + (size_t)u.pm * 256 * 4096 + 2048 + u.pn * 256;
        const int row0 = wr * 64 + fr, col0 = wc * 32 + 8 * fq;
#pragma unroll
        for (int ai = 0; ai < 2; ++ai)
#pragma unroll
            for (int m = 0; m < 4; ++m) { const size_t r = (size_t)(row0 + ai * 128 + m * 16);
#pragma unroll
                for (int bj = 0; bj < 2; ++bj) { const u32x4 z = *(const u32x4*)(zb + r * NU + col0 + bj * 128);
                    const f32x4 v0 = acc[ai][bj][m][0], v1 = acc[ai][bj][m][1];
                    u32x4 w; w.x = cvt_pk_bf16(v0[0] * bf_lo(z.x), v0[1] * bf_hi(z.x)); w.y = cvt_pk_bf16(v0[2] * bf_lo(z.y), v0[3] * bf_hi(z.y));
                    w.z = cvt_pk_bf16(v1[0] * bf_lo(z.z), v1[1] * bf_hi(z.z)); w.w = cvt_pk_bf16(v1[2] * bf_lo(z.w), v1[3] * bf_hi(z.w));
                    *(u32x4*)(ob + r * 4096 + col0 + bj * 128) = w; }
                asm volatile("" ::: "memory"); }
    }
};
struct SchedMerge {
    int G, c; const char *ym, *ycx, *wpmt, *wpcxt;
    __device__ __forceinline__ bool next(int i, Unit& u) const {
        const int r = i / 3, br = i - 3 * r;
        if (!pg8::tile_map((long)r * G + c, 32, 16, u.pm, u.pn)) return false;
        u.kind = br;
        if (br == 0) { u.A = ym + (size_t)u.pm * 256 * 8192; u.B = wpmt + (size_t)u.pn * 256 * 8192; u.nt = 64; }
        else { u.A = ycx + (size_t)u.pm * 256 * 8192 + (br == 2 ? 4096 : 0); u.B = wpcxt + (size_t)u.pn * 256 * 8192 + (br == 2 ? 4096 : 0); u.nt = 32; }
        return true;
    }
};
struct EpiMerge {
    static constexpr bool PERM = false;
    const bf16_t* U; float* scr; bf16_t* MERGED;
    __device__ __forceinline__ void operator()(const f32x4 (&acc)[2][2][4][2], const Unit& u, int wr, int wc, int fr, int fq) const {
        asm volatile("" : "+v"(fr), "+v"(fq));
        const int br = u.kind;
        const bf16_t* gb = U + (size_t)u.pm * 256 * NU + UG + br * 4096 + u.pn * 256;
        const size_t ob = (size_t)u.pm * 256 * 4096 + u.pn * 256;
        const int row0 = wr * 64 + fr, col0 = wc * 32 + 4 * fq;
#pragma unroll
        for (int ai = 0; ai < 2; ++ai)
#pragma unroll
            for (int m = 0; m < 4; ++m) { const size_t r = (size_t)(row0 + ai * 128 + m * 16);
#pragma unroll
                for (int bj = 0; bj < 2; ++bj)
#pragma unroll
                    for (int n = 0; n < 2; ++n) { const int cc = col0 + bj * 128 + n * 16;
                        const u32x2 g = *(const u32x2*)(gb + r * NU + cc);
                        f32x4 v = acc[ai][bj][m][n]; v[0] *= bf_lo(g.x); v[1] *= bf_hi(g.x); v[2] *= bf_lo(g.y); v[3] *= bf_hi(g.y);
                        float* sp = scr + ob + r * 4096 + cc;
                        if (br != 0) v = v + *(const f32x4*)sp;
                        if (br != 2) *(f32x4*)sp = v;
                        else { u32x2 w; w.x = cvt_pk_bf16(v[0], v[1]); w.y = cvt_pk_bf16(v[2], v[3]); *(u32x2*)(MERGED + ob + r * 4096 + cc) = w; } }
                asm volatile("" ::: "memory"); }
    }
};
struct SchedOut {
    int G, c; const char *merged, *wot;
    __device__ __forceinline__ bool next(int i, Unit& u) const {
        if (!pg8::tile_map((long)i * G + c, 32, 16, u.pm, u.pn)) return false;
        u.A = merged + (size_t)u.pm * 256 * 8192; u.B = wot + (size_t)u.pn * 256 * 8192; u.nt = 64; u.kind = 0; return true;
    }
};
struct EpiOut {
    static constexpr bool PERM = false;
    const float* x; float* out;
    __device__ __forceinline__ void operator()(const f32x4 (&acc)[2][2][4][2], const Unit& u, int wr, int wc, int fr, int fq) const {
        asm volatile("" : "+v"(fr), "+v"(fq));
        const size_t ob = (size_t)u.pm * 256 * 4096 + u.pn * 256;
        const int row0 = wr * 64 + fr, col0 = wc * 32 + 4 * fq;
#pragma unroll
        for (int ai = 0; ai < 2; ++ai)
#pragma unroll
            for (int m = 0; m < 4; ++m) { const size_t r = (size_t)(row0 + ai * 128 + m * 16);
#pragma unroll
                for (int bj = 0; bj < 2; ++bj)
#pragma unroll
                    for (int n = 0; n < 2; ++n) { const size_t o = ob + r * 4096 + col0 + bj * 128 + n * 16;
                        const f32x4 xv = *(const f32x4*)(x + o);
                        *(f32x4*)(out + o) = xv * DN_ALPHA + acc[ai][bj][m][n]; }
                asm volatile("" ::: "memory"); }
    }
};

__device__ __forceinline__ void conv_phase(const Params& p, int gtid, int NGT) {
    const bf16_t* U = (const bf16_t*)(p.ws + WS_U); bf16_t* YCX = (bf16_t*)(p.ws + WS_YCX);
    for (int idx = gtid; idx < T * 256; idx += NGT) {
        const int t = idx >> 8, c = (idx & 255) * 8, tl = t & (SEQ - 1);
        const bf16_t* row = U + (size_t)t * NU;
        const u32x4 cb = *(const u32x4*)(row + UCB + c), cz = *(const u32x4*)(row + UCZ + c);
        const unsigned cbw[4] = {cb.x, cb.y, cb.z, cb.w}, czw[4] = {cz.x, cz.y, cz.z, cz.w};
        float accv[8];
#pragma unroll
        for (int j = 0; j < 8; ++j) accv[j] = 0.f;
#pragma unroll
        for (int w = 0; w < 3; ++w) {
            const int dt = 2 - w;
            if (tl >= dt) {
                const bf16_t* r2 = row - (size_t)dt * NU;
                const u32x4 a = *(const u32x4*)(r2 + UCC + c), b = *(const u32x4*)(r2 + UCX + c);
                const unsigned aw[4] = {a.x, a.y, a.z, a.w}, bw[4] = {b.x, b.y, b.z, b.w};
                const f32x4 w0 = *(const f32x4*)(p.conv_w + w * 2048 + c), w1 = *(const f32x4*)(p.conv_w + w * 2048 + c + 4);
                const float wv[8] = {w0[0], w0[1], w0[2], w0[3], w1[0], w1[1], w1[2], w1[3]};
#pragma unroll
                for (int j = 0; j < 4; ++j) { accv[2 * j] += wv[2 * j] * (bf_lo(aw[j]) * bf_lo(bw[j])); accv[2 * j + 1] += wv[2 * j + 1] * (bf_hi(aw[j]) * bf_hi(bw[j])); }
            }
        }
        u32x4 o; unsigned ow[4];
#pragma unroll
        for (int j = 0; j < 4; ++j) ow[j] = cvt_pk_bf16(bf_lo(cbw[j]) * accv[2 * j] * bf_lo(czw[j]), bf_hi(cbw[j]) * accv[2 * j + 1] * bf_hi(czw[j]));
        o.x = ow[0]; o.y = ow[1]; o.z = ow[2]; o.w = ow[3];
        *(u32x4*)(YCX + (size_t)t * 4096 + c) = o;
    }
}
__device__ __forceinline__ void softmax_phase(const Params& p, int gw, int NGW, int lane) {
    const float* SC = (const float*)(p.ws + WS_SC); bf16_t* PB = (bf16_t*)(p.ws + WS_PB);
    for (int it = gw; it < T * 4; it += NGW) {
        const f32x4 s = *(const f32x4*)(SC + (size_t)it * 256 + 4 * lane);
        const float mx = wave_max(fmaxf(fmaxf(s[0], s[1]), fmaxf(s[2], s[3])));
        const float e0 = __expf(s[0] - mx), e1 = __expf(s[1] - mx), e2 = __expf(s[2] - mx), e3 = __expf(s[3] - mx);
        const float inv = 1.0f / wave_sum((e0 + e1) + (e2 + e3));
        u32x2 o; o.x = cvt_pk_bf16(e0 * inv, e1 * inv); o.y = cvt_pk_bf16(e2 * inv, e3 * inv);
        *(u32x2*)(PB + (size_t)it * 256 + 4 * lane) = o;
    }
}
__device__ __forceinline__ void ym_phase(const Params& p, int gw, int NGW, int lane) {
    const bf16_t* U = (const bf16_t*)(p.ws + WS_U); const bf16_t* HR = (const bf16_t*)(p.ws + WS_HRAW); bf16_t* YM = (bf16_t*)(p.ws + WS_YM);
    for (int it = gw; it < T * 8; it += NGW) {
        const int t = it >> 3, h = it & 7, c = h * 512 + 8 * lane;
        const u32x4 hv = *(const u32x4*)(HR + (size_t)t * 4096 + c);
        const u32x4 mo = *(const u32x4*)(U + (size_t)t * NU + UO + c), mz = *(const u32x4*)(U + (size_t)t * NU + UZ + c);
        const f32x4 w0 = *(const f32x4*)(p.mh_norm_w + c), w1 = *(const f32x4*)(p.mh_norm_w + c + 4);
        float v[8] = {bf_lo(hv.x), bf_hi(hv.x), bf_lo(hv.y), bf_hi(hv.y), bf_lo(hv.z), bf_hi(hv.z), bf_lo(hv.w), bf_hi(hv.w)};
        float s = 0.f;
#pragma unroll
        for (int j = 0; j < 8; ++j) s += v[j];
        const float mean = wave_sum(s) * (1.0f / 512.0f);
        float q = 0.f;
#pragma unroll
        for (int j = 0; j < 8; ++j) { v[j] -= mean; q += v[j] * v[j]; }
        const float rstd = 1.0f / sqrtf(wave_sum(q) * (1.0f / 512.0f) + LN_EPS);
        const float g[8] = {bf_lo(mo.x) * bf_lo(mz.x), bf_hi(mo.x) * bf_hi(mz.x), bf_lo(mo.y) * bf_lo(mz.y), bf_hi(mo.y) * bf_hi(mz.y),
                            bf_lo(mo.z) * bf_lo(mz.z), bf_hi(mo.z) * bf_hi(mz.z), bf_lo(mo.w) * bf_lo(mz.w), bf_hi(mo.w) * bf_hi(mz.w)};
        const float wv[8] = {w0[0], w0[1], w0[2], w0[3], w1[0], w1[1], w1[2], w1[3]};
        u32x4 o; unsigned ow[4];
#pragma unroll
        for (int j = 0; j < 4; ++j) ow[j] = cvt_pk_bf16(v[2 * j] * rstd * wv[2 * j] * g[2 * j], v[2 * j + 1] * rstd * wv[2 * j + 1] * g[2 * j + 1]);
        o.x = ow[0]; o.y = ow[1]; o.z = ow[2]; o.w = ow[3];
        *(u32x4*)(YM + (size_t)t * 4096 + c) = o;
    }
}
__device__ __forceinline__ void ln_phase(const Params& p, int gw, int NGW, int lane) {
    for (int m = gw; m < T; m += NGW) {
        f32x4* r = (f32x4*)(p.out + (size_t)m * D) + lane;
        f32x4 v[16]; float s = 0.f;
#pragma unroll
        for (int j = 0; j < 16; ++j) { v[j] = r[64 * j]; s += (v[j][0] + v[j][1]) + (v[j][2] + v[j][3]); }
        const float mean = wave_sum(s) * (1.0f / D); float q = 0.f;
#pragma unroll
        for (int j = 0; j < 16; ++j) { v[j] = v[j] - mean; q += (v[j][0] * v[j][0] + v[j][1] * v[j][1]) + (v[j][2] * v[j][2] + v[j][3] * v[j][3]); }
        const float rstd = 1.0f / sqrtf(wave_sum(q) * (1.0f / D) + LN_EPS);
#pragma unroll
        for (int j = 0; j < 16; ++j) { const f32x4 w = *((const f32x4*)p.ln_w + lane + 64 * j), b = *((const f32x4*)p.ln_b + lane + 64 * j); r[64 * j] = v[j] * rstd * w + b; }
    }
}

__device__ __forceinline__ void mlstm_naive(const Params& p, LAS unsigned char* lds, int unit, int wave, int lane) {
    const int s = unit & 7, h = (unit >> 3) & 7, b = unit >> 6;
    LAS float* part = (LAS float*)lds;
    LAS float* pden = part + 2 * 8 * 64;
    const bf16_t* Ub = (const bf16_t*)(p.ws + WS_U) + (size_t)(b * SEQ) * NU;
    bf16_t* HR = (bf16_t*)(p.ws + WS_HRAW) + (size_t)(b * SEQ) * 4096 + h * 512 + s * 64 + lane;
    float C[32], n[32];
#pragma unroll
    for (int d = 0; d < 32; ++d) { C[d] = 0.f; n[d] = 0.f; }
    float m = 0.f;
    for (int t = 0; t < SEQ; ++t) {
        const bf16_t* row = Ub + (size_t)t * NU;
        u32x4 kk[4], qq[4];
#pragma unroll
        for (int j = 0; j < 4; ++j) { kk[j] = *(const u32x4*)(row + UK + h * 256 + wave * 32 + 8 * j); qq[j] = *(const u32x4*)(row + UQ + h * 256 + wave * 32 + 8 * j); }
        const float vv = bf2f(row[UV + h * 512 + s * 64 + lane]);
        const float ig = bf2f(row[UI + h]), fp = bf2f(row[UF + h]);
        const float lf = fminf(fp, 0.f) - log1pf(__expf(-fabsf(fp)));
        const float mn = fmaxf(lf + m, ig), fd = __expf(lf + m - mn), iw = __expf(ig - mn);
        m = mn;
        float num = 0.f, den = 0.f;
#pragma unroll
        for (int j = 0; j < 4; ++j) {
            const unsigned kw[4] = {kk[j].x, kk[j].y, kk[j].z, kk[j].w}, qw[4] = {qq[j].x, qq[j].y, qq[j].z, qq[j].w};
#pragma unroll
            for (int e = 0; e < 4; ++e) {
                const int d = 8 * j + 2 * e;
                const float k0 = iw * bf_lo(kw[e]), k1 = iw * bf_hi(kw[e]), q0 = bf_lo(qw[e]), q1 = bf_hi(qw[e]);
                C[d] = fd * C[d] + k0 * vv; n[d] = fd * n[d] + k0; num += q0 * C[d]; den += q0 * n[d];
                C[d + 1] = fd * C[d + 1] + k1 * vv; n[d + 1] = fd * n[d + 1] + k1; num += q1 * C[d + 1]; den += q1 * n[d + 1];
            }
        }
        const int buf = t & 1;
        part[(buf * 8 + wave) * 64 + lane] = num; if (lane == 0) pden[buf * 8 + wave] = den;
        __syncthreads();
        if (wave == (t & 7)) {
            float nt_ = 0.f, dt_ = 0.f;
#pragma unroll
            for (int w = 0; w < 8; ++w) { nt_ += part[(buf * 8 + w) * 64 + lane]; dt_ += pden[buf * 8 + w]; }
            const float hv = nt_ / fmaxf(fabsf(dt_), __expf(-m));
            HR[(size_t)t * 4096] = (bf16_t)(cvt_pk_bf16(hv, 0.f) & 0xffffu);
        }
    }
    __syncthreads();
}

__global__ void __launch_bounds__(NWAVES * 64, 2) mk_fwd(Params p) {
    extern __shared__ __attribute__((aligned(16))) unsigned char lds_raw[];
    LAS unsigned char* lds = (LAS unsigned char*)lds_raw;
    volatile LAS unsigned* MISC = (volatile LAS unsigned*)(lds + MISC_OFF);
    const int tid = threadIdx.x, lane = tid & 63, wave = __builtin_amdgcn_readfirstlane(tid >> 6);
    const int G = gridDim.x, bx = blockIdx.x;
    const int vcu = (G % 8 == 0) ? (bx % 8) * (G / 8) + bx / 8 : bx;
    const int gw = vcu * NWAVES + wave, NGW = G * NWAVES;
    unsigned char* ws = p.ws;
    unsigned* ctl = (unsigned*)(ws + WS_CTL);
    for (int u = tid; u < (LDS_BYTES - LDSCTL_OFF) / 4; u += NWAVES * 64) ((LAS unsigned*)(lds + LDSCTL_OFF))[u] = 0u;
    __syncthreads();
    const bool one_launch = (p.ph_lo == 0 && p.ph_hi >= 8);
    XcdBarrier bar; bar.bar = ctl + CW_BAR; bar.x = 0; bar.st = nullptr;
    if (one_launch) bar = xcd_barrier_post(ctl + CW_BAR, MISC + 8);
    const int lo = p.ph_lo, hi = p.ph_hi;
#define IN(k) (lo <= (k) && (k) < hi)
#define GRID_BAR() do { if (one_launch) xcd_barrier(bar); } while (0)

    if (IN(0)) { p0_prologue(p, lds, gw, NGW, wave, lane); GRID_BAR(); }
    if (IN(1)) {
        SchedP1 S{G, bx, (const char*)(ws + WS_XB), (const char*)(ws + WS_MEMB), (const char*)(ws + WS_WINT), (const char*)(ws + WS_WKVT)};
        EpiP1 E{(bf16_t*)(ws + WS_U), (const float*)(ws + WS_BU), (bf16_t*)(ws + WS_KMEM), (bf16_t*)(ws + WS_VT)};
        pg8::gemm_phase<EpiP1, SchedP1, true, true>(lds, 8192, 8192, S, E);
        GRID_BAR();
    }
    if (IN(2)) {
        { SchedQK S{G, bx, (const char*)(ws + WS_U), (const char*)(ws + WS_KMEM)}; EpiSC E{(float*)(ws + WS_SC)};
          pg8::gemm_phase<EpiSC, SchedQK, true, true>(lds, NU * 2, 4096, S, E); }
        conv_phase(p, vcu * (NWAVES * 64) + tid, G * NWAVES * 64);
        __syncthreads();
        for (int unit = bx; unit < 256; unit += G) mlstm_naive(p, lds, unit, wave, lane);
        GRID_BAR();
    }
    if (IN(3)) { softmax_phase(p, gw, NGW, lane); ym_phase(p, gw, NGW, lane); GRID_BAR(); }
    if (IN(4)) {
        SchedPV S{G, bx, (const char*)(ws + WS_PB), (const char*)(ws + WS_VT)}; EpiPV E{(const bf16_t*)(ws + WS_U), (bf16_t*)(ws + WS_YCX)};
        pg8::gemm_phase<EpiPV, SchedPV, true, true>(lds, 2048, 2048, S, E);
        GRID_BAR();
    }
    if (IN(5)) {
        SchedMerge S{G, bx, (const char*)(ws + WS_YM), (const char*)(ws + WS_YCX), (const char*)(ws + WS_WPMT), (const char*)(ws + WS_WPCXT)};
        EpiMerge E{(const bf16_t*)(ws + WS_U), p.out, (bf16_t*)(ws + WS_MERGED)};
        pg8::gemm_phase<EpiMerge, SchedMerge, true, true>(lds, 8192, 8192, S, E);
        GRID_BAR();
    }
    if (IN(6)) {
        SchedOut S{G, bx, (const char*)(ws + WS_MERGED), (const char*)(ws + WS_WOT)}; EpiOut E{p.x, p.out};
        pg8::gemm_phase<EpiOut, SchedOut, true, true>(lds, 8192, 8192, S, E);
        GRID_BAR();
    }
    if (IN(7)) ln_phase(p, gw, NGW, lane);
#undef IN
#undef GRID_BAR
}

#ifndef MK_N_LAUNCHES
#define MK_N_LAUNCHES 1
#endif
extern "C" void kernel_launch(void* const* d_in, const int* in_sizes, int n_in, void* d_out, int out_size, void* d_ws, size_t ws_size, hipStream_t stream) {
    static int grid = 0;
    if (grid == 0) {
        if (n_in != 13 || out_size != T * D || ws_size < WS_END) { fprintf(stderr, "kernel_launch: unexpected shapes (n_in %d out %d ws %zu)\n", n_in, out_size, ws_size); grid = -1; return; }
        int dev = 0, cus = 0, per_cu = 0;
        if (hipGetDevice(&dev) != hipSuccess || hipDeviceGetAttribute(&cus, hipDeviceAttributeMultiprocessorCount, dev) != hipSuccess) { grid = -1; return; }
        if (hipFuncSetAttribute((const void*)mk_fwd, hipFuncAttributeMaxDynamicSharedMemorySize, LDS_BYTES) != hipSuccess) { fprintf(stderr, "kernel_launch: hipFuncSetAttribute failed\n"); grid = -1; return; }
        if (hipOccupancyMaxActiveBlocksPerMultiprocessor(&per_cu, (const void*)mk_fwd, NWAVES * 64, LDS_BYTES) != hipSuccess || per_cu < 1)
            fprintf(stderr, "kernel_launch: note: occupancy query reports %d\n", per_cu);
        (void)hipGetLastError();
        grid = cus;
    }
    if (grid < 0) return;
    (void)hipMemsetAsync((char*)d_ws + WS_CTL, 0, CTL_ZERO_BYTES, stream);
    Params p{};
    p.x = (const float*)d_in[0]; p.mem = (const float*)d_in[1]; p.w_in = (const float*)d_in[2]; p.b_in = (const float*)d_in[3];
    p.conv_w = (const float*)d_in[4]; p.mh_norm_w = (const float*)d_in[5]; p.w_mem_kv = (const float*)d_in[6]; p.w_proj_m = (const float*)d_in[7];
    p.w_proj_c = (const float*)d_in[8]; p.w_proj_x = (const float*)d_in[9]; p.w_out = (const float*)d_in[10]; p.ln_w = (const float*)d_in[11]; p.ln_b = (const float*)d_in[12];
    p.out = (float*)d_out; p.ws = (unsigned char*)d_ws;
    if (MK_N_LAUNCHES == 1) { p.ph_lo = 0; p.ph_hi = 8; hipLaunchKernelGGL(mk_fwd, dim3(grid), dim3(NWAVES * 64), LDS_BYTES, stream, p); }
    else for (int k = 0; k < 8; ++k) { p.ph_lo = k; p.ph_hi = k + 1; hipLaunchKernelGGL(mk_fwd, dim3(grid), dim3(NWAVES * 64), LDS_BYTES, stream, p); }
}
```

```cpp
#include <hip/hip_runtime.h>
#include <cstdio>
#include <cstdint>

#define LAS __attribute__((address_space(3)))
#define GAS __attribute__((address_space(1)))
typedef unsigned short bf16_t;
typedef short bf16x8 __attribute__((ext_vector_type(8)));
typedef float f32x4 __attribute__((ext_vector_type(4)));
typedef float f32x2 __attribute__((ext_vector_type(2)));
typedef unsigned u32x4 __attribute__((ext_vector_type(4)));
typedef unsigned u32x2 __attribute__((ext_vector_type(2)));

constexpr int NB = 4, SEQ = 2048, T = NB * SEQ, D = 4096;
constexpr int DIN = 40976, NU = 41216;
constexpr int MEMLEN = 256, TM = NB * MEMLEN;
constexpr int UQ = 0, UK = 2048, UV = 4096, UO = 8192, UZ = 12288, UCB = 16384, UCC = 18432, UCX = 20480, UCZ = 22528,
              UXQ = 24576, UXZ = 26624, UG = 28672, UI = 40960, UF = 40968;
constexpr float LN_EPS = 1e-5f;
constexpr float DN_ALPHA = 1.189207115002721f;

constexpr size_t MiB = 1u << 20;
constexpr size_t WS_CTL = 0, CTL_ZERO_BYTES = 1 * MiB;
constexpr size_t WS_BU = 1 * MiB;
constexpr size_t WS_XB = 2 * MiB;
constexpr size_t WS_MEMB = 66 * MiB;
constexpr size_t WS_WINT = 74 * MiB;
constexpr size_t WS_WKVT = 396 * MiB;
constexpr size_t WS_WPMT = 428 * MiB;
constexpr size_t WS_WPCXT = 460 * MiB;
constexpr size_t WS_WOT = 492 * MiB;
constexpr size_t WS_U = 524 * MiB;
constexpr size_t WS_KMEM = 1168 * MiB;
constexpr size_t WS_VT = 1172 * MiB;
constexpr size_t WS_SC = 1176 * MiB;
constexpr size_t WS_PB = 1208 * MiB;
constexpr size_t WS_HRAW = 1224 * MiB;
constexpr size_t WS_YM = 1288 * MiB;
constexpr size_t WS_YCX = 1352 * MiB;
constexpr size_t WS_MERGED = 1416 * MiB;
constexpr size_t WS_END = 1480 * MiB;
constexpr int CW_BAR = 4096;

constexpr int RING_BYTES = 131072;
constexpr int LDSCTL_OFF = RING_BYTES, MISC_OFF = LDSCTL_OFF + 320;
constexpr int LDS_BYTES = 147456;
constexpr int NWAVES = 8;

__device__ __forceinline__ unsigned cvt_pk_bf16(float lo, float hi) { unsigned r; asm("v_cvt_pk_bf16_f32 %0, %1, %2" : "=v"(r) : "v"(lo), "v"(hi)); return r; }
__device__ __forceinline__ float bf_lo(unsigned w) { return __uint_as_float(w << 16); }
__device__ __forceinline__ float bf_hi(unsigned w) { return __uint_as_float(w & 0xffff0000u); }
__device__ __forceinline__ float bf2f(bf16_t h) { return __uint_as_float(((unsigned)h) << 16); }
__device__ __forceinline__ float sigmoidf_(float x) { return __builtin_amdgcn_rcpf(1.0f + __expf(-x)); }
__device__ __forceinline__ float wave_sum(float v) {
#pragma unroll
    for (int o = 1; o < 64; o <<= 1) v += __shfl_xor(v, o);
    return v;
}
__device__ __forceinline__ float wave_max(float v) {
#pragma unroll
    for (int o = 1; o < 64; o <<= 1) v = fmaxf(v, __shfl_xor(v, o));
    return v;
}
#define LDS_WAIT() asm volatile("s_waitcnt lgkmcnt(0)" ::: "memory")
#define VM_WAIT() asm volatile("s_waitcnt vmcnt(0)" ::: "memory")

namespace pg8 {
constexpr int BM = 256, BK = 64, HALF = 128, HTB = HALF * BK * 2, STAGE_BYTES = 8 * HTB;
__host__ __device__ __forceinline__ int lds_byte(int r, int c) { const int st = (r >> 4) * 2 + (c >> 5), rr = r & 15, cc = c & 31, ob = rr * 64 + cc * 2; return st * 1024 + (ob ^ (((ob >> 9) & 1) << 5)); }
__host__ __device__ __forceinline__ void stage_rc(int b, int& R, int& C) { const int st = b / 1024, sb = b % 1024, swz = sb ^ (((sb >> 9) & 1) << 5); R = (st >> 1) * 16 + swz / 64; C = (st & 1) * 32 + (swz % 64) / 2; }
__host__ __device__ __forceinline__ int perm32(int rho) { const int n = rho >> 4, i = rho & 15; return 8 * (i >> 2) + 4 * n + (i & 3); }

struct Unit { const char* A; const char* B; int nt, pm, pn, kind; };

__device__ __forceinline__ bool tile_map(long L, int nM, int nN, int& pm, int& pn) {
    const int nwg = nM * nN; if (L >= nwg) return false;
    int wgid = (int)L; { const int q = nwg / 8, r = nwg % 8, xcd = wgid % 8, off = wgid / 8; wgid = (xcd < r ? xcd * (q + 1) : r * (q + 1) + (xcd - r) * q) + off; }
    const int nig = 8 * nN, gid = wgid / nig, fm = gid * 8, gsz = (nM - fm) < 8 ? (nM - fm) : 8;
    pm = fm + ((wgid % nig) % gsz); pn = (wgid % nig) / gsz; return true;
}

template <class Epi, class Sched, bool ALIGN_EPI, bool SP2>
__device__ __forceinline__ void gemm_phase(LAS unsigned char* lds, const int lda, const int ldb, const Sched& S, const Epi& E) {
    const int tid = threadIdx.x, wid = __builtin_amdgcn_readfirstlane(tid >> 6), lane = tid & 63, wr = wid >> 2, wc = wid & 3, fr = lane & 15, fq = lane >> 4;
    unsigned voffA[2], voffB[2];
#pragma unroll
    for (int i = 0; i < 2; ++i) { int R, C; stage_rc(tid * 16 + i * 8192, R, C); const int Rb = Epi::PERM ? ((R & ~31) + perm32(R & 31)) : R;
        voffA[i] = (unsigned)(R * lda + C * 2); voffB[i] = (unsigned)(Rb * ldb + C * 2); }
    const size_t kstep = (size_t)(BK * 2);
    const size_t hstepA = (size_t)HALF * lda, hstepB = (size_t)HALF * ldb;
    const unsigned ldsw = (unsigned)wid * 1024u;
    const int aoff = lds_byte(wr * 64 + fr, fq * 8), boff = lds_byte(wc * 32 + fr, fq * 8);
#define PG8_SA(b, h) (((b) * 2 + (h)) * HTB)
#define PG8_SB(b, h) ((4 + (b) * 2 + (h)) * HTB)
#define PG8_STAGE(bufoff, gbase, voff) do { _Pragma("unroll") for (int _i = 0; _i < 2; ++_i) \
        __builtin_amdgcn_global_load_lds((const unsigned*)((const char*)(gbase) + (voff)[_i]), (LAS unsigned*)(lds + (bufoff) + ldsw + _i * 8192), 16, 0, 0); } while (0)
#define PG8_LDA(dst, b, h) do { _Pragma("unroll") for (int m = 0; m < 4; ++m) _Pragma("unroll") for (int k = 0; k < 2; ++k) dst[m][k] = *(const LAS bf16x8*)(lds + PG8_SA(b, h) + aoff + m * 2048 + k * 1024); } while (0)
#define PG8_LDB(dst, b, h) do { _Pragma("unroll") for (int n = 0; n < 2; ++n) _Pragma("unroll") for (int k = 0; k < 2; ++k) dst[n][k] = *(const LAS bf16x8*)(lds + PG8_SB(b, h) + boff + n * 2048 + k * 1024); } while (0)
#define PG8_MMA(ai, bj, At, Bt) do { __builtin_amdgcn_s_setprio(1); _Pragma("unroll") for (int m = 0; m < 4; ++m) _Pragma("unroll") for (int n = 0; n < 2; ++n) _Pragma("unroll") for (int k = 0; k < 2; ++k) \
        acc[ai][bj][m][n] = __builtin_amdgcn_mfma_f32_16x16x32_bf16(Bt[n][k], At[m][k], acc[ai][bj][m][n], 0, 0, 0); __builtin_amdgcn_s_setprio(0); } while (0)
#define PG8_WAIT_V(n) asm volatile("s_waitcnt vmcnt(" #n ")" ::: "memory")
#define PG8_WAIT_L(n) asm volatile("s_waitcnt lgkmcnt(" #n ")" ::: "memory")
#define PG8_BAR __builtin_amdgcn_s_barrier()
#define PG8_SCHED __builtin_amdgcn_sched_barrier(0)
    Unit cur, nxt; int ui = 0;
    if (!S.next(0, cur)) return;
    f32x4 acc[2][2][4][2];
#pragma unroll
    for (int a = 0; a < 2; ++a)
#pragma unroll
        for (int b = 0; b < 2; ++b)
#pragma unroll
            for (int m = 0; m < 4; ++m)
#pragma unroll
                for (int n = 0; n < 2; ++n) acc[a][b][m][n] = (f32x4){0.f, 0.f, 0.f, 0.f};
    bf16x8 At[4][2], B0[2][2], B1[2][2];
    const char* cA = cur.A; const char* cB = cur.B;
    if constexpr (SP2) {
        PG8_STAGE(PG8_SB(0, 0), cB, voffB); PG8_STAGE(PG8_SB(0, 1), cB + hstepB, voffB); PG8_STAGE(PG8_SA(0, 0), cA, voffA); PG8_STAGE(PG8_SA(0, 1), cA + hstepA, voffA);
        if (wr == 1) PG8_BAR;
        PG8_WAIT_V(2); PG8_BAR;
        PG8_STAGE(PG8_SB(1, 0), cB + kstep, voffB); PG8_STAGE(PG8_SA(1, 0), cA + kstep, voffA); PG8_STAGE(PG8_SB(1, 1), cB + hstepB + kstep, voffB);
        PG8_WAIT_V(6); PG8_BAR;
    } else {
        PG8_STAGE(PG8_SB(0, 0), cB, voffB); PG8_STAGE(PG8_SA(0, 0), cA, voffA); PG8_STAGE(PG8_SB(0, 1), cB + hstepB, voffB); PG8_STAGE(PG8_SA(0, 1), cA + hstepA, voffA);
        if (wr == 1) PG8_BAR;
        PG8_WAIT_V(4); PG8_BAR;
        PG8_STAGE(PG8_SB(1, 0), cB + kstep, voffB); PG8_STAGE(PG8_SA(1, 0), cA + kstep, voffA); PG8_STAGE(PG8_SB(1, 1), cB + hstepB + kstep, voffB);
        PG8_WAIT_V(6); PG8_BAR;
    }
    for (;;) {
        const bool has_next = S.next(ui + 1, nxt);
        const char* nA = has_next ? nxt.A : cA; const char* nB = has_next ? nxt.B : cB;
        const int nt = cur.nt;
        for (int t = 0; t < nt; t += 2) {
            const bool last = (t == nt - 2);
            const char* a1 = cA + (size_t)(t + 1) * kstep;
            const char* a2 = last ? nA : cA + (size_t)(t + 2) * kstep; const char* b2 = last ? nB : cB + (size_t)(t + 2) * kstep;
            const char* a3 = a2 + kstep; const char* b3 = b2 + kstep;
            if constexpr (SP2) {
            PG8_LDB(B0, 0, 0); PG8_LDB(B1, 0, 1); PG8_SCHED; PG8_LDA(At, 0, 0); PG8_STAGE(PG8_SA(1, 1), a1 + hstepA, voffA);
            PG8_WAIT_V(8); PG8_WAIT_L(0); PG8_BAR; PG8_MMA(0, 0, At, B0); PG8_MMA(0, 1, At, B1); PG8_BAR; PG8_SCHED;
            PG8_LDA(At, 0, 1); PG8_STAGE(PG8_SB(0, 0), b2, voffB); PG8_STAGE(PG8_SB(0, 1), b2 + hstepB, voffB); PG8_STAGE(PG8_SA(0, 0), a2, voffA);
            PG8_WAIT_V(8); PG8_WAIT_L(0); PG8_BAR; PG8_MMA(1, 0, At, B0); PG8_MMA(1, 1, At, B1); PG8_BAR; PG8_SCHED;
            PG8_LDB(B0, 1, 0); PG8_LDB(B1, 1, 1); PG8_SCHED; PG8_LDA(At, 1, 0); PG8_STAGE(PG8_SA(0, 1), a2 + hstepA, voffA);
            PG8_WAIT_V(8); PG8_WAIT_L(0); PG8_BAR; PG8_MMA(0, 0, At, B0); PG8_MMA(0, 1, At, B1); PG8_BAR; PG8_SCHED;
            PG8_LDA(At, 1, 1); PG8_STAGE(PG8_SB(1, 0), b3, voffB); PG8_STAGE(PG8_SB(1, 1), b3 + hstepB, voffB); PG8_STAGE(PG8_SA(1, 0), a3, voffA);
            PG8_WAIT_V(8); PG8_WAIT_L(0); PG8_BAR; PG8_MMA(1, 0, At, B0); PG8_MMA(1, 1, At, B1); PG8_BAR; PG8_SCHED;
            } else {
            PG8_LDB(B0, 0, 0); PG8_SCHED; PG8_LDA(At, 0, 0); PG8_STAGE(PG8_SA(1, 1), a1 + hstepA, voffA);
            PG8_WAIT_L(8); PG8_BAR; PG8_WAIT_L(0); PG8_MMA(0, 0, At, B0); PG8_BAR; PG8_SCHED;
            PG8_LDB(B1, 0, 1); PG8_STAGE(PG8_SB(0, 0), b2, voffB);
            PG8_BAR; PG8_WAIT_L(0); PG8_MMA(0, 1, At, B1); PG8_BAR;
            PG8_LDA(At, 0, 1); PG8_STAGE(PG8_SA(0, 0), a2, voffA);
            PG8_BAR; PG8_WAIT_L(0); PG8_MMA(1, 0, At, B0); PG8_BAR; PG8_SCHED;
            PG8_STAGE(PG8_SB(0, 1), b2 + hstepB, voffB);
            PG8_WAIT_V(6); PG8_BAR; PG8_MMA(1, 1, At, B1); PG8_BAR;
            PG8_LDB(B0, 1, 0); PG8_SCHED; PG8_LDA(At, 1, 0); PG8_STAGE(PG8_SA(0, 1), a2 + hstepA, voffA);
            PG8_WAIT_L(8); PG8_BAR; PG8_WAIT_L(0); PG8_MMA(0, 0, At, B0); PG8_BAR; PG8_SCHED;
            PG8_LDB(B1, 1, 1); PG8_STAGE(PG8_SB(1, 0), b3, voffB);
            PG8_BAR; PG8_WAIT_L(0); PG8_MMA(0, 1, At, B1); PG8_BAR;
            PG8_LDA(At, 1, 1); PG8_STAGE(PG8_SA(1, 0), a3, voffA);
            PG8_BAR; PG8_WAIT_L(0); PG8_MMA(1, 0, At, B0); PG8_BAR; PG8_SCHED;
            PG8_STAGE(PG8_SB(1, 1), b3 + hstepB, voffB);
            PG8_WAIT_V(6); PG8_BAR; PG8_MMA(1, 1, At, B1); PG8_BAR;
            }
        }
        if constexpr (ALIGN_EPI) { if (wr == 0) PG8_BAR; }
        E(acc, cur, wr, wc, fr, fq);
        if (!has_next) break;
#pragma unroll
        for (int a = 0; a < 2; ++a)
#pragma unroll
            for (int b = 0; b < 2; ++b)
#pragma unroll
                for (int m = 0; m < 4; ++m)
#pragma unroll
                    for (int n = 0; n < 2; ++n) acc[a][b][m][n] = (f32x4){0.f, 0.f, 0.f, 0.f};
        cur = nxt; cA = nA; cB = nB; ++ui;
        if constexpr (ALIGN_EPI) { if (wr == 1) PG8_BAR; }
    }
    PG8_WAIT_V(0);
    if constexpr (!ALIGN_EPI) { if (wr == 0) PG8_BAR; }
    PG8_BAR;
#undef PG8_SA
#undef PG8_SB
#undef PG8_STAGE
#undef PG8_LDA
#undef PG8_LDB
#undef PG8_MMA
#undef PG8_WAIT_V
#undef PG8_WAIT_L
#undef PG8_BAR
#undef PG8_SCHED
}
}
using pg8::Unit;

#define XB_TMO      128
#define XB_XCNT(j)  (256  + 64 * (j))
#define XB_XSUB(j)  (1280 + 64 * (j))
#define XB_XGEN(j)  (2304 + 64 * (j))
#define XB_TOP      3328
#define XB_TOPGEN   3392
#define XCD_BAR_WORDS 3456
#define XB_SPIN_CAP (1u << 18)

__device__ __forceinline__ unsigned xb_ld(unsigned* p)              { return __hip_atomic_load(p, __ATOMIC_RELAXED, __HIP_MEMORY_SCOPE_AGENT); }
__device__ __forceinline__ unsigned xb_add(unsigned* p, unsigned v) { return __hip_atomic_fetch_add(p, v, __ATOMIC_RELAXED, __HIP_MEMORY_SCOPE_AGENT); }
__device__ __forceinline__ unsigned xb_xcc_id() { return (unsigned)__builtin_amdgcn_s_getreg((3 << 11) | 20) & 0xFu; }
#define XB_SPIN(cond, bar) do { unsigned _sp = 0; while (cond) { __builtin_amdgcn_s_sleep(1); \
    if ((++_sp & 255u) == 0u) { if (xb_ld(&(bar)[XB_TMO])) break; if (_sp > XB_SPIN_CAP) { atomicAdd(&(bar)[XB_TMO], 1u); break; } } } } while (0)

struct XcdBarrier { unsigned* bar; unsigned x; volatile LAS unsigned* st; };

__device__ __forceinline__ XcdBarrier xcd_barrier_post(unsigned* bar, volatile LAS unsigned* st) {
    XcdBarrier b; b.bar = bar; b.x = xb_xcc_id(); b.st = st;
    if (threadIdx.x == 0) (void)xb_add(&bar[XB_XCNT(b.x)], 1u);
    return b;
}
__device__ __forceinline__ void xcd_barrier_complete(unsigned* bar, unsigned x, unsigned& nloc, unsigned& nx) {
    const unsigned G = gridDim.x * gridDim.y * gridDim.z;
    unsigned sum, cnt, mine, sp = 0u;
    for (;;) {
        sum = 0u; cnt = 0u; mine = 0u;
#pragma unroll
        for (unsigned j = 0; j < 16; ++j) { const unsigned c = xb_ld(&bar[XB_XCNT(j)]); sum += c; cnt += (c > 0u) ? 1u : 0u; mine = (j == x) ? c : mine; }
        if (sum == G) break;
        __builtin_amdgcn_s_sleep(1);
        if ((++sp & 255u) == 0u) { if (xb_ld(&bar[XB_TMO])) break; if (sp > XB_SPIN_CAP) { atomicAdd(&bar[XB_TMO], 1u); break; } }
    }
    nloc = mine > 0u ? mine : 1u; nx = cnt > 0u ? cnt : 1u;
}
__device__ __forceinline__ void xcd_barrier(const XcdBarrier& b) {
    asm volatile("s_waitcnt vmcnt(0)" ::: "memory");
    __syncthreads();
    if (threadIdx.x == 0) {
        unsigned* bar = b.bar;
        __builtin_amdgcn_s_waitcnt(0);
        unsigned nloc = b.st[0], nx = b.st[1];
        if (nloc == 0u) { xcd_barrier_complete(bar, b.x, nloc, nx); b.st[0] = nloc; b.st[1] = nx; }
        const unsigned old = xb_add(&bar[XB_XSUB(b.x)], 1u);
        const unsigned gen = old / nloc;
        if (old + 1u == (gen + 1u) * nloc) {
            __builtin_amdgcn_fence(__ATOMIC_RELEASE, "agent");
            asm volatile("s_waitcnt vmcnt(0)" ::: "memory");
            const unsigned og = xb_add(&bar[XB_TOP], 1u);
            const unsigned tg = og / nx;
            if (og + 1u == (tg + 1u) * nx) xb_add(&bar[XB_TOPGEN], 1u);
            else XB_SPIN(xb_ld(&bar[XB_TOPGEN]) == tg, bar);
            __builtin_amdgcn_fence(__ATOMIC_ACQUIRE, "agent");
            xb_add(&bar[XB_XGEN(b.x)], 1u);
            asm volatile("s_waitcnt vmcnt(0)" ::: "memory");
        } else {
            XB_SPIN(xb_ld(&bar[XB_XGEN(b.x)]) == gen, bar);
            __builtin_amdgcn_fence(__ATOMIC_ACQUIRE, "agent");
            asm volatile("s_waitcnt vmcnt(0)" ::: "memory");
        }
    }
    __syncthreads();
}

struct Params {
    const float *x, *mem, *w_in, *b_in, *conv_w, *mh_norm_w, *w_mem_kv, *w_proj_m, *w_proj_c, *w_proj_x, *w_out, *ln_w, *ln_b;
    float* out; unsigned char* ws;
    int ph_lo, ph_hi;
};

__device__ __forceinline__ void transpose_item(const float* src, size_t src_ld, int col0, int ncv, bf16_t* dst, size_t dst_ld, int n0, int k0, LAS unsigned* scr, int lane) {
    const float* sp = src + (size_t)k0 * src_ld + col0 + lane;
    if (ncv > 0) {
#pragma unroll 8
        for (int i = 0; i < 32; ++i) {
            float a = 0.f, b = 0.f;
            if (lane < ncv) { a = sp[(size_t)(2 * i) * src_ld]; b = sp[(size_t)(2 * i + 1) * src_ld]; }
            scr[i * 65 + lane] = cvt_pk_bf16(a, b);
        }
    } else {
#pragma unroll 8
        for (int i = 0; i < 32; ++i) scr[i * 65 + lane] = 0u;
    }
    LDS_WAIT(); asm volatile("" ::: "memory");
    const int c = lane & 7;
#pragma unroll
    for (int j = 0; j < 8; ++j) {
        const int n = (lane >> 3) + 8 * j; const LAS unsigned* s = scr + (4 * c) * 65 + n;
        u32x4 o; o.x = s[0]; o.y = s[65]; o.z = s[130]; o.w = s[195];
        *(u32x4*)(dst + (size_t)(n0 + n) * dst_ld + k0 + 8 * c) = o;
    }
    LDS_WAIT(); asm volatile("" ::: "memory");
}
__device__ __forceinline__ void cvt_row(const float* src, bf16_t* dst, int lane) {
    const f32x4* s = (const f32x4*)src + lane; u32x2* d = (u32x2*)dst + lane;
#pragma unroll
    for (int j = 0; j < 16; ++j) { const f32x4 v = s[64 * j]; u32x2 o; o.x = cvt_pk_bf16(v.x, v.y); o.y = cvt_pk_bf16(v.z, v.w); d[64 * j] = o; }
}
__device__ __forceinline__ void p0_prologue(const Params& p, LAS unsigned char* lds, int gw, int NGW, int wave, int lane) {
    LAS unsigned* scr = (LAS unsigned*)(lds + wave * 8448);
    unsigned char* ws = p.ws;
    bf16_t* WINT = (bf16_t*)(ws + WS_WINT); bf16_t* WKVT = (bf16_t*)(ws + WS_WKVT); bf16_t* WPMT = (bf16_t*)(ws + WS_WPMT);
    bf16_t* WPCXT = (bf16_t*)(ws + WS_WPCXT); bf16_t* WOT = (bf16_t*)(ws + WS_WOT);
    constexpr int I_IN = 64 * 644, I_KV = 64 * 64, I_PM = 64 * 64, I_PC = 32 * 64, I_PX = 32 * 64, I_O = 64 * 64;
    constexpr int NITEMS = I_IN + I_KV + I_PM + I_PC + I_PX + I_O;
    for (int it = gw; it < NITEMS; it += NGW) {
        int r = it;
        if (r < I_IN) { const int kb = r / 644, nb = r % 644, n0 = nb * 64; int col0, ncv;
            if (n0 < 16384) { col0 = n0; ncv = 64; } else if (n0 < 40960) { col0 = n0 + 16; ncv = 64; } else if (n0 == 40960) { col0 = 16384; ncv = 16; } else { col0 = 0; ncv = 0; }
            transpose_item(p.w_in, DIN, col0, ncv, WINT, D, n0, kb * 64, scr, lane); continue; }
        r -= I_IN;
        if (r < I_KV) { transpose_item(p.w_mem_kv, 4096, (r % 64) * 64, 64, WKVT, 4096, (r % 64) * 64, (r / 64) * 64, scr, lane); continue; }
        r -= I_KV;
        if (r < I_PM) { transpose_item(p.w_proj_m, 4096, (r % 64) * 64, 64, WPMT, 4096, (r % 64) * 64, (r / 64) * 64, scr, lane); continue; }
        r -= I_PM;
        if (r < I_PC) { transpose_item(p.w_proj_c, 4096, (r % 64) * 64, 64, WPCXT, 4096, (r % 64) * 64, (r / 64) * 64, scr, lane); continue; }
        r -= I_PC;
        if (r < I_PX) { transpose_item(p.w_proj_x, 4096, (r % 64) * 64, 64, WPCXT + 2048, 4096, (r % 64) * 64, (r / 64) * 64, scr, lane); continue; }
        r -= I_PX;
        transpose_item(p.w_out, 4096, (r % 64) * 64, 64, WOT, 4096, (r % 64) * 64, (r / 64) * 64, scr, lane);
    }
    bf16_t* XB = (bf16_t*)(ws + WS_XB); bf16_t* MEMB = (bf16_t*)(ws + WS_MEMB);
    for (int m = gw; m < T; m += NGW) cvt_row(p.x + (size_t)m * D, XB + (size_t)m * D, lane);
    for (int m = gw; m < TM; m += NGW) cvt_row(p.mem + (size_t)m * D, MEMB + (size_t)m * D, lane);
    float* BU = (float*)(ws + WS_BU);
    for (int c = gw * 64 + lane; c < NU; c += NGW * 64) {
        float v = 0.f;
        if (c < 16384) v = p.b_in[c]; else if (c < 40960) v = p.b_in[c + 16]; else if (c < 40976) v = p.b_in[16384 + (c - 40960)];
        BU[c] = v;
    }
}

__device__ __forceinline__ int act_of(int c0) {
    if (c0 >= UO && c0 < UZ) return 1;
    if (c0 >= UZ && c0 < UCB) return 2;
    if (c0 >= UCZ && c0 < UXQ) return 2;
    if (c0 >= UXZ && c0 < UG) return 2;
    if (c0 >= UG && c0 < UI) return 1;
    return 0;
}
struct SchedP1 {
    int G, c; const char *xb, *memb, *wint, *wkvt;
    __device__ __forceinline__ bool next(int i, Unit& u) const {
        long L = (long)i * G + c;
        if (L < 5152) { pg8::tile_map(L, 32, 161, u.pm, u.pn); u.A = xb + (size_t)u.pm * 256 * 8192; u.B = wint + (size_t)u.pn * 256 * 8192; u.nt = 64; u.kind = 0; return true; }
        L -= 5152;
        if (L < 32) { u.pm = (int)L / 8; u.pn = (int)L % 8; u.A = memb + (size_t)u.pm * 256 * 8192; u.B = wkvt + (size_t)u.pn * 256 * 8192; u.nt = 64; u.kind = 1; return true; }
        L -= 32;
        if (L < 32) { u.pm = (int)L / 4; u.pn = (int)L % 4; u.A = wkvt + (size_t)(2048 + u.pm * 256) * 8192; u.B = memb + (size_t)u.pn * 256 * 8192; u.nt = 64; u.kind = 2; return true; }
        return false;
    }
};
struct EpiP1 {
    static constexpr bool PERM = true;
    bf16_t* U; const float* bU; bf16_t* KMEM; bf16_t* VT;
    __device__ __forceinline__ void operator()(const f32x4 (&acc)[2][2][4][2], const Unit& u, int wr, int wc, int fr, int fq) const {
        asm volatile("" : "+v"(fr), "+v"(fq));
        bf16_t* base; int ldc; const float* bias; int act = 0; float sc = 1.f;
        if (u.kind == 0) { const int c0 = u.pn * 256; base = U + (size_t)u.pm * 256 * NU + c0; ldc = NU; bias = bU + c0; act = act_of(c0); if (c0 < UK) sc = 0.0625f; }
        else if (u.kind == 1) { base = KMEM + (size_t)u.pm * 256 * 2048 + u.pn * 256; ldc = 2048; bias = nullptr; }
        else { base = VT + (size_t)u.pm * 256 * 1024 + u.pn * 256; ldc = 1024; bias = nullptr; }
        const int row0 = wr * 64 + fr, col0 = wc * 32 + 8 * fq;
        f32x4 bv[2][2];
#pragma unroll
        for (int bj = 0; bj < 2; ++bj)
#pragma unroll
            for (int n = 0; n < 2; ++n) bv[bj][n] = bias ? *(const f32x4*)(bias + col0 + bj * 128 + 4 * n) : (f32x4){0.f, 0.f, 0.f, 0.f};
#pragma unroll
        for (int ai = 0; ai < 2; ++ai)
#pragma unroll
            for (int m = 0; m < 4; ++m) { bf16_t* rowp = base + (size_t)(row0 + ai * 128 + m * 16) * ldc + col0;
#pragma unroll
                for (int bj = 0; bj < 2; ++bj) { f32x4 v0 = acc[ai][bj][m][0] + bv[bj][0], v1 = acc[ai][bj][m][1] + bv[bj][1];
                    if (act) {
#pragma unroll
                        for (int j = 0; j < 4; ++j) { const float s0 = sigmoidf_(v0[j]), s1 = sigmoidf_(v1[j]); v0[j] = (act == 1) ? s0 : v0[j] * s0; v1[j] = (act == 1) ? s1 : v1[j] * s1; } }
                    v0 = v0 * sc; v1 = v1 * sc;
                    u32x4 w; w.x = cvt_pk_bf16(v0[0], v0[1]); w.y = cvt_pk_bf16(v0[2], v0[3]); w.z = cvt_pk_bf16(v1[0], v1[1]); w.w = cvt_pk_bf16(v1[2], v1[3]);
                    *(u32x4*)(rowp + bj * 128) = w; } }
    }
};
struct SchedQK {
    int G, c; const char *u, *kmem;
    __device__ __forceinline__ bool next(int i, Unit& un) const {
        const int L = i * G + c; if (L >= 128) return false;
        const int head = L & 3, rt = L >> 2;
        un.pm = rt; un.pn = head; un.A = u + ((size_t)rt * 256 * NU + UXQ + head * 512) * 2; un.B = kmem + ((size_t)(rt >> 3) * 256 * 2048 + head * 512) * 2; un.nt = 8; un.kind = 0; return true;
    }
};
struct EpiSC {
    static constexpr bool PERM = false;
    float* SC;
    __device__ __forceinline__ void operator()(const f32x4 (&acc)[2][2][4][2], const Unit& u, int wr, int wc, int fr, int fq) const {
        asm volatile("" : "+v"(fr), "+v"(fq));
        const float sc = 0.04419417382415922f;
        float* base = SC + (size_t)u.pm * 256 * 1024 + u.pn * 256;
        const int row0 = wr * 64 + fr, col0 = wc * 32 + 4 * fq;
#pragma unroll
        for (int ai = 0; ai < 2; ++ai)
#pragma unroll
            for (int m = 0; m < 4; ++m) { float* rowp = base + (size_t)(row0 + ai * 128 + m * 16) * 1024 + col0;
#pragma unroll
                for (int bj = 0; bj < 2; ++bj)
#pragma unroll
                    for (int n = 0; n < 2; ++n) *(f32x4*)(rowp + bj * 128 + n * 16) = acc[ai][bj][m][n] * sc; }
    }
};
struct SchedPV {
    int G, c; const char *pb, *vt;
    __device__ __forceinline__ bool next(int i, Unit& un) const {
        const int L = i * G + c; if (L >= 256) return false;
        const int n2 = L & 1, head = (L >> 1) & 3, rt = L >> 3;
        un.pm = rt; un.pn = head * 2 + n2; un.A = pb + ((size_t)rt * 256 * 1024 + head * 256) * 2; un.B = vt + ((size_t)(head * 512 + n2 * 256) * 1024 + (rt >> 3) * 256) * 2; un.nt = 4; un.kind = 0; return true;
    }
};
struct EpiPV {
    static constexpr bool PERM = true;
    const bf16_t* U; bf16_t* YCX;
    __device__ __forceinline__ void operator()(const f32x4 (&acc)[2][2][4][2], const Unit& u, int wr, int wc, int fr, int fq) const {
        asm volatile("" : "+v"(fr), "+v"(fq));
        const bf16_t* zb = U + (size_t)u.pm * 256 * NU + UXZ + u.pn * 256;
        bf16_t* ob = YCX + (size_t)u.pm * 256 * 4096 + 2048 + u.pn * 256;
        const int row0 = wr * 64 + fr, col0 = wc * 32 + 8 * fq;
#pragma unroll
        for (int ai = 0; ai < 2; ++ai)
#pragma unroll
            for (int m = 0; m < 4; ++m) { const size_t r = (size_t)(row0 + ai * 128 + m * 16);
#pragma unroll
                for (int bj = 0; bj < 2; ++bj) { const u32x4 z = *(const u32x4*)(zb + r * NU + col0 + bj * 128);
                    const f32x4 v0 = acc[ai][bj][m][0], v1 = acc[ai][bj][m][1];
                    u32x4 w; w.x = cvt_pk_bf16(v0[0] * bf_lo(z.x), v0[1] * bf_hi(z.x)); w.y = cvt_pk_bf16(v0[2] * bf_lo(z.y), v0[3] * bf_hi(z.y));
                    w.z = cvt_pk_bf16(v1[0] * bf_lo(z.z), v1[1] * bf_hi(z.z)); w.w = cvt_pk_bf16(v1[2] * bf_lo(z.w), v1[3] * bf_hi(z.w));
                    *(u32x4*)(ob + r * 4096 + col0 + bj * 128) = w; }
                asm volatile("" ::: "memory"); }
    }
};
struct SchedMerge {
    int G, c; const char *ym, *ycx, *wpmt, *wpcxt;
    __device__ __forceinline__ bool next(int i, Unit& u) const {
        const int r = i / 3, br = i - 3 * r;
        if (!pg8::tile_map((long)r * G + c, 32, 16, u.pm, u.pn)) return false;
        u.kind = br;
        if (br == 0) { u.A = ym + (size_t)u.pm * 256 * 8192; u.B = wpmt + (size_t)u.pn * 256 * 8192; u.nt = 64; }
        else { u.A = ycx + (size_t)u.pm * 256 * 8192 + (br == 2 ? 4096 : 0); u.B = wpcxt + (size_t)u.pn * 256 * 8192 + (br == 2 ? 4096 : 0); u.nt = 32; }
        return true;
    }
};
struct EpiMerge {
    static constexpr bool PERM = false;
    const bf16_t* U; float* scr; bf16_t* MERGED;
    __device__ __forceinline__ void operator()(const f32x4 (&acc)[2][2][4][2], const Unit& u, int wr, int wc, int fr, int fq) const {
        asm volatile("" : "+v"(fr), "+v"(fq));
        const int br = u.kind;
        const bf16_t* gb = U + (size_t)u.pm * 256 * NU + UG + br * 4096 + u.pn * 256;
        const size_t ob = (size_t)u.pm * 256 * 4096 + u.pn * 256;
        const int row0 = wr * 64 + fr, col0 = wc * 32 + 4 * fq;
#pragma unroll
        for (int ai = 0; ai < 2; ++ai)
#pragma unroll
            for (int m = 0; m < 4; ++m) { const size_t r = (size_t)(row0 + ai * 128 + m * 16);
#pragma unroll
                for (int bj = 0; bj < 2; ++bj)
#pragma unroll
                    for (int n = 0; n < 2; ++n) { const int cc = col0 + bj * 128 + n * 16;
                        const u32x2 g = *(const u32x2*)(gb + r * NU + cc);
                        f32x4 v = acc[ai][bj][m][n]; v[0] *= bf_lo(g.x); v[1] *= bf_hi(g.x); v[2] *= bf_lo(g.y); v[3] *= bf_hi(g.y);
                        float* sp = scr + ob + r * 4096 + cc;
                        if (br != 0) v = v + *(const f32x4*)sp;
                        if (br != 2) *(f32x4*)sp = v;
                        else { u32x2 w; w.x = cvt_pk_bf16(v[0], v[1]); w.y = cvt_pk_bf16(v[2], v[3]); *(u32x2*)(MERGED + ob + r * 4096 + cc) = w; } }
                asm volatile("" ::: "memory"); }
    }
};
struct SchedOut {
    int G, c; const char *merged, *wot;
    __device__ __forceinline__ bool next(int i, Unit& u) const {
        if (!pg8::tile_map((long)i * G + c, 32, 16, u.pm, u.pn)) return false;
        u.A = merged + (size_t)u.pm * 256 * 8192; u.B = wot + (size_t)u.pn * 256 * 8192; u.nt = 64; u.kind = 0; return true;
    }
};
struct EpiOut {
    static constexpr bool PERM = false;
    const float* x; float* out;
    __device__ __forceinline__ void operator()(const f32x4 (&acc)[2][2][4][2], const Unit& u, int wr, int wc, int fr, int fq) const {
        asm volatile("" : "+v"(fr), "+v"(fq));
        const size_t ob = (size_t)u.pm * 256 * 4096 + u.pn * 256;
        const int row0 = wr * 64 + fr, col0 = wc * 32 + 4 * fq;
#pragma unroll
        for (int ai = 0; ai < 2; ++ai)
#pragma unroll
            for (int m = 0; m < 4; ++m) { const size_t r = (size_t)(row0 + ai * 128 + m * 16);
#pragma unroll
                for (int bj = 0; bj < 2; ++bj)
#pragma unroll
                    for (int n = 0; n < 2; ++n) { const size_t o = ob + r * 4096 + col0 + bj * 128 + n * 16;
                        const f32x4 xv = *(const f32x4*)(x + o);
                        *(f32x4*)(out + o) = xv * DN_ALPHA + acc[ai][bj][m][n]; }
                asm volatile("" ::: "memory"); }
    }
};

__device__ __forceinline__ void conv_phase(const Params& p, int gtid, int NGT) {
    const bf16_t* U = (const bf16_t*)(p.ws + WS_U); bf16_t* YCX = (bf16_t*)(p.ws + WS_YCX);
    for (int idx = gtid; idx < T * 256; idx += NGT) {
        const int t = idx >> 8, c = (idx & 255) * 8, tl = t & (SEQ - 1);
        const bf16_t* row = U + (size_t)t * NU;
        const u32x4 cb = *(const u32x4*)(row + UCB + c), cz = *(const u32x4*)(row + UCZ + c);
        const unsigned cbw[4] = {cb.x, cb.y, cb.z, cb.w}, czw[4] = {cz.x, cz.y, cz.z, cz.w};
        float accv[8];
#pragma unroll
        for (int j = 0; j < 8; ++j) accv[j] = 0.f;
#pragma unroll
        for (int w = 0; w < 3; ++w) {
            const int dt = 2 - w;
            if (tl >= dt) {
                const bf16_t* r2 = row - (size_t)dt * NU;
                const u32x4 a = *(const u32x4*)(r2 + UCC + c), b = *(const u32x4*)(r2 + UCX + c);
                const unsigned aw[4] = {a.x, a.y, a.z, a.w}, bw[4] = {b.x, b.y, b.z, b.w};
                const f32x4 w0 = *(const f32x4*)(p.conv_w + w * 2048 + c), w1 = *(const f32x4*)(p.conv_w + w * 2048 + c + 4);
                const float wv[8] = {w0[0], w0[1], w0[2], w0[3], w1[0], w1[1], w1[2], w1[3]};
#pragma unroll
                for (int j = 0; j < 4; ++j) { accv[2 * j] += wv[2 * j] * (bf_lo(aw[j]) * bf_lo(bw[j])); accv[2 * j + 1] += wv[2 * j + 1] * (bf_hi(aw[j]) * bf_hi(bw[j])); }
            }
        }
        u32x4 o; unsigned ow[4];
#pragma unroll
        for (int j = 0; j < 4; ++j) ow[j] = cvt_pk_bf16(bf_lo(cbw[j]) * accv[2 * j] * bf_lo(czw[j]), bf_hi(cbw[j]) * accv[2 * j + 1] * bf_hi(czw[j]));
        o.x = ow[0]; o.y = ow[1]; o.z = ow[2]; o.w = ow[3];
        *(u32x4*)(YCX + (size_t)t * 4096 + c) = o;
    }
}
__device__ __forceinline__ void softmax_phase(const Params& p, int gw, int NGW, int lane) {
    const float* SC = (const float*)(p.ws + WS_SC); bf16_t* PB = (bf16_t*)(p.ws + WS_PB);
    for (int it = gw; it < T * 4; it += NGW) {
        const f32x4 s = *(const f32x4*)(SC + (size_t)it * 256 + 4 * lane);
        const float mx = wave_max(fmaxf(fmaxf(s[0], s[1]), fmaxf(s[2], s[3])));
        const float e0 = __expf(s[0] - mx), e1 = __expf(s[1] - mx), e2 = __expf(s[2] - mx), e3 = __expf(s[3] - mx);
        const float inv = 1.0f / wave_sum((e0 + e1) + (e2 + e3));
        u32x2 o; o.x = cvt_pk_bf16(e0 * inv, e1 * inv); o.y = cvt_pk_bf16(e2 * inv, e3 * inv);
        *(u32x2*)(PB + (size_t)it * 256 + 4 * lane) = o;
    }
}
__device__ __forceinline__ void ym_phase(const Params& p, int gw, int NGW, int lane) {
    const bf16_t* U = (const bf16_t*)(p.ws + WS_U); const bf16_t* HR = (const bf16_t*)(p.ws + WS_HRAW); bf16_t* YM = (bf16_t*)(p.ws + WS_YM);
    for (int it = gw; it < T * 8; it += NGW) {
        const int t = it >> 3, h = it & 7, c = h * 512 + 8 * lane;
        const u32x4 hv = *(const u32x4*)(HR + (size_t)t * 4096 + c);
        const u32x4 mo = *(const u32x4*)(U + (size_t)t * NU + UO + c), mz = *(const u32x4*)(U + (size_t)t * NU + UZ + c);
        const f32x4 w0 = *(const f32x4*)(p.mh_norm_w + c), w1 = *(const f32x4*)(p.mh_norm_w + c + 4);
        float v[8] = {bf_lo(hv.x), bf_hi(hv.x), bf_lo(hv.y), bf_hi(hv.y), bf_lo(hv.z), bf_hi(hv.z), bf_lo(hv.w), bf_hi(hv.w)};
        float s = 0.f;
#pragma unroll
        for (int j = 0; j < 8; ++j) s += v[j];
        const float mean = wave_sum(s) * (1.0f / 512.0f);
        float q = 0.f;
#pragma unroll
        for (int j = 0; j < 8; ++j) { v[j] -= mean; q += v[j] * v[j]; }
        const float rstd = 1.0f / sqrtf(wave_sum(q) * (1.0f / 512.0f) + LN_EPS);
        const float g[8] = {bf_lo(mo.x) * bf_lo(mz.x), bf_hi(mo.x) * bf_hi(mz.x), bf_lo(mo.y) * bf_lo(mz.y), bf_hi(mo.y) * bf_hi(mz.y),
                            bf_lo(mo.z) * bf_lo(mz.z), bf_hi(mo.z) * bf_hi(mz.z), bf_lo(mo.w) * bf_lo(mz.w), bf_hi(mo.w) * bf_hi(mz.w)};
        const float wv[8] = {w0[0], w0[1], w0[2], w0[3], w1[0], w1[1], w1[2], w1[3]};
        u32x4 o; unsigned ow[4];
#pragma unroll
        for (int j = 0; j < 4; ++j) ow[j] = cvt_pk_bf16(v[2 * j] * rstd * wv[2 * j] * g[2 * j], v[2 * j + 1] * rstd * wv[2 * j + 1] * g[2 * j + 1]);
        o.x = ow[0]; o.y = ow[1]; o.z = ow[2]; o.w = ow[3];
        *(u32x4*)(YM + (size_t)t * 4096 + c) = o;
    }
}
__device__ __forceinline__ void ln_phase(const Params& p, int gw, int NGW, int lane) {
    for (int m = gw; m < T; m += NGW) {
        f32x4* r = (f32x4*)(p.out + (size_t)m * D) + lane;
        f32x4 v[16]; float s = 0.f;
#pragma unroll
        for (int j = 0; j < 16; ++j) { v[j] = r[64 * j]; s += (v[j][0] + v[j][1]) + (v[j][2] + v[j][3]); }
        const float mean = wave_sum(s) * (1.0f / D); float q = 0.f;
#pragma unroll
        for (int j = 0; j < 16; ++j) { v[j] = v[j] - mean; q += (v[j][0] * v[j][0] + v[j][1] * v[j][1]) + (v[j][2] * v[j][2] + v[j][3] * v[j][3]); }
        const float rstd = 1.0f / sqrtf(wave_sum(q) * (1.0f / D) + LN_EPS);
#pragma unroll
        for (int j = 0; j < 16; ++j) { const f32x4 w = *((const f32x4*)p.ln_w + lane + 64 * j), b = *((const f32x4*)p.ln_b + lane + 64 * j); r[64 * j] = v[j] * rstd * w + b; }
    }
}

__device__ __forceinline__ void mlstm_naive(const Params& p, LAS unsigned char* lds, int unit, int wave, int lane) {
    const int s = unit & 7, h = (unit >> 3) & 7, b = unit >> 6;
    LAS float* part = (LAS float*)lds;
    LAS float* pden = part + 2 * 8 * 64;
    const bf16_t* Ub = (const bf16_t*)(p.ws + WS_U) + (size_t)(b * SEQ) * NU;
    bf16_t* HR = (bf16_t*)(p.ws + WS_HRAW) + (size_t)(b * SEQ) * 4096 + h * 512 + s * 64 + lane;
    float C[32], n[32];
#pragma unroll
    for (int d = 0; d < 32; ++d) { C[d] = 0.f; n[d] = 0.f; }
    float m = 0.f;
    for (int t = 0; t < SEQ; ++t) {
        const bf16_t* row = Ub + (size_t)t * NU;
        u32x4 kk[4], qq[4];
#pragma unroll
        for (int j = 0; j < 4; ++j) { kk[j] = *(const u32x4*)(row + UK + h * 256 + wave * 32 + 8 * j); qq[j] = *(const u32x4*)(row + UQ + h * 256 + wave * 32 + 8 * j); }
        const float vv = bf2f(row[UV + h * 512 + s * 64 + lane]);
        const float ig = bf2f(row[UI + h]), fp = bf2f(row[UF + h]);
        const float lf = fminf(fp, 0.f) - log1pf(__expf(-fabsf(fp)));
        const float mn = fmaxf(lf + m, ig), fd = __expf(lf + m - mn), iw = __expf(ig - mn);
        m = mn;
        float num = 0.f, den = 0.f;
#pragma unroll
        for (int j = 0; j < 4; ++j) {
            const unsigned kw[4] = {kk[j].x, kk[j].y, kk[j].z, kk[j].w}, qw[4] = {qq[j].x, qq[j].y, qq[j].z, qq[j].w};
#pragma unroll
            for (int e = 0; e < 4; ++e) {
                const int d = 8 * j + 2 * e;
                const float k0 = iw * bf_lo(kw[e]), k1 = iw * bf_hi(kw[e]), q0 = bf_lo(qw[e]), q1 = bf_hi(qw[e]);
                C[d] = fd * C[d] + k0 * vv; n[d] = fd * n[d] + k0; num += q0 * C[d]; den += q0 * n[d];
                C[d + 1] = fd * C[d + 1] + k1 * vv; n[d + 1] = fd * n[d + 1] + k1; num += q1 * C[d + 1]; den += q1 * n[d + 1];
            }
        }
        const int buf = t & 1;
        part[(buf * 8 + wave) * 64 + lane] = num; if (lane == 0) pden[buf * 8 + wave] = den;
        __syncthreads();
        if (wave == (t & 7)) {
            float nt_ = 0.f, dt_ = 0.f;
#pragma unroll
            for (int w = 0; w < 8; ++w) { nt_ += part[(buf * 8 + w) * 64 + lane]; dt_ += pden[buf * 8 + w]; }
            const float hv = nt_ / fmaxf(fabsf(dt_), __expf(-m));
            HR[(size_t)t * 4096] = (bf16_t)(cvt_pk_bf16(hv, 0.f) & 0xffffu);
        }
    }
    __syncthreads();
}

constexpr int ML_RS = 528, ML_VS = 160;
constexpr int ML_Q = 0, ML_K = 64 * ML_RS, ML_V = 2 * 64 * ML_RS, ML_VSC = ML_V + 64 * ML_VS, ML_CT = ML_VSC + 64 * ML_VS, ML_END = ML_CT + 80 * ML_RS;
static_assert(ML_END <= RING_BYTES, "mLSTM LDS map");
typedef short s16x4 __attribute__((ext_vector_type(4)));
__device__ __forceinline__ bf16x8 tr_pair(const LAS unsigned char* a0, const LAS unsigned char* a1) {
    const s16x4 lo = __builtin_amdgcn_ds_read_tr16_b64_v4i16((LAS s16x4*)a0), hi = __builtin_amdgcn_ds_read_tr16_b64_v4i16((LAS s16x4*)a1);
    return (bf16x8){lo[0], lo[1], lo[2], lo[3], hi[0], hi[1], hi[2], hi[3]};
}
__device__ __forceinline__ void mlstm_unit(const Params& p, LAS unsigned char* lds, int unit, int wave, int lane, int tid) {
    const int s = unit & 7, h = (unit >> 3) & 7, b = unit >> 6;
    const int g = lane >> 4, li = lane & 15, q4 = li >> 2, p4 = lane & 3;
    const int tt = wave >> 1, vh = wave & 1;
    const bf16_t* U = (const bf16_t*)(p.ws + WS_U) + (size_t)(b * SEQ) * NU;
    bf16_t* HR = (bf16_t*)(p.ws + WS_HRAW) + (size_t)(b * SEQ) * 4096 + h * 512 + s * 64;
    const int srow = tid >> 5, sch = tid & 31, vrow = tid >> 3, vch = tid & 7;
    for (int i = tid; i < (80 * ML_RS) / 16; i += NWAVES * 64) *(LAS u32x4*)(lds + ML_CT + 16 * i) = (u32x4){0u, 0u, 0u, 0u};
    if (tid < 64) {
        *(LAS u32x4*)(lds + ML_V + tid * ML_VS + 128) = (u32x4){0x3F80u, 0u, 0u, 0u}; *(LAS u32x4*)(lds + ML_V + tid * ML_VS + 144) = (u32x4){0u, 0u, 0u, 0u};
        *(LAS u32x4*)(lds + ML_VSC + tid * ML_VS + 128) = (u32x4){0u, 0u, 0u, 0u}; *(LAS u32x4*)(lds + ML_VSC + tid * ML_VS + 144) = (u32x4){0u, 0u, 0u, 0u};
    }
    f32x4 cacc[2][5];
#pragma unroll
    for (int a = 0; a < 2; ++a)
#pragma unroll
        for (int v = 0; v < 5; ++v) cacc[a][v] = (f32x4){0.f, 0.f, 0.f, 0.f};
    float m_st = 0.f;
    u32x4 rq[4], rk[4], rv; float ig_n, fp_n;
#define ML_PREFETCH(c) do { const bf16_t* base_ = U + (size_t)((c) * 64) * NU; \
        _Pragma("unroll") for (int i_ = 0; i_ < 4; ++i_) { rq[i_] = *(const u32x4*)(base_ + (size_t)(srow + 16 * i_) * NU + UQ + h * 256 + sch * 8); \
                                                          rk[i_] = *(const u32x4*)(base_ + (size_t)(srow + 16 * i_) * NU + UK + h * 256 + sch * 8); } \
        rv = *(const u32x4*)(base_ + (size_t)vrow * NU + UV + h * 512 + s * 64 + vch * 8); \
        ig_n = bf2f(base_[(size_t)lane * NU + UI + h]); fp_n = bf2f(base_[(size_t)lane * NU + UF + h]); } while (0)
    ML_PREFETCH(0);
    for (int c = 0; c < SEQ / 64; ++c) {
        const float ig = ig_n, fp = fp_n;
        const float lf = fminf(fp, 0.f) - log1pf(__expf(-fabsf(fp)));
        float bs = lf;
#pragma unroll
        for (int o = 1; o < 64; o <<= 1) { const float t_ = __shfl_up(bs, o); if (lane >= o) bs += t_; }
        const float Cj = ig - bs; float cm = Cj;
#pragma unroll
        for (int o = 1; o < 64; o <<= 1) { const float t_ = __shfl_up(cm, o); if (lane >= o) cm = fmaxf(cm, t_); }
        const float Mt = fmaxf(cm, m_st);
        const float gsum = __shfl(bs, 63), M63 = __shfl(Mt, 63);
        const float scale = __expf(Cj - M63), inter = __expf(m_st - Mt), emt = __expf(-(bs + Mt)), decay = __expf(m_st - M63);
        if (c > 0) {
#pragma unroll
            for (int a = 0; a < 2; ++a)
#pragma unroll
                for (int v = 0; v < 5; ++v) { u32x2 w; w.x = cvt_pk_bf16(cacc[a][v][0], cacc[a][v][1]); w.y = cvt_pk_bf16(cacc[a][v][2], cacc[a][v][3]);
                    *(LAS u32x2*)(lds + ML_CT + (16 * v + li) * ML_RS + (16 * (2 * wave + a) + 4 * g) * 2) = w; }
        }
#pragma unroll
        for (int i = 0; i < 4; ++i) { *(LAS u32x4*)(lds + ML_Q + (srow + 16 * i) * ML_RS + sch * 16) = rq[i]; *(LAS u32x4*)(lds + ML_K + (srow + 16 * i) * ML_RS + sch * 16) = rk[i]; }
        *(LAS u32x4*)(lds + ML_V + vrow * ML_VS + vch * 16) = rv;
        { const float sc = __shfl(scale, vrow); u32x4 o;
          o.x = cvt_pk_bf16(bf_lo(rv.x) * sc, bf_hi(rv.x) * sc); o.y = cvt_pk_bf16(bf_lo(rv.y) * sc, bf_hi(rv.y) * sc);
          o.z = cvt_pk_bf16(bf_lo(rv.z) * sc, bf_hi(rv.z) * sc); o.w = cvt_pk_bf16(bf_lo(rv.w) * sc, bf_hi(rv.w) * sc);
          *(LAS u32x4*)(lds + ML_VSC + vrow * ML_VS + vch * 16) = o; }
        if (tid < 64) *(LAS bf16_t*)(lds + ML_VSC + tid * ML_VS + 128) = (bf16_t)(cvt_pk_bf16(scale, 0.f) & 0xffffu);
        __syncthreads();
        if (c + 1 < SEQ / 64) ML_PREFETCH(c + 1);
        const int tcol = 16 * tt + li;
        const float Mt_t = __shfl(Mt, tcol), inter_t = __shfl(inter, tcol), emt_t = __shfl(emt, tcol);
        bf16x8 Bq[8]; f32x4 sacc[4];
#pragma unroll
        for (int j = 0; j < 4; ++j) sacc[j] = (f32x4){0.f, 0.f, 0.f, 0.f};
#pragma unroll
        for (int ks = 0; ks < 8; ++ks) {
            Bq[ks] = *(const LAS bf16x8*)(lds + ML_Q + tcol * ML_RS + g * 16 + ks * 64);
#pragma unroll
            for (int jt = 0; jt < 4; ++jt) if (jt <= tt) {
                const bf16x8 Ak = *(const LAS bf16x8*)(lds + ML_K + (16 * jt + li) * ML_RS + g * 16 + ks * 64);
                sacc[jt] = __builtin_amdgcn_mfma_f32_16x16x32_bf16(Ak, Bq[ks], sacc[jt], 0, 0, 0); }
        }
        bf16x8 sp[2];
#pragma unroll
        for (int ks2 = 0; ks2 < 2; ++ks2) {
            float sv[8];
#pragma unroll
            for (int e = 0; e < 8; ++e) { const int jt = 2 * ks2 + (e >> 2), j = 16 * jt + 4 * g + (e & 3);
                const float cj = __shfl(Cj, j);
                sv[e] = (j <= tcol) ? sacc[jt][e & 3] * __expf(cj - Mt_t) : 0.f; }
            const unsigned w0 = cvt_pk_bf16(sv[0], sv[1]), w1 = cvt_pk_bf16(sv[2], sv[3]), w2 = cvt_pk_bf16(sv[4], sv[5]), w3 = cvt_pk_bf16(sv[6], sv[7]);
            sp[ks2] = (bf16x8){(short)(w0 & 0xffff), (short)(w0 >> 16), (short)(w1 & 0xffff), (short)(w1 >> 16), (short)(w2 & 0xffff), (short)(w2 >> 16), (short)(w3 & 0xffff), (short)(w3 >> 16)};
        }
        f32x4 pacc[3];
#pragma unroll
        for (int a = 0; a < 3; ++a) pacc[a] = (f32x4){0.f, 0.f, 0.f, 0.f};
#pragma unroll
        for (int ks = 0; ks < 8; ++ks)
#pragma unroll
            for (int a = 0; a < 3; ++a) { const int vt = (a == 2) ? 4 : 2 * vh + a;
                const bf16x8 Ac = *(const LAS bf16x8*)(lds + ML_CT + (16 * vt + li) * ML_RS + g * 16 + ks * 64);
                pacc[a] = __builtin_amdgcn_mfma_f32_16x16x32_bf16(Ac, Bq[ks], pacc[a], 0, 0, 0); }
#pragma unroll
        for (int a = 0; a < 3; ++a) pacc[a] = pacc[a] * inter_t;
#pragma unroll
        for (int ks2 = 0; ks2 < 2; ++ks2)
#pragma unroll
            for (int a = 0; a < 3; ++a) { const int vt = (a == 2) ? 4 : 2 * vh + a;
                const LAS unsigned char* ad = lds + ML_V + (32 * ks2 + 4 * g + q4) * ML_VS + (16 * vt + 4 * p4) * 2;
                const bf16x8 Av = tr_pair(ad, ad + 16 * ML_VS);
                pacc[a] = __builtin_amdgcn_mfma_f32_16x16x32_bf16(Av, sp[ks2], pacc[a], 0, 0, 0); }
        { const float den = __shfl(pacc[2][0], li);
          const float inv = 1.0f / fmaxf(fabsf(den), emt_t);
          bf16_t* hp = HR + (size_t)(c * 64 + tcol) * 4096 + 4 * g;
#pragma unroll
          for (int a = 0; a < 2; ++a) { u32x2 w; w.x = cvt_pk_bf16(pacc[a][0] * inv, pacc[a][1] * inv); w.y = cvt_pk_bf16(pacc[a][2] * inv, pacc[a][3] * inv);
              *(u32x2*)(hp + 16 * (2 * vh + a)) = w; } }
#pragma unroll
        for (int a = 0; a < 2; ++a)
#pragma unroll
            for (int v = 0; v < 5; ++v) cacc[a][v] = cacc[a][v] * decay;
#pragma unroll
        for (int ks2 = 0; ks2 < 2; ++ks2) {
            bf16x8 Ak[2];
#pragma unroll
            for (int a = 0; a < 2; ++a) { const LAS unsigned char* ad = lds + ML_K + (32 * ks2 + 8 * g + q4) * ML_RS + (16 * (2 * wave + a) + 4 * p4) * 2; Ak[a] = tr_pair(ad, ad + 4 * ML_RS); }
#pragma unroll
            for (int v = 0; v < 5; ++v) { const LAS unsigned char* ad = lds + ML_VSC + (32 * ks2 + 8 * g + q4) * ML_VS + (16 * v + 4 * p4) * 2;
                const bf16x8 Bv = tr_pair(ad, ad + 4 * ML_VS);
#pragma unroll
                for (int a = 0; a < 2; ++a) cacc[a][v] = __builtin_amdgcn_mfma_f32_16x16x32_bf16(Ak[a], Bv, cacc[a][v], 0, 0, 0); }
        }
        m_st = gsum + M63;
        __syncthreads();
    }
#undef ML_PREFETCH
}

__global__ void __launch_bounds__(NWAVES * 64, 2) mk_fwd(Params p) {
    extern __shared__ __attribute__((aligned(16))) unsigned char lds_raw[];
    LAS unsigned char* lds = (LAS unsigned char*)lds_raw;
    volatile LAS unsigned* MISC = (volatile LAS unsigned*)(lds + MISC_OFF);
    const int tid = threadIdx.x, lane = tid & 63, wave = __builtin_amdgcn_readfirstlane(tid >> 6);
    const int G = gridDim.x, bx = blockIdx.x;
    const int vcu = (G % 8 == 0) ? (bx % 8) * (G / 8) + bx / 8 : bx;
    const int gw = vcu * NWAVES + wave, NGW = G * NWAVES;
    unsigned char* ws = p.ws;
    unsigned* ctl = (unsigned*)(ws + WS_CTL);
    for (int u = tid; u < (LDS_BYTES - LDSCTL_OFF) / 4; u += NWAVES * 64) ((LAS unsigned*)(lds + LDSCTL_OFF))[u] = 0u;
    __syncthreads();
    const bool one_launch = (p.ph_lo == 0 && p.ph_hi >= 8);
    XcdBarrier bar; bar.bar = ctl + CW_BAR; bar.x = 0; bar.st = nullptr;
    if (one_launch) bar = xcd_barrier_post(ctl + CW_BAR, MISC + 8);
    const int lo = p.ph_lo, hi = p.ph_hi;
#define IN(k) (lo <= (k) && (k) < hi)
#define GRID_BAR() do { if (one_launch) xcd_barrier(bar); } while (0)

    if (IN(0)) { p0_prologue(p, lds, gw, NGW, wave, lane); GRID_BAR(); }
    if (IN(1)) {
        SchedP1 S{G, bx, (const char*)(ws + WS_XB), (const char*)(ws + WS_MEMB), (const char*)(ws + WS_WINT), (const char*)(ws + WS_WKVT)};
        EpiP1 E{(bf16_t*)(ws + WS_U), (const float*)(ws + WS_BU), (bf16_t*)(ws + WS_KMEM), (bf16_t*)(ws + WS_VT)};
        pg8::gemm_phase<EpiP1, SchedP1, true, true>(lds, 8192, 8192, S, E);
        GRID_BAR();
    }
    if (IN(2)) {
        { SchedQK S{G, bx, (const char*)(ws + WS_U), (const char*)(ws + WS_KMEM)}; EpiSC E{(float*)(ws + WS_SC)};
          pg8::gemm_phase<EpiSC, SchedQK, true, true>(lds, NU * 2, 4096, S, E); }
        conv_phase(p, vcu * (NWAVES * 64) + tid, G * NWAVES * 64);
        __syncthreads();
        #if defined(MK_NAIVE_MLSTM)
        for (int unit = bx; unit < 256; unit += G) mlstm_naive(p, lds, unit, wave, lane);
#else
        for (int unit = bx; unit < 256; unit += G) mlstm_unit(p, lds, unit, wave, lane, tid);
#endif
        GRID_BAR();
    }
    if (IN(3)) { softmax_phase(p, gw, NGW, lane); ym_phase(p, gw, NGW, lane); GRID_BAR(); }
    if (IN(4)) {
        SchedPV S{G, bx, (const char*)(ws + WS_PB), (const char*)(ws + WS_VT)}; EpiPV E{(const bf16_t*)(ws + WS_U), (bf16_t*)(ws + WS_YCX)};
        pg8::gemm_phase<EpiPV, SchedPV, true, true>(lds, 2048, 2048, S, E);
        GRID_BAR();
    }
    if (IN(5)) {
        SchedMerge S{G, bx, (const char*)(ws + WS_YM), (const char*)(ws + WS_YCX), (const char*)(ws + WS_WPMT), (const char*)(ws + WS_WPCXT)};
        EpiMerge E{(const bf16_t*)(ws + WS_U), p.out, (bf16_t*)(ws + WS_MERGED)};
        pg8::gemm_phase<EpiMerge, SchedMerge, true, true>(lds, 8192, 8192, S, E);
        GRID_BAR();
    }
    if (IN(6)) {
        SchedOut S{G, bx, (const char*)(ws + WS_MERGED), (const char*)(ws + WS_WOT)}; EpiOut E{p.x, p.out};
        pg8::gemm_phase<EpiOut, SchedOut, true, true>(lds, 8192, 8192, S, E);
        GRID_BAR();
    }
    if (IN(7)) ln_phase(p, gw, NGW, lane);
#undef IN
#undef GRID_BAR
}

#ifndef MK_N_LAUNCHES
#define MK_N_LAUNCHES 1
#endif
extern "C" void kernel_launch(void* const* d_in, const int* in_sizes, int n_in, void* d_out, int out_size, void* d_ws, size_t ws_size, hipStream_t stream) {
    static int grid = 0;
    if (grid == 0) {
        if (n_in != 13 || out_size != T * D || ws_size < WS_END) { fprintf(stderr, "kernel_launch: unexpected shapes (n_in %d out %d ws %zu)\n", n_in, out_size, ws_size); grid = -1; return; }
        int dev = 0, cus = 0, per_cu = 0;
        if (hipGetDevice(&dev) != hipSuccess || hipDeviceGetAttribute(&cus, hipDeviceAttributeMultiprocessorCount, dev) != hipSuccess) { grid = -1; return; }
        if (hipFuncSetAttribute((const void*)mk_fwd, hipFuncAttributeMaxDynamicSharedMemorySize, LDS_BYTES) != hipSuccess) { fprintf(stderr, "kernel_launch: hipFuncSetAttribute failed\n"); grid = -1; return; }
        if (hipOccupancyMaxActiveBlocksPerMultiprocessor(&per_cu, (const void*)mk_fwd, NWAVES * 64, LDS_BYTES) != hipSuccess || per_cu < 1)
            fprintf(stderr, "kernel_launch: note: occupancy query reports %d\n", per_cu);
        (void)hipGetLastError();
        grid = cus;
    }
    if (grid < 0) return;
    (void)hipMemsetAsync((char*)d_ws + WS_CTL, 0, CTL_ZERO_BYTES, stream);
    Params p{};
    p.x = (const float*)d_in[0]; p.mem = (const float*)d_in[1]; p.w_in = (const float*)d_in[2]; p.b_in = (const float*)d_in[3];
    p.conv_w = (const float*)d_in[4]; p.mh_norm_w = (const float*)d_in[5]; p.w_mem_kv = (const float*)d_in[6]; p.w_proj_m = (const float*)d_in[7];
    p.w_proj_c = (const float*)d_in[8]; p.w_proj_x = (const float*)d_in[9]; p.w_out = (const float*)d_in[10]; p.ln_w = (const float*)d_in[11]; p.ln_b = (const float*)d_in[12];
    p.out = (float*)d_out; p.ws = (unsigned char*)d_ws;
    if (MK_N_LAUNCHES == 1) { p.ph_lo = 0; p.ph_hi = 8; hipLaunchKernelGGL(mk_fwd, dim3(grid), dim3(NWAVES * 64), LDS_BYTES, stream, p); }
    else for (int k = 0; k < 8; ++k) { p.ph_lo = k; p.ph_hi = k + 1; hipLaunchKernelGGL(mk_fwd, dim3(grid), dim3(NWAVES * 64), LDS_BYTES, stream, p); }
}
```

```cpp
#include <hip/hip_runtime.h>
#include <cstdio>
#include <cstdint>

#define LAS __attribute__((address_space(3)))
#define GAS __attribute__((address_space(1)))
typedef unsigned short bf16_t;
typedef short bf16x8 __attribute__((ext_vector_type(8)));
typedef float f32x4 __attribute__((ext_vector_type(4)));
typedef float f32x2 __attribute__((ext_vector_type(2)));
typedef unsigned u32x4 __attribute__((ext_vector_type(4)));
typedef unsigned u32x2 __attribute__((ext_vector_type(2)));

constexpr int NB = 4, SEQ = 2048, T = NB * SEQ, D = 4096;
constexpr int DIN = 40976, NU = 41216;
constexpr int MEMLEN = 256, TM = NB * MEMLEN;
constexpr int UQ = 0, UK = 2048, UV = 4096, UO = 8192, UZ = 12288, UCB = 16384, UCC = 18432, UCX = 20480, UCZ = 22528,
              UXQ = 24576, UXZ = 26624, UG = 28672, UI = 40960, UF = 40968;
constexpr float LN_EPS = 1e-5f;
constexpr float DN_ALPHA = 1.189207115002721f;

constexpr size_t MiB = 1u << 20;
constexpr size_t WS_CTL = 0, CTL_ZERO_BYTES = 1 * MiB;
constexpr size_t WS_BU = 1 * MiB;
constexpr size_t WS_XB = 2 * MiB;
constexpr size_t WS_MEMB = 66 * MiB;
constexpr size_t WS_WINT = 74 * MiB;
constexpr size_t WS_WKVT = 396 * MiB;
constexpr size_t WS_WPMT = 428 * MiB;
constexpr size_t WS_WPCXT = 460 * MiB;
constexpr size_t WS_WOT = 492 * MiB;
constexpr size_t WS_U = 524 * MiB;
constexpr size_t WS_KMEM = 1168 * MiB;
constexpr size_t WS_VT = 1172 * MiB;
constexpr size_t WS_SC = 1176 * MiB;
constexpr size_t WS_PB = 1208 * MiB;
constexpr size_t WS_HRAW = 1224 * MiB;
constexpr size_t WS_YM = 1288 * MiB;
constexpr size_t WS_YCX = 1352 * MiB;
constexpr size_t WS_MERGED = 1416 * MiB;
constexpr size_t WS_END = 1480 * MiB;
constexpr int CW_BAR = 4096;

constexpr int RING_BYTES = 131072;
constexpr int LDSCTL_OFF = RING_BYTES, MISC_OFF = LDSCTL_OFF + 320;
constexpr int EPI_OFF = RING_BYTES + 1024, EPI_WAVE_BYTES = 16 * 144;
constexpr int LDS_BYTES = 163840;
static_assert(EPI_OFF + 8 * EPI_WAVE_BYTES <= LDS_BYTES, "LDS map");
constexpr int NWAVES = 8;

__device__ __forceinline__ unsigned cvt_pk_bf16(float lo, float hi) { unsigned r; asm("v_cvt_pk_bf16_f32 %0, %1, %2" : "=v"(r) : "v"(lo), "v"(hi)); return r; }
__device__ __forceinline__ float bf_lo(unsigned w) { return __uint_as_float(w << 16); }
__device__ __forceinline__ float bf_hi(unsigned w) { return __uint_as_float(w & 0xffff0000u); }
__device__ __forceinline__ float bf2f(bf16_t h) { return __uint_as_float(((unsigned)h) << 16); }
__device__ __forceinline__ float sigmoidf_(float x) { return __builtin_amdgcn_rcpf(1.0f + __expf(-x)); }
__device__ __forceinline__ float wave_sum(float v) {
#pragma unroll
    for (int o = 1; o < 64; o <<= 1) v += __shfl_xor(v, o);
    return v;
}
__device__ __forceinline__ float wave_max(float v) {
#pragma unroll
    for (int o = 1; o < 64; o <<= 1) v = fmaxf(v, __shfl_xor(v, o));
    return v;
}
#define LDS_WAIT() asm volatile("s_waitcnt lgkmcnt(0)" ::: "memory")
#define VM_WAIT() asm volatile("s_waitcnt vmcnt(0)" ::: "memory")

namespace pg8 {
constexpr int BM = 256, BK = 64, HALF = 128, HTB = HALF * BK * 2, STAGE_BYTES = 8 * HTB;
__host__ __device__ __forceinline__ int lds_byte(int r, int c) { const int st = (r >> 4) * 2 + (c >> 5), rr = r & 15, cc = c & 31, ob = rr * 64 + cc * 2; return st * 1024 + (ob ^ (((ob >> 9) & 1) << 5)); }
__host__ __device__ __forceinline__ void stage_rc(int b, int& R, int& C) { const int st = b / 1024, sb = b % 1024, swz = sb ^ (((sb >> 9) & 1) << 5); R = (st >> 1) * 16 + swz / 64; C = (st & 1) * 32 + (swz % 64) / 2; }
__host__ __device__ __forceinline__ int perm32(int rho) { const int n = rho >> 4, i = rho & 15; return 8 * (i >> 2) + 4 * n + (i & 3); }

struct Unit { const char* A; const char* B; int nt, pm, pn, kind; };

__device__ __forceinline__ bool tile_map(long L, int nM, int nN, int& pm, int& pn) {
    const int nwg = nM * nN; if (L >= nwg) return false;
    int wgid = (int)L; { const int q = nwg / 8, r = nwg % 8, xcd = wgid % 8, off = wgid / 8; wgid = (xcd < r ? xcd * (q + 1) : r * (q + 1) + (xcd - r) * q) + off; }
    const int nig = 8 * nN, gid = wgid / nig, fm = gid * 8, gsz = (nM - fm) < 8 ? (nM - fm) : 8;
    pm = fm + ((wgid % nig) % gsz); pn = (wgid % nig) / gsz; return true;
}

template <class Epi, class Sched, bool ALIGN_EPI, bool SP2, bool APACK, bool BPACK>
__device__ __forceinline__ void gemm_phase(LAS unsigned char* lds, const int lda, const int ldb, const Sched& S, const Epi& E) {
    const int tid = threadIdx.x, wid = __builtin_amdgcn_readfirstlane(tid >> 6), lane = tid & 63, wr = wid >> 2, wc = wid & 3, fr = lane & 15, fq = lane >> 4;
    unsigned voffA[2], voffB[2];
#pragma unroll
    for (int i = 0; i < 2; ++i) { int R, C; stage_rc(tid * 16 + i * 8192, R, C); const int Rb = Epi::PERM ? ((R & ~31) + perm32(R & 31)) : R;
        voffA[i] = APACK ? (unsigned)(tid * 16 + i * 8192) : (unsigned)(R * lda + C * 2); voffB[i] = BPACK ? (unsigned)(tid * 16 + i * 8192) : (unsigned)(Rb * ldb + C * 2); }
    const size_t kstepA = APACK ? (size_t)16384 : (size_t)(BK * 2), kstepB = BPACK ? (size_t)16384 : (size_t)(BK * 2);
    const size_t hstepA = APACK ? (size_t)lda : (size_t)HALF * lda, hstepB = BPACK ? (size_t)ldb : (size_t)HALF * ldb;
    const unsigned ldsw = (unsigned)wid * 1024u;
    const int aoff = lds_byte(wr * 64 + fr, fq * 8), boff = lds_byte(wc * 32 + fr, fq * 8);
#define PG8_SA(b, h) (((b) * 2 + (h)) * HTB)
#define PG8_SB(b, h) ((4 + (b) * 2 + (h)) * HTB)
#define PG8_STAGE(bufoff, gbase, voff) do { _Pragma("unroll") for (int _i = 0; _i < 2; ++_i) \
        __builtin_amdgcn_global_load_lds((const unsigned*)((const char*)(gbase) + (voff)[_i]), (LAS unsigned*)(lds + (bufoff) + ldsw + _i * 8192), 16, 0, 0); } while (0)
#define PG8_LDA(dst, b, h) do { _Pragma("unroll") for (int m = 0; m < 4; ++m) _Pragma("unroll") for (int k = 0; k < 2; ++k) dst[m][k] = *(const LAS bf16x8*)(lds + PG8_SA(b, h) + aoff + m * 2048 + k * 1024); } while (0)
#define PG8_LDB(dst, b, h) do { _Pragma("unroll") for (int n = 0; n < 2; ++n) _Pragma("unroll") for (int k = 0; k < 2; ++k) dst[n][k] = *(const LAS bf16x8*)(lds + PG8_SB(b, h) + boff + n * 2048 + k * 1024); } while (0)
#define PG8_MMA(ai, bj, At, Bt) do { __builtin_amdgcn_s_setprio(1); _Pragma("unroll") for (int m = 0; m < 4; ++m) _Pragma("unroll") for (int n = 0; n < 2; ++n) _Pragma("unroll") for (int k = 0; k < 2; ++k) \
        acc[ai][bj][m][n] = __builtin_amdgcn_mfma_f32_16x16x32_bf16(Bt[n][k], At[m][k], acc[ai][bj][m][n], 0, 0, 0); __builtin_amdgcn_s_setprio(0); } while (0)
#define PG8_WAIT_V(n) asm volatile("s_waitcnt vmcnt(" #n ")" ::: "memory")
#define PG8_WAIT_L(n) asm volatile("s_waitcnt lgkmcnt(" #n ")" ::: "memory")
#define PG8_BAR __builtin_amdgcn_s_barrier()
#define PG8_SCHED __builtin_amdgcn_sched_barrier(0)
    Unit cur, nxt; int ui = 0;
    if (!S.next(0, cur)) return;
    f32x4 acc[2][2][4][2];
#pragma unroll
    for (int a = 0; a < 2; ++a)
#pragma unroll
        for (int b = 0; b < 2; ++b)
#pragma unroll
            for (int m = 0; m < 4; ++m)
#pragma unroll
                for (int n = 0; n < 2; ++n) acc[a][b][m][n] = (f32x4){0.f, 0.f, 0.f, 0.f};
    bf16x8 At[4][2], B0[2][2], B1[2][2];
    const char* cA = cur.A; const char* cB = cur.B;
    if constexpr (SP2) {
        PG8_STAGE(PG8_SB(0, 0), cB, voffB); PG8_STAGE(PG8_SB(0, 1), cB + hstepB, voffB); PG8_STAGE(PG8_SA(0, 0), cA, voffA); PG8_STAGE(PG8_SA(0, 1), cA + hstepA, voffA);
        if (wr == 1) PG8_BAR;
        PG8_WAIT_V(2); PG8_BAR;
        PG8_STAGE(PG8_SB(1, 0), cB + kstepB, voffB); PG8_STAGE(PG8_SA(1, 0), cA + kstepA, voffA); PG8_STAGE(PG8_SB(1, 1), cB + hstepB + kstepB, voffB);
        PG8_WAIT_V(6); PG8_BAR;
    } else {
        PG8_STAGE(PG8_SB(0, 0), cB, voffB); PG8_STAGE(PG8_SA(0, 0), cA, voffA); PG8_STAGE(PG8_SB(0, 1), cB + hstepB, voffB); PG8_STAGE(PG8_SA(0, 1), cA + hstepA, voffA);
        if (wr == 1) PG8_BAR;
        PG8_WAIT_V(4); PG8_BAR;
        PG8_STAGE(PG8_SB(1, 0), cB + kstepB, voffB); PG8_STAGE(PG8_SA(1, 0), cA + kstepA, voffA); PG8_STAGE(PG8_SB(1, 1), cB + hstepB + kstepB, voffB);
        PG8_WAIT_V(6); PG8_BAR;
    }
    for (;;) {
        const bool has_next = S.next(ui + 1, nxt);
        const char* nA = has_next ? nxt.A : cA; const char* nB = has_next ? nxt.B : cB;
        const int nt = cur.nt;
#pragma clang loop unroll(disable)
        for (int t = 0; t < nt; t += 2) {
            const bool last = (t == nt - 2);
            const char* a1 = cA + (size_t)(t + 1) * kstepA;
            const char* a2 = last ? nA : cA + (size_t)(t + 2) * kstepA; const char* b2 = last ? nB : cB + (size_t)(t + 2) * kstepB;
            const char* a3 = a2 + kstepA; const char* b3 = b2 + kstepB;
            if constexpr (SP2) {
            PG8_LDB(B0, 0, 0); PG8_LDB(B1, 0, 1); PG8_SCHED; PG8_LDA(At, 0, 0); PG8_STAGE(PG8_SA(1, 1), a1 + hstepA, voffA);
            PG8_WAIT_V(8); PG8_WAIT_L(0); PG8_BAR; PG8_MMA(0, 0, At, B0); PG8_MMA(0, 1, At, B1); PG8_BAR; PG8_SCHED;
            PG8_LDA(At, 0, 1); PG8_STAGE(PG8_SB(0, 0), b2, voffB); PG8_STAGE(PG8_SB(0, 1), b2 + hstepB, voffB); PG8_STAGE(PG8_SA(0, 0), a2, voffA);
            PG8_WAIT_V(8); PG8_WAIT_L(0); PG8_BAR; PG8_MMA(1, 0, At, B0); PG8_MMA(1, 1, At, B1); PG8_BAR; PG8_SCHED;
            PG8_LDB(B0, 1, 0); PG8_LDB(B1, 1, 1); PG8_SCHED; PG8_LDA(At, 1, 0); PG8_STAGE(PG8_SA(0, 1), a2 + hstepA, voffA);
            PG8_WAIT_V(8); PG8_WAIT_L(0); PG8_BAR; PG8_MMA(0, 0, At, B0); PG8_MMA(0, 1, At, B1); PG8_BAR; PG8_SCHED;
            PG8_LDA(At, 1, 1); PG8_STAGE(PG8_SB(1, 0), b3, voffB); PG8_STAGE(PG8_SB(1, 1), b3 + hstepB, voffB); PG8_STAGE(PG8_SA(1, 0), a3, voffA);
            PG8_WAIT_V(8); PG8_WAIT_L(0); PG8_BAR; PG8_MMA(1, 0, At, B0); PG8_MMA(1, 1, At, B1); PG8_BAR; PG8_SCHED;
            } else {
            PG8_LDB(B0, 0, 0); PG8_SCHED; PG8_LDA(At, 0, 0); PG8_STAGE(PG8_SA(1, 1), a1 + hstepA, voffA);
            PG8_WAIT_L(8); PG8_BAR; PG8_WAIT_L(0); PG8_MMA(0, 0, At, B0); PG8_BAR; PG8_SCHED;
            PG8_LDB(B1, 0, 1); PG8_STAGE(PG8_SB(0, 0), b2, voffB);
            PG8_BAR; PG8_WAIT_L(0); PG8_MMA(0, 1, At, B1); PG8_BAR;
            PG8_LDA(At, 0, 1); PG8_STAGE(PG8_SA(0, 0), a2, voffA);
            PG8_BAR; PG8_WAIT_L(0); PG8_MMA(1, 0, At, B0); PG8_BAR; PG8_SCHED;
            PG8_STAGE(PG8_SB(0, 1), b2 + hstepB, voffB);
            PG8_WAIT_V(6); PG8_BAR; PG8_MMA(1, 1, At, B1); PG8_BAR;
            PG8_LDB(B0, 1, 0); PG8_SCHED; PG8_LDA(At, 1, 0); PG8_STAGE(PG8_SA(0, 1), a2 + hstepA, voffA);
            PG8_WAIT_L(8); PG8_BAR; PG8_WAIT_L(0); PG8_MMA(0, 0, At, B0); PG8_BAR; PG8_SCHED;
            PG8_LDB(B1, 1, 1); PG8_STAGE(PG8_SB(1, 0), b3, voffB);
            PG8_BAR; PG8_WAIT_L(0); PG8_MMA(0, 1, At, B1); PG8_BAR;
            PG8_LDA(At, 1, 1); PG8_STAGE(PG8_SA(1, 0), a3, voffA);
            PG8_BAR; PG8_WAIT_L(0); PG8_MMA(1, 0, At, B0); PG8_BAR; PG8_SCHED;
            PG8_STAGE(PG8_SB(1, 1), b3 + hstepB, voffB);
            PG8_WAIT_V(6); PG8_BAR; PG8_MMA(1, 1, At, B1); PG8_BAR;
            }
        }
        if constexpr (ALIGN_EPI) { if (wr == 0) PG8_BAR; }
        E(acc, cur, wr, wc, fr, fq);
        if (!has_next) break;
        if (!(Epi::KEEP && cur.kind != 2)) {
#pragma unroll
        for (int a = 0; a < 2; ++a)
#pragma unroll
            for (int b = 0; b < 2; ++b)
#pragma unroll
                for (int m = 0; m < 4; ++m)
#pragma unroll
                    for (int n = 0; n < 2; ++n) acc[a][b][m][n] = (f32x4){0.f, 0.f, 0.f, 0.f};
        }
        cur = nxt; cA = nA; cB = nB; ++ui;
        if constexpr (ALIGN_EPI) { if (wr == 1) PG8_BAR; }
    }
    PG8_WAIT_V(0);
    if constexpr (!ALIGN_EPI) { if (wr == 0) PG8_BAR; }
    PG8_BAR;
#undef PG8_SA
#undef PG8_SB
#undef PG8_STAGE
#undef PG8_LDA
#undef PG8_LDB
#undef PG8_MMA
#undef PG8_WAIT_V
#undef PG8_WAIT_L
#undef PG8_BAR
#undef PG8_SCHED
}
}
using pg8::Unit;
constexpr size_t PKB = 16384;
__device__ __forceinline__ size_t pk_off(int row, int col, int ktiles) { return ((size_t)(row >> 7) * ktiles + (col >> 6)) * PKB + pg8::lds_byte(row & 127, col & 63); }

#define XB_TMO      128
#define XB_XCNT(j)  (256  + 64 * (j))
#define XB_XSUB(j)  (1280 + 64 * (j))
#define XB_XGEN(j)  (2304 + 64 * (j))
#define XB_TOP      3328
#define XB_TOPGEN   3392
#define XCD_BAR_WORDS 3456
#define XB_SPIN_CAP (1u << 18)

__device__ __forceinline__ unsigned xb_ld(unsigned* p)              { return __hip_atomic_load(p, __ATOMIC_RELAXED, __HIP_MEMORY_SCOPE_AGENT); }
__device__ __forceinline__ unsigned xb_add(unsigned* p, unsigned v) { return __hip_atomic_fetch_add(p, v, __ATOMIC_RELAXED, __HIP_MEMORY_SCOPE_AGENT); }
__device__ __forceinline__ unsigned xb_xcc_id() { return (unsigned)__builtin_amdgcn_s_getreg((3 << 11) | 20) & 0xFu; }
#define XB_SPIN(cond, bar) do { unsigned _sp = 0; while (cond) { __builtin_amdgcn_s_sleep(1); \
    if ((++_sp & 255u) == 0u) { if (xb_ld(&(bar)[XB_TMO])) break; if (_sp > XB_SPIN_CAP) { atomicAdd(&(bar)[XB_TMO], 1u); break; } } } } while (0)

struct XcdBarrier { unsigned* bar; unsigned x; volatile LAS unsigned* st; };

__device__ __forceinline__ XcdBarrier xcd_barrier_post(unsigned* bar, volatile LAS unsigned* st) {
    XcdBarrier b; b.bar = bar; b.x = xb_xcc_id(); b.st = st;
    if (threadIdx.x == 0) (void)xb_add(&bar[XB_XCNT(b.x)], 1u);
    return b;
}
__device__ __forceinline__ void xcd_barrier_complete(unsigned* bar, unsigned x, unsigned& nloc, unsigned& nx) {
    const unsigned G = gridDim.x * gridDim.y * gridDim.z;
    unsigned sum, cnt, mine, sp = 0u;
    for (;;) {
        sum = 0u; cnt = 0u; mine = 0u;
#pragma unroll
        for (unsigned j = 0; j < 16; ++j) { const unsigned c = xb_ld(&bar[XB_XCNT(j)]); sum += c; cnt += (c > 0u) ? 1u : 0u; mine = (j == x) ? c : mine; }
        if (sum == G) break;
        __builtin_amdgcn_s_sleep(1);
        if ((++sp & 255u) == 0u) { if (xb_ld(&bar[XB_TMO])) break; if (sp > XB_SPIN_CAP) { atomicAdd(&bar[XB_TMO], 1u); break; } }
    }
    nloc = mine > 0u ? mine : 1u; nx = cnt > 0u ? cnt : 1u;
}
__device__ __forceinline__ void xcd_barrier(const XcdBarrier& b) {
    asm volatile("s_waitcnt vmcnt(0)" ::: "memory");
    __syncthreads();
    if (threadIdx.x == 0) {
        unsigned* bar = b.bar;
        __builtin_amdgcn_s_waitcnt(0);
        unsigned nloc = b.st[0], nx = b.st[1];
        if (nloc == 0u) { xcd_barrier_complete(bar, b.x, nloc, nx); b.st[0] = nloc; b.st[1] = nx; }
        const unsigned old = xb_add(&bar[XB_XSUB(b.x)], 1u);
        const unsigned gen = old / nloc;
        if (old + 1u == (gen + 1u) * nloc) {
            __builtin_amdgcn_fence(__ATOMIC_RELEASE, "agent");
            asm volatile("s_waitcnt vmcnt(0)" ::: "memory");
            const unsigned og = xb_add(&bar[XB_TOP], 1u);
            const unsigned tg = og / nx;
            if (og + 1u == (tg + 1u) * nx) xb_add(&bar[XB_TOPGEN], 1u);
            else XB_SPIN(xb_ld(&bar[XB_TOPGEN]) == tg, bar);
            __builtin_amdgcn_fence(__ATOMIC_ACQUIRE, "agent");
            xb_add(&bar[XB_XGEN(b.x)], 1u);
            asm volatile("s_waitcnt vmcnt(0)" ::: "memory");
        } else {
            XB_SPIN(xb_ld(&bar[XB_XGEN(b.x)]) == gen, bar);
            __builtin_amdgcn_fence(__ATOMIC_ACQUIRE, "agent");
            asm volatile("s_waitcnt vmcnt(0)" ::: "memory");
        }
    }
    __syncthreads();
}

struct Params {
    const float *x, *mem, *w_in, *b_in, *conv_w, *mh_norm_w, *w_mem_kv, *w_proj_m, *w_proj_c, *w_proj_x, *w_out, *ln_w, *ln_b;
    float* out; unsigned char* ws;
    int ph_lo, ph_hi;
};

__device__ __forceinline__ void transpose_item_pk(const float* src, size_t src_ld, int col0, int ncv, unsigned char* img, int ktiles, int n0, int k0, LAS unsigned* scr, int lane, int kdst_off = 0) {
    const float* sp = src + (size_t)k0 * src_ld + col0 + lane;
    if (ncv > 0) {
#pragma unroll 8
        for (int i = 0; i < 32; ++i) {
            float a = 0.f, b = 0.f;
            if (lane < ncv) { a = sp[(size_t)(2 * i) * src_ld]; b = sp[(size_t)(2 * i + 1) * src_ld]; }
            scr[i * 66 + lane] = cvt_pk_bf16(a, b);
        }
    } else {
#pragma unroll 8
        for (int i = 0; i < 32; ++i) scr[i * 66 + lane] = 0u;
    }
    LDS_WAIT(); asm volatile("" ::: "memory");
    const int rr = lane >> 2, ch = lane & 3;
    unsigned char* blk = img + ((size_t)(2 * (n0 >> 8)) * ktiles + ((k0 + kdst_off) >> 6)) * PKB;
    const int wcs = (n0 >> 6) & 3;
#pragma unroll
    for (int sub = 0; sub < 8; ++sub) {
        const int grp = sub >> 2, np = (sub >> 1) & 1, k32 = sub & 1;
        const int nl = 32 * grp + 8 * (rr >> 2) + 4 * np + (rr & 3);
        const LAS unsigned* s = scr + (16 * k32 + 4 * ch) * 66 + nl;
        u32x4 o; o.x = s[0]; o.y = s[66]; o.z = s[132]; o.w = s[198];
        const int rho = 32 * wcs + 16 * np + rr;
        *(u32x4*)(blk + (size_t)grp * ktiles * PKB + pg8::lds_byte(rho, 32 * k32 + 8 * ch)) = o;
    }
    LDS_WAIT(); asm volatile("" ::: "memory");
}
__device__ __forceinline__ void cvt_item_pk(const float* src, unsigned char* img, int item, int lane) {
    const int rg = item >> 7, cg = item & 127, rr = lane >> 2, ch = lane & 3, row = rg * 16 + rr, col = cg * 32 + 8 * ch;
    const f32x4 a = *(const f32x4*)(src + (size_t)row * 4096 + col), b = *(const f32x4*)(src + (size_t)row * 4096 + col + 4);
    u32x4 o; o.x = cvt_pk_bf16(a[0], a[1]); o.y = cvt_pk_bf16(a[2], a[3]); o.z = cvt_pk_bf16(b[0], b[1]); o.w = cvt_pk_bf16(b[2], b[3]);
    *(u32x4*)(img + pk_off(row, col, 64)) = o;
}
__device__ __forceinline__ void p0_prologue(const Params& p, LAS unsigned char* lds, int gw, int NGW, int wave, int lane) {
    LAS unsigned* scr = (LAS unsigned*)(lds + wave * 8448);
    unsigned char* ws = p.ws;
    constexpr int I_IN = 64 * 644, I_KV = 64 * 64, I_PM = 64 * 64, I_PC = 32 * 64, I_PX = 32 * 64, I_O = 64 * 64;
    constexpr int NITEMS = I_IN + I_KV + I_PM + I_PC + I_PX + I_O;
    for (int it = gw; it < NITEMS; it += NGW) {
        int r = it;
        if (r < I_IN) { const int kb = r / 644, nb = r % 644, n0 = nb * 64; int col0, ncv;
            if (n0 < 16384) { col0 = n0; ncv = 64; } else if (n0 < 40960) { col0 = n0 + 16; ncv = 64; } else if (n0 == 40960) { col0 = 16384; ncv = 16; } else { col0 = 0; ncv = 0; }
            transpose_item_pk(p.w_in, DIN, col0, ncv, ws + WS_WINT, 64, n0, kb * 64, scr, lane); continue; }
        r -= I_IN;
        if (r < I_KV) { transpose_item_pk(p.w_mem_kv, 4096, (r % 64) * 64, 64, ws + WS_WKVT, 64, (r % 64) * 64, (r / 64) * 64, scr, lane); continue; }
        r -= I_KV;
        if (r < I_PM) { transpose_item_pk(p.w_proj_m, 4096, (r % 64) * 64, 64, ws + WS_WPMT, 64, (r % 64) * 64, (r / 64) * 64, scr, lane); continue; }
        r -= I_PM;
        if (r < I_PC) { transpose_item_pk(p.w_proj_c, 4096, (r % 64) * 64, 64, ws + WS_WPCXT, 64, (r % 64) * 64, (r / 64) * 64, scr, lane); continue; }
        r -= I_PC;
        if (r < I_PX) { transpose_item_pk(p.w_proj_x, 4096, (r % 64) * 64, 64, ws + WS_WPCXT, 64, (r % 64) * 64, (r / 64) * 64, scr, lane, 2048); continue; }
        r -= I_PX;
        transpose_item_pk(p.w_out, 4096, (r % 64) * 64, 64, ws + WS_WOT, 64, (r % 64) * 64, (r / 64) * 64, scr, lane);
    }
    for (int it = gw; it < (T / 16) * 128; it += NGW) cvt_item_pk(p.x, ws + WS_XB, it, lane);
    for (int it = gw; it < (TM / 16) * 128; it += NGW) cvt_item_pk(p.mem, ws + WS_MEMB, it, lane);
    float* BU = (float*)(ws + WS_BU);
    for (int c = gw * 64 + lane; c < NU; c += NGW * 64) {
        float v = 0.f;
        if (c < 16384) v = p.b_in[c]; else if (c < 40960) v = p.b_in[c + 16]; else if (c < 40976) v = p.b_in[16384 + (c - 40960)];
        BU[c] = v;
    }
}

__device__ __forceinline__ int act_of(int c0) {
    if (c0 >= UO && c0 < UZ) return 1;
    if (c0 >= UZ && c0 < UCB) return 2;
    if (c0 >= UCZ && c0 < UXQ) return 2;
    if (c0 >= UXZ && c0 < UG) return 2;
    if (c0 >= UG && c0 < UI) return 1;
    return 0;
}
struct SchedP1 {
    int G, c; const char *xb, *memb, *wint, *wkvt;
    __device__ __forceinline__ bool next(int i, Unit& u) const {
        long L = (long)i * G + c;
        if (L < 5152) { pg8::tile_map(L, 32, 161, u.pm, u.pn); u.A = xb + (size_t)u.pm * (128 * PKB); u.B = wint + (size_t)u.pn * (128 * PKB); u.nt = 64; u.kind = 0; return true; }
        L -= 5152;
        if (L < 64) { u.pm = (int)L / 16; u.pn = (int)L % 16; u.A = memb + (size_t)u.pm * (128 * PKB); u.B = wkvt + (size_t)u.pn * (128 * PKB); u.nt = 64; u.kind = 1; return true; }
        return false;
    }
};
struct EpiP1 {
    static constexpr bool PERM = true, KEEP = false;
    bf16_t* U; const float* bU; bf16_t* KMEM; bf16_t* VT; LAS unsigned char* lds;
    __device__ __forceinline__ void operator()(f32x4 (&acc)[2][2][4][2], const Unit& u, int wr, int wc, int fr, int fq) const {
        asm volatile("" : "+v"(fr), "+v"(fq));
#if defined(MK_PROBE_EPI_OFF)
        if (u.kind != 77) return;
#endif
        const int row0 = wr * 64 + fr, col0 = wc * 64 + 8 * fq;
        if (u.kind == 1 && u.pn >= 8) {
            bf16_t* vb = VT + (size_t)((u.pn - 8) * 256 + col0) * 1024 + u.pm * 256 + row0;
#pragma unroll
            for (int ai = 0; ai < 2; ++ai)
#pragma unroll
                for (int m = 0; m < 4; ++m)
#pragma unroll
                    for (int bj = 0; bj < 2; ++bj)
#pragma unroll
                        for (int n = 0; n < 2; ++n)
#pragma unroll
                            for (int j = 0; j < 4; j += 2) { const unsigned w = cvt_pk_bf16(acc[ai][bj][m][n][j], acc[ai][bj][m][n][j + 1]);
                                bf16_t* q = vb + (size_t)(bj * 32 + 4 * n + j) * 1024 + ai * 128 + m * 16;
                                q[0] = (bf16_t)(w & 0xffffu); q[1024] = (bf16_t)(w >> 16); }
            return;
        }
        bf16_t* base; int ldc; const float* bias; int act = 0; float sc = 1.f;
        if (u.kind == 0) { const int c0 = u.pn * 256; base = U + (size_t)u.pm * 256 * NU + c0; ldc = NU; bias = bU + c0; act = act_of(c0); if (c0 < UK) sc = 0.0625f; }
        else { base = KMEM + (size_t)u.pm * 256 * 2048 + u.pn * 256; ldc = 2048; bias = nullptr; }
        f32x4 bv[2][2];
#pragma unroll
        for (int bj = 0; bj < 2; ++bj)
#pragma unroll
            for (int n = 0; n < 2; ++n) bv[bj][n] = bias ? *(const f32x4*)(bias + col0 + bj * 32 + 4 * n) : (f32x4){0.f, 0.f, 0.f, 0.f};
        const int wid = wr * 4 + wc, lane = fr + 16 * fq;
        LAS unsigned char* stg = lds + EPI_OFF + wid * EPI_WAVE_BYTES;
        LAS unsigned char* wp = stg + fr * 144 + fq * 16;
        const LAS unsigned char* rp = stg + (lane >> 3) * 144 + (lane & 7) * 16;
        bf16_t* gp = base + (size_t)(wr * 64 + (lane >> 3)) * ldc + wc * 64 + (lane & 7) * 8;
#pragma unroll
        for (int ai = 0; ai < 2; ++ai)
#pragma unroll
            for (int m = 0; m < 4; ++m) {
#pragma unroll
                for (int bj = 0; bj < 2; ++bj) { f32x4 v0 = acc[ai][bj][m][0] + bv[bj][0], v1 = acc[ai][bj][m][1] + bv[bj][1];
                    if (act) {
#pragma unroll
                        for (int j = 0; j < 4; ++j) { const float s0 = sigmoidf_(v0[j]), s1 = sigmoidf_(v1[j]); v0[j] = (act == 1) ? s0 : v0[j] * s0; v1[j] = (act == 1) ? s1 : v1[j] * s1; } }
                    v0 = v0 * sc; v1 = v1 * sc;
                    u32x4 w; w.x = cvt_pk_bf16(v0[0], v0[1]); w.y = cvt_pk_bf16(v0[2], v0[3]); w.z = cvt_pk_bf16(v1[0], v1[1]); w.w = cvt_pk_bf16(v1[2], v1[3]);
                    *(LAS u32x4*)(wp + bj * 64) = w; }
                asm volatile("" ::: "memory");
                const u32x4 o0 = *(const LAS u32x4*)rp, o1 = *(const LAS u32x4*)(rp + 8 * 144);
                asm volatile("" ::: "memory");
                bf16_t* g0 = gp + (size_t)(ai * 128 + m * 16) * ldc;
                __builtin_nontemporal_store(o0, (u32x4*)g0); __builtin_nontemporal_store(o1, (u32x4*)(g0 + (size_t)8 * ldc)); }
    }
};
struct SchedQK {
    int G, c; const char *u, *kmem;
    __device__ __forceinline__ bool next(int i, Unit& un) const {
        const int L = i * G + c; if (L >= 128) return false;
        const int head = L & 3, rt = L >> 2;
        un.pm = rt; un.pn = head; un.A = u + ((size_t)rt * 256 * NU + UXQ + head * 512) * 2; un.B = kmem + ((size_t)(rt >> 3) * 256 * 2048 + head * 512) * 2; un.nt = 8; un.kind = 0; return true;
    }
};
struct EpiSC {
    static constexpr bool PERM = false, KEEP = false;
    float* SC;
    __device__ __forceinline__ void operator()(f32x4 (&acc)[2][2][4][2], const Unit& u, int wr, int wc, int fr, int fq) const {
        asm volatile("" : "+v"(fr), "+v"(fq));
        const float sc = 0.04419417382415922f;
        float* base = SC + (size_t)u.pm * 256 * 1024 + u.pn * 256;
        const int row0 = wr * 64 + fr, col0 = wc * 32 + 4 * fq;
#pragma unroll
        for (int ai = 0; ai < 2; ++ai)
#pragma unroll
            for (int m = 0; m < 4; ++m) { float* rowp = base + (size_t)(row0 + ai * 128 + m * 16) * 1024 + col0;
#pragma unroll
                for (int bj = 0; bj < 2; ++bj)
#pragma unroll
                    for (int n = 0; n < 2; ++n) *(f32x4*)(rowp + bj * 128 + n * 16) = acc[ai][bj][m][n] * sc; }
    }
};
struct SchedPV {
    int G, c; const char *pb, *vt;
    __device__ __forceinline__ bool next(int i, Unit& un) const {
        const int L = i * G + c; if (L >= 256) return false;
        const int n2 = L & 1, head = (L >> 1) & 3, rt = L >> 3;
        un.pm = rt; un.pn = head * 2 + n2; un.A = pb + ((size_t)rt * 256 * 1024 + head * 256) * 2; un.B = vt + ((size_t)(head * 512 + n2 * 256) * 1024 + (rt >> 3) * 256) * 2; un.nt = 4; un.kind = 0; return true;
    }
};
struct EpiPV {
    static constexpr bool PERM = true, KEEP = false;
    const bf16_t* U; bf16_t* YCX;
    __device__ __forceinline__ void operator()(f32x4 (&acc)[2][2][4][2], const Unit& u, int wr, int wc, int fr, int fq) const {
        asm volatile("" : "+v"(fr), "+v"(fq));
        const bf16_t* zb = U + (size_t)u.pm * 256 * NU + UXZ + u.pn * 256;
        const int row0 = wr * 64 + fr, col0 = wc * 32 + 8 * fq;
        const unsigned lane_off = (unsigned)((fr * 64 + fq * 16) ^ (((fr >> 3) & 1) << 5));
        unsigned char* ob = (unsigned char*)YCX + (size_t)(32 + 4 * u.pn + (wc >> 1)) * PKB + (wc & 1) * 1024 + lane_off;
#pragma unroll
        for (int ai = 0; ai < 2; ++ai)
#pragma unroll
            for (int m = 0; m < 4; ++m) { const size_t r = (size_t)(row0 + ai * 128 + m * 16);
#pragma unroll
                for (int bj = 0; bj < 2; ++bj) { const u32x4 z = *(const u32x4*)(zb + r * NU + col0 + bj * 128);
                    const f32x4 v0 = acc[ai][bj][m][0], v1 = acc[ai][bj][m][1];
                    u32x4 w; w.x = cvt_pk_bf16(v0[0] * bf_lo(z.x), v0[1] * bf_hi(z.x)); w.y = cvt_pk_bf16(v0[2] * bf_lo(z.y), v0[3] * bf_hi(z.y));
                    w.z = cvt_pk_bf16(v1[0] * bf_lo(z.z), v1[1] * bf_hi(z.z)); w.w = cvt_pk_bf16(v1[2] * bf_lo(z.w), v1[3] * bf_hi(z.w));
                    *(u32x4*)(ob + ((size_t)(2 * u.pm + ai) * 64 + 2 * bj) * PKB + (size_t)((4 * wr + m) * 2) * 1024) = w; }
                asm volatile("" ::: "memory"); }
    }
};
struct SchedMerge {
    int G, c; const char *ym, *ycx, *wpmt, *wpcxt;
    __device__ __forceinline__ bool next(int i, Unit& u) const {
        const int r = i / 3, br = i - 3 * r;
        if (!pg8::tile_map((long)r * G + c, 32, 16, u.pm, u.pn)) return false;
        u.kind = br;
        if (br == 0) { u.A = ym + (size_t)u.pm * (128 * PKB); u.B = wpmt + (size_t)u.pn * (128 * PKB); u.nt = 64; }
        else { u.A = ycx + (size_t)u.pm * (128 * PKB) + (br == 2 ? 32 * PKB : 0); u.B = wpcxt + (size_t)u.pn * (128 * PKB) + (br == 2 ? 32 * PKB : 0); u.nt = 32; }
        return true;
    }
};
struct EpiMerge {
    static constexpr bool PERM = true, KEEP = true;
    const bf16_t* U; unsigned char* MERGED;
    __device__ __forceinline__ void operator()(f32x4 (&acc)[2][2][4][2], const Unit& u, int wr, int wc, int fr, int fq) const {
        asm volatile("" : "+v"(fr), "+v"(fq));
        const int br = u.kind;
        const bf16_t* gb = U + (size_t)u.pm * 256 * NU + UG + br * 4096 + u.pn * 256;
        const int row0 = wr * 64 + fr, col0 = wc * 64 + 8 * fq;
        unsigned char* mb = MERGED + (size_t)(4 * u.pn + wc) * PKB + (unsigned)((fr * 64 + fq * 16) ^ (((fr >> 3) & 1) << 5));
        const float tiny = 1e-30f;
#pragma unroll
        for (int ai = 0; ai < 2; ++ai)
#pragma unroll
            for (int m = 0; m < 4; ++m) { const size_t r = (size_t)(row0 + ai * 128 + m * 16);
#pragma unroll
                for (int bj = 0; bj < 2; ++bj) { const int cc = col0 + bj * 32;
                    const u32x4 g = *(const u32x4*)(gb + r * NU + cc);
                    float f[8] = {bf_lo(g.x), bf_hi(g.x), bf_lo(g.y), bf_hi(g.y), bf_lo(g.z), bf_hi(g.z), bf_lo(g.w), bf_hi(g.w)};
                    if (br != 0) {
#pragma unroll
                        for (int j = 0; j < 8; ++j) f[j] = fmaxf(f[j], tiny); }
                    if (br != 2) { const u32x4 g2 = *(const u32x4*)(gb + r * NU + cc + 4096);
                        const float d[8] = {bf_lo(g2.x), bf_hi(g2.x), bf_lo(g2.y), bf_hi(g2.y), bf_lo(g2.z), bf_hi(g2.z), bf_lo(g2.w), bf_hi(g2.w)};
#pragma unroll
                        for (int j = 0; j < 8; ++j) f[j] = f[j] * __builtin_amdgcn_rcpf(fmaxf(d[j], tiny)); }
                    f32x4 v0 = acc[ai][bj][m][0], v1 = acc[ai][bj][m][1];
                    v0[0] *= f[0]; v0[1] *= f[1]; v0[2] *= f[2]; v0[3] *= f[3]; v1[0] *= f[4]; v1[1] *= f[5]; v1[2] *= f[6]; v1[3] *= f[7];
                    if (br != 2) { acc[ai][bj][m][0] = v0; acc[ai][bj][m][1] = v1; }
                    else { u32x4 w; w.x = cvt_pk_bf16(v0[0], v0[1]); w.y = cvt_pk_bf16(v0[2], v0[3]); w.z = cvt_pk_bf16(v1[0], v1[1]); w.w = cvt_pk_bf16(v1[2], v1[3]);
                        *(u32x4*)(mb + ((size_t)(2 * u.pm + ai) * 64) * PKB + (size_t)((4 * wr + m) * 2 + bj) * 1024) = w; } }
                asm volatile("" ::: "memory"); }
    }
};
struct SchedOut {
    int G, c; const char *merged, *wot;
    __device__ __forceinline__ bool next(int i, Unit& u) const {
        if (!pg8::tile_map((long)i * G + c, 32, 16, u.pm, u.pn)) return false;
        u.A = merged + (size_t)u.pm * (128 * PKB); u.B = wot + (size_t)u.pn * (128 * PKB); u.nt = 64; u.kind = 0; return true;
    }
};
struct EpiOut {
    static constexpr bool PERM = true, KEEP = false;
    const float* x; float* out;
    __device__ __forceinline__ void operator()(f32x4 (&acc)[2][2][4][2], const Unit& u, int wr, int wc, int fr, int fq) const {
        asm volatile("" : "+v"(fr), "+v"(fq));
        const size_t ob = (size_t)u.pm * 256 * 4096 + u.pn * 256;
        const int row0 = wr * 64 + fr, col0 = wc * 64 + 8 * fq;
#pragma unroll
        for (int ai = 0; ai < 2; ++ai)
#pragma unroll
            for (int m = 0; m < 4; ++m) { const size_t r = (size_t)(row0 + ai * 128 + m * 16);
#pragma unroll
                for (int bj = 0; bj < 2; ++bj)
#pragma unroll
                    for (int n = 0; n < 2; ++n) { const size_t o = ob + r * 4096 + col0 + bj * 32 + n * 4;
                        const f32x4 xv = *(const f32x4*)(x + o);
                        *(f32x4*)(out + o) = xv * DN_ALPHA + acc[ai][bj][m][n]; }
                asm volatile("" ::: "memory"); }
    }
};

__device__ __forceinline__ void conv_phase(const Params& p, int gtid, int NGT) {
    const bf16_t* U = (const bf16_t*)(p.ws + WS_U); bf16_t* YCX = (bf16_t*)(p.ws + WS_YCX);
    for (int idx = gtid; idx < T * 256; idx += NGT) {
        const int t = idx >> 8, c = (idx & 255) * 8, tl = t & (SEQ - 1);
        const bf16_t* row = U + (size_t)t * NU;
        const u32x4 cb = *(const u32x4*)(row + UCB + c), cz = *(const u32x4*)(row + UCZ + c);
        const unsigned cbw[4] = {cb.x, cb.y, cb.z, cb.w}, czw[4] = {cz.x, cz.y, cz.z, cz.w};
        float accv[8];
#pragma unroll
        for (int j = 0; j < 8; ++j) accv[j] = 0.f;
#pragma unroll
        for (int w = 0; w < 3; ++w) {
            const int dt = 2 - w;
            if (tl >= dt) {
                const bf16_t* r2 = row - (size_t)dt * NU;
                const u32x4 a = *(const u32x4*)(r2 + UCC + c), b = *(const u32x4*)(r2 + UCX + c);
                const unsigned aw[4] = {a.x, a.y, a.z, a.w}, bw[4] = {b.x, b.y, b.z, b.w};
                const f32x4 w0 = *(const f32x4*)(p.conv_w + w * 2048 + c), w1 = *(const f32x4*)(p.conv_w + w * 2048 + c + 4);
                const float wv[8] = {w0[0], w0[1], w0[2], w0[3], w1[0], w1[1], w1[2], w1[3]};
#pragma unroll
                for (int j = 0; j < 4; ++j) { accv[2 * j] += wv[2 * j] * (bf_lo(aw[j]) * bf_lo(bw[j])); accv[2 * j + 1] += wv[2 * j + 1] * (bf_hi(aw[j]) * bf_hi(bw[j])); }
            }
        }
        u32x4 o; unsigned ow[4];
#pragma unroll
        for (int j = 0; j < 4; ++j) ow[j] = cvt_pk_bf16(bf_lo(cbw[j]) * accv[2 * j] * bf_lo(czw[j]), bf_hi(cbw[j]) * accv[2 * j + 1] * bf_hi(czw[j]));
        o.x = ow[0]; o.y = ow[1]; o.z = ow[2]; o.w = ow[3];
        *(u32x4*)((unsigned char*)YCX + pk_off(t, c, 64)) = o;
    }
}
__device__ __forceinline__ void softmax_phase(const Params& p, int gw, int NGW, int lane) {
    const float* SC = (const float*)(p.ws + WS_SC); bf16_t* PB = (bf16_t*)(p.ws + WS_PB);
    for (int it = gw; it < T * 4; it += NGW) {
        const f32x4 s = *(const f32x4*)(SC + (size_t)it * 256 + 4 * lane);
        const float mx = wave_max(fmaxf(fmaxf(s[0], s[1]), fmaxf(s[2], s[3])));
        const float e0 = __expf(s[0] - mx), e1 = __expf(s[1] - mx), e2 = __expf(s[2] - mx), e3 = __expf(s[3] - mx);
        const float inv = 1.0f / wave_sum((e0 + e1) + (e2 + e3));
        u32x2 o; o.x = cvt_pk_bf16(e0 * inv, e1 * inv); o.y = cvt_pk_bf16(e2 * inv, e3 * inv);
        *(u32x2*)(PB + (size_t)it * 256 + 4 * lane) = o;
    }
}
__device__ __forceinline__ void ym_phase(const Params& p, int gw, int NGW, int lane) {
    const bf16_t* U = (const bf16_t*)(p.ws + WS_U); const bf16_t* HR = (const bf16_t*)(p.ws + WS_HRAW); bf16_t* YM = (bf16_t*)(p.ws + WS_YM);
    for (int it = gw; it < T * 8; it += NGW) {
        const int t = it >> 3, h = it & 7, c = h * 512 + 8 * lane;
        const u32x4 hv = *(const u32x4*)(HR + (size_t)t * 4096 + c);
        const u32x4 mo = *(const u32x4*)(U + (size_t)t * NU + UO + c), mz = *(const u32x4*)(U + (size_t)t * NU + UZ + c);
        const f32x4 w0 = *(const f32x4*)(p.mh_norm_w + c), w1 = *(const f32x4*)(p.mh_norm_w + c + 4);
        float v[8] = {bf_lo(hv.x), bf_hi(hv.x), bf_lo(hv.y), bf_hi(hv.y), bf_lo(hv.z), bf_hi(hv.z), bf_lo(hv.w), bf_hi(hv.w)};
        float s = 0.f;
#pragma unroll
        for (int j = 0; j < 8; ++j) s += v[j];
        const float mean = wave_sum(s) * (1.0f / 512.0f);
        float q = 0.f;
#pragma unroll
        for (int j = 0; j < 8; ++j) { v[j] -= mean; q += v[j] * v[j]; }
        const float rstd = 1.0f / sqrtf(wave_sum(q) * (1.0f / 512.0f) + LN_EPS);
        const float g[8] = {bf_lo(mo.x) * bf_lo(mz.x), bf_hi(mo.x) * bf_hi(mz.x), bf_lo(mo.y) * bf_lo(mz.y), bf_hi(mo.y) * bf_hi(mz.y),
                            bf_lo(mo.z) * bf_lo(mz.z), bf_hi(mo.z) * bf_hi(mz.z), bf_lo(mo.w) * bf_lo(mz.w), bf_hi(mo.w) * bf_hi(mz.w)};
        const float wv[8] = {w0[0], w0[1], w0[2], w0[3], w1[0], w1[1], w1[2], w1[3]};
        u32x4 o; unsigned ow[4];
#pragma unroll
        for (int j = 0; j < 4; ++j) ow[j] = cvt_pk_bf16(v[2 * j] * rstd * wv[2 * j] * g[2 * j], v[2 * j + 1] * rstd * wv[2 * j + 1] * g[2 * j + 1]);
        o.x = ow[0]; o.y = ow[1]; o.z = ow[2]; o.w = ow[3];
        *(u32x4*)((unsigned char*)YM + pk_off(t, c, 64)) = o;
    }
}
__device__ __forceinline__ void ln_phase(const Params& p, int gw, int NGW, int lane) {
    for (int m = gw; m < T; m += NGW) {
        f32x4* r = (f32x4*)(p.out + (size_t)m * D) + lane;
        f32x4 v[16]; float s = 0.f;
#pragma unroll
        for (int j = 0; j < 16; ++j) { v[j] = r[64 * j]; s += (v[j][0] + v[j][1]) + (v[j][2] + v[j][3]); }
        const float mean = wave_sum(s) * (1.0f / D); float q = 0.f;
#pragma unroll
        for (int j = 0; j < 16; ++j) { v[j] = v[j] - mean; q += (v[j][0] * v[j][0] + v[j][1] * v[j][1]) + (v[j][2] * v[j][2] + v[j][3] * v[j][3]); }
        const float rstd = 1.0f / sqrtf(wave_sum(q) * (1.0f / D) + LN_EPS);
#pragma unroll
        for (int j = 0; j < 16; ++j) { const f32x4 w = *((const f32x4*)p.ln_w + lane + 64 * j), b = *((const f32x4*)p.ln_b + lane + 64 * j); r[64 * j] = v[j] * rstd * w + b; }
    }
}

__device__ __forceinline__ void mlstm_naive(const Params& p, LAS unsigned char* lds, int unit, int wave, int lane) {
    const int s = unit & 7, h = (unit >> 3) & 7, b = unit >> 6;
    LAS float* part = (LAS float*)lds;
    LAS float* pden = part + 2 * 8 * 64;
    const bf16_t* Ub = (const bf16_t*)(p.ws + WS_U) + (size_t)(b * SEQ) * NU;
    bf16_t* HR = (bf16_t*)(p.ws + WS_HRAW) + (size_t)(b * SEQ) * 4096 + h * 512 + s * 64 + lane;
    float C[32], n[32];
#pragma unroll
    for (int d = 0; d < 32; ++d) { C[d] = 0.f; n[d] = 0.f; }
    float m = 0.f;
    for (int t = 0; t < SEQ; ++t) {
        const bf16_t* row = Ub + (size_t)t * NU;
        u32x4 kk[4], qq[4];
#pragma unroll
        for (int j = 0; j < 4; ++j) { kk[j] = *(const u32x4*)(row + UK + h * 256 + wave * 32 + 8 * j); qq[j] = *(const u32x4*)(row + UQ + h * 256 + wave * 32 + 8 * j); }
        const float vv = bf2f(row[UV + h * 512 + s * 64 + lane]);
        const float ig = bf2f(row[UI + h]), fp = bf2f(row[UF + h]);
        const float lf = fminf(fp, 0.f) - log1pf(__expf(-fabsf(fp)));
        const float mn = fmaxf(lf + m, ig), fd = __expf(lf + m - mn), iw = __expf(ig - mn);
        m = mn;
        float num = 0.f, den = 0.f;
#pragma unroll
        for (int j = 0; j < 4; ++j) {
            const unsigned kw[4] = {kk[j].x, kk[j].y, kk[j].z, kk[j].w}, qw[4] = {qq[j].x, qq[j].y, qq[j].z, qq[j].w};
#pragma unroll
            for (int e = 0; e < 4; ++e) {
                const int d = 8 * j + 2 * e;
                const float k0 = iw * bf_lo(kw[e]), k1 = iw * bf_hi(kw[e]), q0 = bf_lo(qw[e]), q1 = bf_hi(qw[e]);
                C[d] = fd * C[d] + k0 * vv; n[d] = fd * n[d] + k0; num += q0 * C[d]; den += q0 * n[d];
                C[d + 1] = fd * C[d + 1] + k1 * vv; n[d + 1] = fd * n[d + 1] + k1; num += q1 * C[d + 1]; den += q1 * n[d + 1];
            }
        }
        const int buf = t & 1;
        part[(buf * 8 + wave) * 64 + lane] = num; if (lane == 0) pden[buf * 8 + wave] = den;
        __syncthreads();
        if (wave == (t & 7)) {
            float nt_ = 0.f, dt_ = 0.f;
#pragma unroll
            for (int w = 0; w < 8; ++w) { nt_ += part[(buf * 8 + w) * 64 + lane]; dt_ += pden[buf * 8 + w]; }
            const float hv = nt_ / fmaxf(fabsf(dt_), __expf(-m));
            HR[(size_t)t * 4096] = (bf16_t)(cvt_pk_bf16(hv, 0.f) & 0xffffu);
        }
    }
    __syncthreads();
}

constexpr int ML_RS = 528, ML_VS = 160;
constexpr int ML_Q = 0, ML_K = 64 * ML_RS, ML_V = 2 * 64 * ML_RS, ML_VSC = ML_V + 64 * ML_VS, ML_CT = ML_VSC + 64 * ML_VS, ML_END = ML_CT + 80 * ML_RS;
static_assert(ML_END <= RING_BYTES, "mLSTM LDS map");
typedef short s16x4 __attribute__((ext_vector_type(4)));
__device__ __forceinline__ bf16x8 tr_pair(const LAS unsigned char* a0, const LAS unsigned char* a1) {
    const s16x4 lo = __builtin_amdgcn_ds_read_tr16_b64_v4i16((LAS s16x4*)a0), hi = __builtin_amdgcn_ds_read_tr16_b64_v4i16((LAS s16x4*)a1);
    return (bf16x8){lo[0], lo[1], lo[2], lo[3], hi[0], hi[1], hi[2], hi[3]};
}
__device__ __forceinline__ void mlstm_unit(const Params& p, LAS unsigned char* lds, int unit, int wave, int lane, int tid) {
    const int s = unit & 7, h = (unit >> 3) & 7, b = unit >> 6;
    const int g = lane >> 4, li = lane & 15, q4 = li >> 2, p4 = lane & 3;
    const int tt = wave >> 1, vh = wave & 1;
    const bf16_t* U = (const bf16_t*)(p.ws + WS_U) + (size_t)(b * SEQ) * NU;
    bf16_t* HR = (bf16_t*)(p.ws + WS_HRAW) + (size_t)(b * SEQ) * 4096 + h * 512 + s * 64;
    const int srow = tid >> 5, sch = tid & 31, vrow = tid >> 3, vch = tid & 7;
    for (int i = tid; i < (80 * ML_RS) / 16; i += NWAVES * 64) *(LAS u32x4*)(lds + ML_CT + 16 * i) = (u32x4){0u, 0u, 0u, 0u};
    if (tid < 64) {
        *(LAS u32x4*)(lds + ML_V + tid * ML_VS + 128) = (u32x4){0x3F80u, 0u, 0u, 0u}; *(LAS u32x4*)(lds + ML_V + tid * ML_VS + 144) = (u32x4){0u, 0u, 0u, 0u};
        *(LAS u32x4*)(lds + ML_VSC + tid * ML_VS + 128) = (u32x4){0u, 0u, 0u, 0u}; *(LAS u32x4*)(lds + ML_VSC + tid * ML_VS + 144) = (u32x4){0u, 0u, 0u, 0u};
    }
    f32x4 cacc[2][5];
#pragma unroll
    for (int a = 0; a < 2; ++a)
#pragma unroll
        for (int v = 0; v < 5; ++v) cacc[a][v] = (f32x4){0.f, 0.f, 0.f, 0.f};
    float m_st = 0.f;
    u32x4 rq[4], rk[4], rv; float ig_n, fp_n;
#define ML_PREFETCH(c) do { const bf16_t* base_ = U + (size_t)((c) * 64) * NU; \
        _Pragma("unroll") for (int i_ = 0; i_ < 4; ++i_) { rq[i_] = *(const u32x4*)(base_ + (size_t)(srow + 16 * i_) * NU + UQ + h * 256 + sch * 8); \
                                                          rk[i_] = *(const u32x4*)(base_ + (size_t)(srow + 16 * i_) * NU + UK + h * 256 + sch * 8); } \
        rv = *(const u32x4*)(base_ + (size_t)vrow * NU + UV + h * 512 + s * 64 + vch * 8); \
        ig_n = bf2f(base_[(size_t)lane * NU + UI + h]); fp_n = bf2f(base_[(size_t)lane * NU + UF + h]); } while (0)
    ML_PREFETCH(0);
    for (int c = 0; c < SEQ / 64; ++c) {
        const float ig = ig_n, fp = fp_n;
        const float lf = fminf(fp, 0.f) - log1pf(__expf(-fabsf(fp)));
        float bs = lf;
#pragma unroll
        for (int o = 1; o < 64; o <<= 1) { const float t_ = __shfl_up(bs, o); if (lane >= o) bs += t_; }
        const float Cj = ig - bs; float cm = Cj;
#pragma unroll
        for (int o = 1; o < 64; o <<= 1) { const float t_ = __shfl_up(cm, o); if (lane >= o) cm = fmaxf(cm, t_); }
        const float Mt = fmaxf(cm, m_st);
        const float gsum = __shfl(bs, 63), M63 = __shfl(Mt, 63);
        const float scale = __expf(Cj - M63), inter = __expf(m_st - Mt), emt = __expf(-(bs + Mt)), decay = __expf(m_st - M63);
        if (c > 0) {
#pragma unroll
            for (int a = 0; a < 2; ++a)
#pragma unroll
                for (int v = 0; v < 5; ++v) { u32x2 w; w.x = cvt_pk_bf16(cacc[a][v][0], cacc[a][v][1]); w.y = cvt_pk_bf16(cacc[a][v][2], cacc[a][v][3]);
                    *(LAS u32x2*)(lds + ML_CT + (16 * v + li) * ML_RS + (16 * (2 * wave + a) + 4 * g) * 2) = w; }
        }
#pragma unroll
        for (int i = 0; i < 4; ++i) { *(LAS u32x4*)(lds + ML_Q + (srow + 16 * i) * ML_RS + sch * 16) = rq[i]; *(LAS u32x4*)(lds + ML_K + (srow + 16 * i) * ML_RS + sch * 16) = rk[i]; }
        *(LAS u32x4*)(lds + ML_V + vrow * ML_VS + vch * 16) = rv;
        { const float sc = __shfl(scale, vrow); u32x4 o;
          o.x = cvt_pk_bf16(bf_lo(rv.x) * sc, bf_hi(rv.x) * sc); o.y = cvt_pk_bf16(bf_lo(rv.y) * sc, bf_hi(rv.y) * sc);
          o.z = cvt_pk_bf16(bf_lo(rv.z) * sc, bf_hi(rv.z) * sc); o.w = cvt_pk_bf16(bf_lo(rv.w) * sc, bf_hi(rv.w) * sc);
          *(LAS u32x4*)(lds + ML_VSC + vrow * ML_VS + vch * 16) = o; }
        if (tid < 64) *(LAS bf16_t*)(lds + ML_VSC + tid * ML_VS + 128) = (bf16_t)(cvt_pk_bf16(scale, 0.f) & 0xffffu);
        __syncthreads();
        if (c + 1 < SEQ / 64) ML_PREFETCH(c + 1);
        const int tcol = 16 * tt + li;
        const float Mt_t = __shfl(Mt, tcol), inter_t = __shfl(inter, tcol), emt_t = __shfl(emt, tcol);
        bf16x8 Bq[8]; f32x4 sacc[4];
#pragma unroll
        for (int j = 0; j < 4; ++j) sacc[j] = (f32x4){0.f, 0.f, 0.f, 0.f};
#pragma unroll
        for (int ks = 0; ks < 8; ++ks) {
            Bq[ks] = *(const LAS bf16x8*)(lds + ML_Q + tcol * ML_RS + g * 16 + ks * 64);
#pragma unroll
            for (int jt = 0; jt < 4; ++jt) if (jt <= tt) {
                const bf16x8 Ak = *(const LAS bf16x8*)(lds + ML_K + (16 * jt + li) * ML_RS + g * 16 + ks * 64);
                sacc[jt] = __builtin_amdgcn_mfma_f32_16x16x32_bf16(Ak, Bq[ks], sacc[jt], 0, 0, 0); }
        }
        bf16x8 sp[2];
#pragma unroll
        for (int ks2 = 0; ks2 < 2; ++ks2) {
            float sv[8];
#pragma unroll
            for (int e = 0; e < 8; ++e) { const int jt = 2 * ks2 + (e >> 2), j = 16 * jt + 4 * g + (e & 3);
                const float cj = __shfl(Cj, j);
                sv[e] = (j <= tcol) ? sacc[jt][e & 3] * __expf(cj - Mt_t) : 0.f; }
            const unsigned w0 = cvt_pk_bf16(sv[0], sv[1]), w1 = cvt_pk_bf16(sv[2], sv[3]), w2 = cvt_pk_bf16(sv[4], sv[5]), w3 = cvt_pk_bf16(sv[6], sv[7]);
            sp[ks2] = (bf16x8){(short)(w0 & 0xffff), (short)(w0 >> 16), (short)(w1 & 0xffff), (short)(w1 >> 16), (short)(w2 & 0xffff), (short)(w2 >> 16), (short)(w3 & 0xffff), (short)(w3 >> 16)};
        }
        f32x4 pacc[3];
#pragma unroll
        for (int a = 0; a < 3; ++a) pacc[a] = (f32x4){0.f, 0.f, 0.f, 0.f};
#pragma unroll
        for (int ks = 0; ks < 8; ++ks)
#pragma unroll
            for (int a = 0; a < 3; ++a) { const int vt = (a == 2) ? 4 : 2 * vh + a;
                const bf16x8 Ac = *(const LAS bf16x8*)(lds + ML_CT + (16 * vt + li) * ML_RS + g * 16 + ks * 64);
                pacc[a] = __builtin_amdgcn_mfma_f32_16x16x32_bf16(Ac, Bq[ks], pacc[a], 0, 0, 0); }
#pragma unroll
        for (int a = 0; a < 3; ++a) pacc[a] = pacc[a] * inter_t;
#pragma unroll
        for (int ks2 = 0; ks2 < 2; ++ks2)
#pragma unroll
            for (int a = 0; a < 3; ++a) { const int vt = (a == 2) ? 4 : 2 * vh + a;
                const LAS unsigned char* ad = lds + ML_V + (32 * ks2 + 4 * g + q4) * ML_VS + (16 * vt + 4 * p4) * 2;
                const bf16x8 Av = tr_pair(ad, ad + 16 * ML_VS);
                pacc[a] = __builtin_amdgcn_mfma_f32_16x16x32_bf16(Av, sp[ks2], pacc[a], 0, 0, 0); }
        { const float den = __shfl(pacc[2][0], li);
          const float inv = 1.0f / fmaxf(fabsf(den), emt_t);
          bf16_t* hp = HR + (size_t)(c * 64 + tcol) * 4096 + 4 * g;
#pragma unroll
          for (int a = 0; a < 2; ++a) { u32x2 w; w.x = cvt_pk_bf16(pacc[a][0] * inv, pacc[a][1] * inv); w.y = cvt_pk_bf16(pacc[a][2] * inv, pacc[a][3] * inv);
              *(u32x2*)(hp + 16 * (2 * vh + a)) = w; } }
#pragma unroll
        for (int a = 0; a < 2; ++a)
#pragma unroll
            for (int v = 0; v < 5; ++v) cacc[a][v] = cacc[a][v] * decay;
#pragma unroll
        for (int ks2 = 0; ks2 < 2; ++ks2) {
            bf16x8 Ak[2];
#pragma unroll
            for (int a = 0; a < 2; ++a) { const LAS unsigned char* ad = lds + ML_K + (32 * ks2 + 8 * g + q4) * ML_RS + (16 * (2 * wave + a) + 4 * p4) * 2; Ak[a] = tr_pair(ad, ad + 4 * ML_RS); }
#pragma unroll
            for (int v = 0; v < 5; ++v) { const LAS unsigned char* ad = lds + ML_VSC + (32 * ks2 + 8 * g + q4) * ML_VS + (16 * v + 4 * p4) * 2;
                const bf16x8 Bv = tr_pair(ad, ad + 4 * ML_VS);
#pragma unroll
                for (int a = 0; a < 2; ++a) cacc[a][v] = __builtin_amdgcn_mfma_f32_16x16x32_bf16(Ak[a], Bv, cacc[a][v], 0, 0, 0); }
        }
        m_st = gsum + M63;
        __syncthreads();
    }
#undef ML_PREFETCH
}

__global__ void __launch_bounds__(NWAVES * 64, 2) mk_fwd(Params p) {
    extern __shared__ __attribute__((aligned(16))) unsigned char lds_raw[];
    LAS unsigned char* lds = (LAS unsigned char*)lds_raw;
    volatile LAS unsigned* MISC = (volatile LAS unsigned*)(lds + MISC_OFF);
    const int tid = threadIdx.x, lane = tid & 63, wave = __builtin_amdgcn_readfirstlane(tid >> 6);
    const int G = gridDim.x, bx = blockIdx.x;
    const int vcu = (G % 8 == 0) ? (bx % 8) * (G / 8) + bx / 8 : bx;
    const int gw = vcu * NWAVES + wave, NGW = G * NWAVES;
    unsigned char* ws = p.ws;
    unsigned* ctl = (unsigned*)(ws + WS_CTL);
    for (int u = tid; u < 1024 / 4; u += NWAVES * 64) ((LAS unsigned*)(lds + LDSCTL_OFF))[u] = 0u;
    __syncthreads();
    const bool one_launch = (p.ph_lo == 0 && p.ph_hi >= 8);
    XcdBarrier bar; bar.bar = ctl + CW_BAR; bar.x = 0; bar.st = nullptr;
    if (one_launch) bar = xcd_barrier_post(ctl + CW_BAR, MISC + 8);
    const int lo = p.ph_lo, hi = p.ph_hi;
#define IN(k) (lo <= (k) && (k) < hi)
#ifndef MK_DUP
#define MK_DUP -1
#endif
#define REP(k) for (int rep_ = 0; rep_ < ((MK_DUP) == (k) ? 2 : 1); ++rep_)
#define GRID_BAR() do { if (one_launch) xcd_barrier(bar); } while (0)

    if (IN(0)) { REP(0) p0_prologue(p, lds, gw, NGW, wave, lane); GRID_BAR(); }
    if (IN(1)) {
        SchedP1 S{G, bx, (const char*)(ws + WS_XB), (const char*)(ws + WS_MEMB), (const char*)(ws + WS_WINT), (const char*)(ws + WS_WKVT)};
        EpiP1 E{(bf16_t*)(ws + WS_U), (const float*)(ws + WS_BU), (bf16_t*)(ws + WS_KMEM), (bf16_t*)(ws + WS_VT), lds};
        REP(1) pg8::gemm_phase<EpiP1, SchedP1, true, true, true, true>(lds, 64 * 16384, 64 * 16384, S, E);
        GRID_BAR();
    }
    if (IN(2)) {
        { SchedQK S{G, bx, (const char*)(ws + WS_U), (const char*)(ws + WS_KMEM)}; EpiSC E{(float*)(ws + WS_SC)};
          REP(2) pg8::gemm_phase<EpiSC, SchedQK, true, true, false, false>(lds, NU * 2, 4096, S, E); }
        REP(8) conv_phase(p, vcu * (NWAVES * 64) + tid, G * NWAVES * 64);
        __syncthreads();
        #if defined(MK_NAIVE_MLSTM)
        for (int unit = bx; unit < 256; unit += G) mlstm_naive(p, lds, unit, wave, lane);
#else
        REP(9) for (int unit = bx; unit < 256; unit += G) mlstm_unit(p, lds, unit, wave, lane, tid);
#endif
        GRID_BAR();
    }
    if (IN(3)) { REP(3) softmax_phase(p, gw, NGW, lane); REP(10) ym_phase(p, gw, NGW, lane); GRID_BAR(); }
    if (IN(4)) {
        SchedPV S{G, bx, (const char*)(ws + WS_PB), (const char*)(ws + WS_VT)}; EpiPV E{(const bf16_t*)(ws + WS_U), (bf16_t*)(ws + WS_YCX)};
        REP(4) pg8::gemm_phase<EpiPV, SchedPV, true, true, false, false>(lds, 2048, 2048, S, E);
        GRID_BAR();
    }
    if (IN(5)) {
        SchedMerge S{G, bx, (const char*)(ws + WS_YM), (const char*)(ws + WS_YCX), (const char*)(ws + WS_WPMT), (const char*)(ws + WS_WPCXT)};
        EpiMerge E{(const bf16_t*)(ws + WS_U), ws + WS_MERGED};
        REP(5) pg8::gemm_phase<EpiMerge, SchedMerge, true, true, true, true>(lds, 64 * 16384, 64 * 16384, S, E);
        GRID_BAR();
    }
    if (IN(6)) {
        SchedOut S{G, bx, (const char*)(ws + WS_MERGED), (const char*)(ws + WS_WOT)}; EpiOut E{p.x, p.out};
        REP(6) pg8::gemm_phase<EpiOut, SchedOut, true, true, true, true>(lds, 64 * 16384, 64 * 16384, S, E);
        GRID_BAR();
    }
    if (IN(7)) ln_phase(p, gw, NGW, lane);
#undef IN
#undef GRID_BAR
}

#ifndef MK_N_LAUNCHES
#define MK_N_LAUNCHES 1
#endif
extern "C" void kernel_launch(void* const* d_in, const int* in_sizes, int n_in, void* d_out, int out_size, void* d_ws, size_t ws_size, hipStream_t stream) {
    static int grid = 0;
    if (grid == 0) {
        if (n_in != 13 || out_size != T * D || ws_size < WS_END) { fprintf(stderr, "kernel_launch: unexpected shapes (n_in %d out %d ws %zu)\n", n_in, out_size, ws_size); grid = -1; return; }
        int dev = 0, cus = 0, per_cu = 0;
        if (hipGetDevice(&dev) != hipSuccess || hipDeviceGetAttribute(&cus, hipDeviceAttributeMultiprocessorCount, dev) != hipSuccess) { grid = -1; return; }
        if (hipFuncSetAttribute((const void*)mk_fwd, hipFuncAttributeMaxDynamicSharedMemorySize, LDS_BYTES) != hipSuccess) { fprintf(stderr, "kernel_launch: hipFuncSetAttribute failed\n"); grid = -1; return; }
        if (hipOccupancyMaxActiveBlocksPerMultiprocessor(&per_cu, (const void*)mk_fwd, NWAVES * 64, LDS_BYTES) != hipSuccess || per_cu < 1)
            fprintf(stderr, "kernel_launch: note: occupancy query reports %d\n", per_cu);
        (void)hipGetLastError();
        grid = cus;
    }
    if (grid < 0) return;
    (void)hipMemsetAsync((char*)d_ws + WS_CTL, 0, CTL_ZERO_BYTES, stream);
    Params p{};
    p.x = (const float*)d_in[0]; p.mem = (const float*)d_in[1]; p.w_in = (const float*)d_in[2]; p.b_in = (const float*)d_in[3];
    p.conv_w = (const float*)d_in[4]; p.mh_norm_w = (const float*)d_in[5]; p.w_mem_kv = (const float*)d_in[6]; p.w_proj_m = (const float*)d_in[7];
    p.w_proj_c = (const float*)d_in[8]; p.w_proj_x = (const float*)d_in[9]; p.w_out = (const float*)d_in[10]; p.ln_w = (const float*)d_in[11]; p.ln_b = (const float*)d_in[12];
    p.out = (float*)d_out; p.ws = (unsigned char*)d_ws;
    if (MK_N_LAUNCHES == 1) { p.ph_lo = 0; p.ph_hi = 8; hipLaunchKernelGGL(mk_fwd, dim3(grid), dim3(NWAVES * 64), LDS_BYTES, stream, p); }
    else for (int k = 0; k < 8; ++k) { p.ph_lo = k; p.ph_hi = k + 1; hipLaunchKernelGGL(mk_fwd, dim3(grid), dim3(NWAVES * 64), LDS_BYTES, stream, p); }
}
```

```cpp
#include <hip/hip_runtime.h>
#include <cstdio>
#include <cstdint>

#define LAS __attribute__((address_space(3)))
#define GAS __attribute__((address_space(1)))
typedef unsigned short bf16_t;
typedef short bf16x8 __attribute__((ext_vector_type(8)));
typedef float f32x4 __attribute__((ext_vector_type(4)));
typedef float f32x2 __attribute__((ext_vector_type(2)));
typedef unsigned u32x4 __attribute__((ext_vector_type(4)));
typedef unsigned u32x2 __attribute__((ext_vector_type(2)));

constexpr int NB = 4, SEQ = 2048, T = NB * SEQ, D = 4096;
constexpr int DIN = 40976, NU = 41216;
constexpr int MEMLEN = 256, TM = NB * MEMLEN;
constexpr int UQ = 0, UK = 2048, UV = 4096, UO = 8192, UZ = 12288, UCB = 16384, UCC = 18432, UCX = 20480, UCZ = 22528,
              UXQ = 24576, UXZ = 26624, UG = 28672, UI = 40960, UF = 40968;
constexpr float LN_EPS = 1e-5f;
constexpr float DN_ALPHA = 1.189207115002721f;

constexpr size_t MiB = 1u << 20;
constexpr size_t WS_CTL = 0, CTL_ZERO_BYTES = 1 * MiB;
constexpr size_t WS_BU = 1 * MiB;
constexpr size_t WS_XB = 2 * MiB;
constexpr size_t WS_MEMB = 66 * MiB;
constexpr size_t WS_WINT = 74 * MiB;
constexpr size_t WS_WKVT = 396 * MiB;
constexpr size_t WS_WPMT = 428 * MiB;
constexpr size_t WS_WPCXT = 460 * MiB;
constexpr size_t WS_WOT = 492 * MiB;
constexpr size_t WS_U = 524 * MiB;
constexpr size_t WS_KMEM = 1168 * MiB;
constexpr size_t WS_VT = 1172 * MiB;
constexpr size_t WS_SC = 1176 * MiB;
constexpr size_t WS_PB = 1208 * MiB;
constexpr size_t WS_HRAW = 1224 * MiB;
constexpr size_t WS_YM = 1288 * MiB;
constexpr size_t WS_YCX = 1352 * MiB;
constexpr size_t WS_MERGED = 1416 * MiB;
constexpr size_t WS_END = 1480 * MiB;
constexpr int CW_BAR = 4096;

constexpr int RING_BYTES = 131072;
constexpr int LDSCTL_OFF = RING_BYTES, MISC_OFF = LDSCTL_OFF + 320;
constexpr int EPI_OFF = RING_BYTES + 1024, EPI_WAVE_BYTES = 16 * 144;
constexpr int LDS_BYTES = 163840;
static_assert(EPI_OFF + 8 * EPI_WAVE_BYTES <= LDS_BYTES, "LDS map");
constexpr int NWAVES = 8;

typedef __bf16 bf16x2_t __attribute__((ext_vector_type(2)));
__device__ __forceinline__ unsigned cvt_pk_bf16_asm(float lo, float hi) { unsigned r; asm("v_cvt_pk_bf16_f32 %0, %1, %2" : "=v"(r) : "v"(lo), "v"(hi)); return r; }
__device__ __forceinline__ unsigned cvt_pk_bf16(float lo, float hi) { const bf16x2_t v = __builtin_convertvector((f32x2){lo, hi}, bf16x2_t); return __builtin_bit_cast(unsigned, v); }
__device__ __forceinline__ float bf_lo(unsigned w) { return __uint_as_float(w << 16); }
__device__ __forceinline__ float bf_hi(unsigned w) { return __uint_as_float(w & 0xffff0000u); }
__device__ __forceinline__ float bf2f(bf16_t h) { return __uint_as_float(((unsigned)h) << 16); }
__device__ __forceinline__ float sigmoidf_(float x) { return __builtin_amdgcn_rcpf(1.0f + __expf(-x)); }
__device__ __forceinline__ float wave_sum(float v) {
#pragma unroll
    for (int o = 1; o < 64; o <<= 1) v += __shfl_xor(v, o);
    return v;
}
__device__ __forceinline__ float wave_max(float v) {
#pragma unroll
    for (int o = 1; o < 64; o <<= 1) v = fmaxf(v, __shfl_xor(v, o));
    return v;
}
#define LDS_WAIT() asm volatile("s_waitcnt lgkmcnt(0)" ::: "memory")
#define VM_WAIT() asm volatile("s_waitcnt vmcnt(0)" ::: "memory")

namespace pg8 {
constexpr int BM = 256, BK = 64, HALF = 128, HTB = HALF * BK * 2, STAGE_BYTES = 8 * HTB;
__host__ __device__ __forceinline__ int lds_byte(int r, int c) { const int st = (r >> 4) * 2 + (c >> 5), rr = r & 15, cc = c & 31, ob = rr * 64 + cc * 2; return st * 1024 + (ob ^ (((ob >> 9) & 1) << 5)); }
__host__ __device__ __forceinline__ void stage_rc(int b, int& R, int& C) { const int st = b / 1024, sb = b % 1024, swz = sb ^ (((sb >> 9) & 1) << 5); R = (st >> 1) * 16 + swz / 64; C = (st & 1) * 32 + (swz % 64) / 2; }
__host__ __device__ __forceinline__ int perm32(int rho) { const int n = rho >> 4, i = rho & 15; return 8 * (i >> 2) + 4 * n + (i & 3); }

struct Unit { const char* A; const char* B; int nt, pm, pn, kind; };

__device__ __forceinline__ bool tile_map(long L, int nM, int nN, int& pm, int& pn) {
    const int nwg = nM * nN; if (L >= nwg) return false;
    int wgid = (int)L; { const int q = nwg / 8, r = nwg % 8, xcd = wgid % 8, off = wgid / 8; wgid = (xcd < r ? xcd * (q + 1) : r * (q + 1) + (xcd - r) * q) + off; }
    const int nig = 8 * nN, gid = wgid / nig, fm = gid * 8, gsz = (nM - fm) < 8 ? (nM - fm) : 8;
    pm = fm + ((wgid % nig) % gsz); pn = (wgid % nig) / gsz; return true;
}

template <class Epi, class Sched, bool ALIGN_EPI, bool SP2, bool APACK, bool BPACK>
__device__ __forceinline__ void gemm_phase(LAS unsigned char* lds, const int lda, const int ldb, const Sched& S, const Epi& E) {
    const int tid = threadIdx.x, wid = __builtin_amdgcn_readfirstlane(tid >> 6), lane = tid & 63, wr = wid >> 2, wc = wid & 3, fr = lane & 15, fq = lane >> 4;
    unsigned voffA[2], voffB[2];
#pragma unroll
    for (int i = 0; i < 2; ++i) { int R, C; stage_rc(tid * 16 + i * 8192, R, C); const int Rb = Epi::PERM ? ((R & ~31) + perm32(R & 31)) : R;
        voffA[i] = APACK ? (unsigned)(tid * 16 + i * 8192) : (unsigned)(R * lda + C * 2); voffB[i] = BPACK ? (unsigned)(tid * 16 + i * 8192) : (unsigned)(Rb * ldb + C * 2); }
    const size_t kstepA = APACK ? (size_t)16384 : (size_t)(BK * 2), kstepB = BPACK ? (size_t)16384 : (size_t)(BK * 2);
    const size_t hstepA = APACK ? (size_t)lda : (size_t)HALF * lda, hstepB = BPACK ? (size_t)ldb : (size_t)HALF * ldb;
    const unsigned ldsw = (unsigned)wid * 1024u;
    const int aoff = lds_byte(wr * 64 + fr, fq * 8), boff = lds_byte(wc * 32 + fr, fq * 8);
#define PG8_SA(b, h) (((b) * 2 + (h)) * HTB)
#define PG8_SB(b, h) ((4 + (b) * 2 + (h)) * HTB)
#define PG8_STAGE(bufoff, gbase, voff) do { _Pragma("unroll") for (int _i = 0; _i < 2; ++_i) \
        __builtin_amdgcn_global_load_lds((const unsigned*)((const char*)(gbase) + (voff)[_i]), (LAS unsigned*)(lds + (bufoff) + ldsw + _i * 8192), 16, 0, 0); } while (0)
#define PG8_LDA(dst, b, h) do { _Pragma("unroll") for (int m = 0; m < 4; ++m) _Pragma("unroll") for (int k = 0; k < 2; ++k) dst[m][k] = *(const LAS bf16x8*)(lds + PG8_SA(b, h) + aoff + m * 2048 + k * 1024); } while (0)
#define PG8_LDB(dst, b, h) do { _Pragma("unroll") for (int n = 0; n < 2; ++n) _Pragma("unroll") for (int k = 0; k < 2; ++k) dst[n][k] = *(const LAS bf16x8*)(lds + PG8_SB(b, h) + boff + n * 2048 + k * 1024); } while (0)
#define PG8_MMA(ai, bj, At, Bt) do { __builtin_amdgcn_s_setprio(1); _Pragma("unroll") for (int m = 0; m < 4; ++m) _Pragma("unroll") for (int n = 0; n < 2; ++n) _Pragma("unroll") for (int k = 0; k < 2; ++k) \
        acc[ai][bj][m][n] = __builtin_amdgcn_mfma_f32_16x16x32_bf16(Bt[n][k], At[m][k], acc[ai][bj][m][n], 0, 0, 0); __builtin_amdgcn_s_setprio(0); } while (0)
#define PG8_WAIT_V(n) asm volatile("s_waitcnt vmcnt(" #n ")" ::: "memory")
#define PG8_WAIT_L(n) asm volatile("s_waitcnt lgkmcnt(" #n ")" ::: "memory")
#define PG8_BAR __builtin_amdgcn_s_barrier()
#define PG8_SCHED __builtin_amdgcn_sched_barrier(0)
    Unit cur, nxt; int ui = 0;
    if (!S.next(0, cur)) return;
    f32x4 acc[2][2][4][2];
#pragma unroll
    for (int a = 0; a < 2; ++a)
#pragma unroll
        for (int b = 0; b < 2; ++b)
#pragma unroll
            for (int m = 0; m < 4; ++m)
#pragma unroll
                for (int n = 0; n < 2; ++n) acc[a][b][m][n] = (f32x4){0.f, 0.f, 0.f, 0.f};
    bf16x8 At[4][2], B0[2][2], B1[2][2];
    const char* cA = cur.A; const char* cB = cur.B;
    if constexpr (SP2) {
        PG8_STAGE(PG8_SB(0, 0), cB, voffB); PG8_STAGE(PG8_SB(0, 1), cB + hstepB, voffB); PG8_STAGE(PG8_SA(0, 0), cA, voffA); PG8_STAGE(PG8_SA(0, 1), cA + hstepA, voffA);
        if (wr == 1) PG8_BAR;
        PG8_WAIT_V(2); PG8_BAR;
        PG8_STAGE(PG8_SB(1, 0), cB + kstepB, voffB); PG8_STAGE(PG8_SA(1, 0), cA + kstepA, voffA); PG8_STAGE(PG8_SB(1, 1), cB + hstepB + kstepB, voffB);
        PG8_WAIT_V(6); PG8_BAR;
    } else {
        PG8_STAGE(PG8_SB(0, 0), cB, voffB); PG8_STAGE(PG8_SA(0, 0), cA, voffA); PG8_STAGE(PG8_SB(0, 1), cB + hstepB, voffB); PG8_STAGE(PG8_SA(0, 1), cA + hstepA, voffA);
        if (wr == 1) PG8_BAR;
        PG8_WAIT_V(4); PG8_BAR;
        PG8_STAGE(PG8_SB(1, 0), cB + kstepB, voffB); PG8_STAGE(PG8_SA(1, 0), cA + kstepA, voffA); PG8_STAGE(PG8_SB(1, 1), cB + hstepB + kstepB, voffB);
        PG8_WAIT_V(6); PG8_BAR;
    }
    for (;;) {
        const bool has_next = S.next(ui + 1, nxt);
        const char* nA = has_next ? nxt.A : cA; const char* nB = has_next ? nxt.B : cB;
        const int nt = cur.nt;
#pragma clang loop unroll(disable)
        for (int t = 0; t < nt; t += 2) {
            const bool last = (t == nt - 2);
            const char* a1 = cA + (size_t)(t + 1) * kstepA;
            const char* a2 = last ? nA : cA + (size_t)(t + 2) * kstepA; const char* b2 = last ? nB : cB + (size_t)(t + 2) * kstepB;
            const char* a3 = a2 + kstepA; const char* b3 = b2 + kstepB;
            if constexpr (SP2) {
            PG8_LDB(B0, 0, 0); PG8_LDB(B1, 0, 1); PG8_SCHED; PG8_LDA(At, 0, 0); PG8_STAGE(PG8_SA(1, 1), a1 + hstepA, voffA);
            PG8_WAIT_V(8); PG8_WAIT_L(0); PG8_BAR; PG8_MMA(0, 0, At, B0); PG8_MMA(0, 1, At, B1); PG8_BAR; PG8_SCHED;
            PG8_LDA(At, 0, 1); PG8_STAGE(PG8_SB(0, 0), b2, voffB); PG8_STAGE(PG8_SB(0, 1), b2 + hstepB, voffB); PG8_STAGE(PG8_SA(0, 0), a2, voffA);
            PG8_WAIT_V(8); PG8_WAIT_L(0); PG8_BAR; PG8_MMA(1, 0, At, B0); PG8_MMA(1, 1, At, B1); PG8_BAR; PG8_SCHED;
            PG8_LDB(B0, 1, 0); PG8_LDB(B1, 1, 1); PG8_SCHED; PG8_LDA(At, 1, 0); PG8_STAGE(PG8_SA(0, 1), a2 + hstepA, voffA);
            PG8_WAIT_V(8); PG8_WAIT_L(0); PG8_BAR; PG8_MMA(0, 0, At, B0); PG8_MMA(0, 1, At, B1); PG8_BAR; PG8_SCHED;
            PG8_LDA(At, 1, 1); PG8_STAGE(PG8_SB(1, 0), b3, voffB); PG8_STAGE(PG8_SB(1, 1), b3 + hstepB, voffB); PG8_STAGE(PG8_SA(1, 0), a3, voffA);
            PG8_WAIT_V(8); PG8_WAIT_L(0); PG8_BAR; PG8_MMA(1, 0, At, B0); PG8_MMA(1, 1, At, B1); PG8_BAR; PG8_SCHED;
            } else {
            PG8_LDB(B0, 0, 0); PG8_SCHED; PG8_LDA(At, 0, 0); PG8_STAGE(PG8_SA(1, 1), a1 + hstepA, voffA);
            PG8_WAIT_L(8); PG8_BAR; PG8_WAIT_L(0); PG8_MMA(0, 0, At, B0); PG8_BAR; PG8_SCHED;
            PG8_LDB(B1, 0, 1); PG8_STAGE(PG8_SB(0, 0), b2, voffB);
            PG8_BAR; PG8_WAIT_L(0); PG8_MMA(0, 1, At, B1); PG8_BAR;
            PG8_LDA(At, 0, 1); PG8_STAGE(PG8_SA(0, 0), a2, voffA);
            PG8_BAR; PG8_WAIT_L(0); PG8_MMA(1, 0, At, B0); PG8_BAR; PG8_SCHED;
            PG8_STAGE(PG8_SB(0, 1), b2 + hstepB, voffB);
            PG8_WAIT_V(6); PG8_BAR; PG8_MMA(1, 1, At, B1); PG8_BAR;
            PG8_LDB(B0, 1, 0); PG8_SCHED; PG8_LDA(At, 1, 0); PG8_STAGE(PG8_SA(0, 1), a2 + hstepA, voffA);
            PG8_WAIT_L(8); PG8_BAR; PG8_WAIT_L(0); PG8_MMA(0, 0, At, B0); PG8_BAR; PG8_SCHED;
            PG8_LDB(B1, 1, 1); PG8_STAGE(PG8_SB(1, 0), b3, voffB);
            PG8_BAR; PG8_WAIT_L(0); PG8_MMA(0, 1, At, B1); PG8_BAR;
            PG8_LDA(At, 1, 1); PG8_STAGE(PG8_SA(1, 0), a3, voffA);
            PG8_BAR; PG8_WAIT_L(0); PG8_MMA(1, 0, At, B0); PG8_BAR; PG8_SCHED;
            PG8_STAGE(PG8_SB(1, 1), b3 + hstepB, voffB);
            PG8_WAIT_V(6); PG8_BAR; PG8_MMA(1, 1, At, B1); PG8_BAR;
            }
        }
        if constexpr (ALIGN_EPI) { if (wr == 0) PG8_BAR; }
        E(acc, cur, wr, wc, fr, fq);
        if (!has_next) break;
        if (!(Epi::KEEP && cur.kind != 2)) {
#pragma unroll
        for (int a = 0; a < 2; ++a)
#pragma unroll
            for (int b = 0; b < 2; ++b)
#pragma unroll
                for (int m = 0; m < 4; ++m)
#pragma unroll
                    for (int n = 0; n < 2; ++n) acc[a][b][m][n] = (f32x4){0.f, 0.f, 0.f, 0.f};
        }
        cur = nxt; cA = nA; cB = nB; ++ui;
        if constexpr (ALIGN_EPI) { if (wr == 1) PG8_BAR; }
    }
    PG8_WAIT_V(0);
    if constexpr (!ALIGN_EPI) { if (wr == 0) PG8_BAR; }
    PG8_BAR;
#undef PG8_SA
#undef PG8_SB
#undef PG8_STAGE
#undef PG8_LDA
#undef PG8_LDB
#undef PG8_MMA
#undef PG8_WAIT_V
#undef PG8_WAIT_L
#undef PG8_BAR
#undef PG8_SCHED
}
}
using pg8::Unit;
constexpr size_t PKB = 16384;
__device__ __forceinline__ size_t pk_off(int row, int col, int ktiles) { return ((size_t)(row >> 7) * ktiles + (col >> 6)) * PKB + pg8::lds_byte(row & 127, col & 63); }

#define XB_TMO      128
#define XB_XCNT(j)  (256  + 64 * (j))
#define XB_XSUB(j)  (1280 + 64 * (j))
#define XB_XGEN(j)  (2304 + 64 * (j))
#define XB_TOP      3328
#define XB_TOPGEN   3392
#define XCD_BAR_WORDS 3456
#define XB_SPIN_CAP (1u << 18)

__device__ __forceinline__ unsigned xb_ld(unsigned* p)              { return __hip_atomic_load(p, __ATOMIC_RELAXED, __HIP_MEMORY_SCOPE_AGENT); }
__device__ __forceinline__ unsigned xb_add(unsigned* p, unsigned v) { return __hip_atomic_fetch_add(p, v, __ATOMIC_RELAXED, __HIP_MEMORY_SCOPE_AGENT); }
__device__ __forceinline__ unsigned xb_xcc_id() { return (unsigned)__builtin_amdgcn_s_getreg((3 << 11) | 20) & 0xFu; }
#define XB_SPIN(cond, bar) do { unsigned _sp = 0; while (cond) { __builtin_amdgcn_s_sleep(1); \
    if ((++_sp & 255u) == 0u) { if (xb_ld(&(bar)[XB_TMO])) break; if (_sp > XB_SPIN_CAP) { atomicAdd(&(bar)[XB_TMO], 1u); break; } } } } while (0)

struct XcdBarrier { unsigned* bar; unsigned x; volatile LAS unsigned* st; };

__device__ __forceinline__ XcdBarrier xcd_barrier_post(unsigned* bar, volatile LAS unsigned* st) {
    XcdBarrier b; b.bar = bar; b.x = xb_xcc_id(); b.st = st;
    if (threadIdx.x == 0) (void)xb_add(&bar[XB_XCNT(b.x)], 1u);
    return b;
}
__device__ __forceinline__ void xcd_barrier_complete(unsigned* bar, unsigned x, unsigned& nloc, unsigned& nx) {
    const unsigned G = gridDim.x * gridDim.y * gridDim.z;
    unsigned sum, cnt, mine, sp = 0u;
    for (;;) {
        sum = 0u; cnt = 0u; mine = 0u;
#pragma unroll
        for (unsigned j = 0; j < 16; ++j) { const unsigned c = xb_ld(&bar[XB_XCNT(j)]); sum += c; cnt += (c > 0u) ? 1u : 0u; mine = (j == x) ? c : mine; }
        if (sum == G) break;
        __builtin_amdgcn_s_sleep(1);
        if ((++sp & 255u) == 0u) { if (xb_ld(&bar[XB_TMO])) break; if (sp > XB_SPIN_CAP) { atomicAdd(&bar[XB_TMO], 1u); break; } }
    }
    nloc = mine > 0u ? mine : 1u; nx = cnt > 0u ? cnt : 1u;
}
__device__ __forceinline__ void xcd_barrier(const XcdBarrier& b) {
    asm volatile("s_waitcnt vmcnt(0)" ::: "memory");
    __syncthreads();
    if (threadIdx.x == 0) {
        unsigned* bar = b.bar;
        __builtin_amdgcn_s_waitcnt(0);
        unsigned nloc = b.st[0], nx = b.st[1];
        if (nloc == 0u) { xcd_barrier_complete(bar, b.x, nloc, nx); b.st[0] = nloc; b.st[1] = nx; }
        const unsigned old = xb_add(&bar[XB_XSUB(b.x)], 1u);
        const unsigned gen = old / nloc;
        if (old + 1u == (gen + 1u) * nloc) {
            __builtin_amdgcn_fence(__ATOMIC_RELEASE, "agent");
            asm volatile("s_waitcnt vmcnt(0)" ::: "memory");
            const unsigned og = xb_add(&bar[XB_TOP], 1u);
            const unsigned tg = og / nx;
            if (og + 1u == (tg + 1u) * nx) xb_add(&bar[XB_TOPGEN], 1u);
            else XB_SPIN(xb_ld(&bar[XB_TOPGEN]) == tg, bar);
            __builtin_amdgcn_fence(__ATOMIC_ACQUIRE, "agent");
            xb_add(&bar[XB_XGEN(b.x)], 1u);
            asm volatile("s_waitcnt vmcnt(0)" ::: "memory");
        } else {
            XB_SPIN(xb_ld(&bar[XB_XGEN(b.x)]) == gen, bar);
            __builtin_amdgcn_fence(__ATOMIC_ACQUIRE, "agent");
            asm volatile("s_waitcnt vmcnt(0)" ::: "memory");
        }
    }
    __syncthreads();
}

struct Params {
    const float *x, *mem, *w_in, *b_in, *conv_w, *mh_norm_w, *w_mem_kv, *w_proj_m, *w_proj_c, *w_proj_x, *w_out, *ln_w, *ln_b;
    float* out; unsigned char* ws;
    int ph_lo, ph_hi;
};

__device__ __forceinline__ void transpose_item_pk(const float* src, size_t src_ld, int col0, int ncv, unsigned char* img, int ktiles, int n0, int k0, LAS unsigned* scr, int lane, int kdst_off = 0) {
    const float* sp = src + (size_t)k0 * src_ld + col0 + lane;
    if (ncv > 0) {
        float a[32], b[32];
#pragma unroll
        for (int i = 0; i < 32; ++i) { a[i] = 0.f; b[i] = 0.f; if (lane < ncv) { a[i] = __builtin_nontemporal_load(sp + (size_t)(2 * i) * src_ld); b[i] = __builtin_nontemporal_load(sp + (size_t)(2 * i + 1) * src_ld); } }
#pragma unroll
        for (int i = 0; i < 32; ++i) scr[i * 66 + lane] = cvt_pk_bf16_asm(a[i], b[i]);
    } else {
#pragma unroll 8
        for (int i = 0; i < 32; ++i) scr[i * 66 + lane] = 0u;
    }
    LDS_WAIT(); asm volatile("" ::: "memory");
    const int rr = lane >> 2, ch = lane & 3;
    unsigned char* blk = img + ((size_t)(2 * (n0 >> 8)) * ktiles + ((k0 + kdst_off) >> 6)) * PKB;
    const int wcs = (n0 >> 6) & 3;
#pragma unroll
    for (int sub = 0; sub < 8; ++sub) {
        const int grp = sub >> 2, np = (sub >> 1) & 1, k32 = sub & 1;
        const int nl = 32 * grp + 8 * (rr >> 2) + 4 * np + (rr & 3);
        const LAS unsigned* s = scr + (16 * k32 + 4 * ch) * 66 + nl;
        u32x4 o; o.x = s[0]; o.y = s[66]; o.z = s[132]; o.w = s[198];
        const int rho = 32 * wcs + 16 * np + rr;
        *(u32x4*)(blk + (size_t)grp * ktiles * PKB + pg8::lds_byte(rho, 32 * k32 + 8 * ch)) = o;
    }
    LDS_WAIT(); asm volatile("" ::: "memory");
}
__device__ __forceinline__ void cvt_item_pk(const float* src, unsigned char* img, int item, int lane) {
    const int rg = item >> 5, cg4 = item & 31, rr = lane >> 2, ch = lane & 3, row = rg * 16 + rr;
    f32x4 a[4], b[4];
#pragma unroll
    for (int q = 0; q < 4; ++q) { const int col = (cg4 * 4 + q) * 32 + 8 * ch;
        a[q] = __builtin_nontemporal_load((const f32x4*)(src + (size_t)row * 4096 + col)); b[q] = __builtin_nontemporal_load((const f32x4*)(src + (size_t)row * 4096 + col + 4)); }
#pragma unroll
    for (int q = 0; q < 4; ++q) { const int col = (cg4 * 4 + q) * 32 + 8 * ch;
        u32x4 o; o.x = cvt_pk_bf16_asm(a[q][0], a[q][1]); o.y = cvt_pk_bf16_asm(a[q][2], a[q][3]); o.z = cvt_pk_bf16_asm(b[q][0], b[q][1]); o.w = cvt_pk_bf16_asm(b[q][2], b[q][3]);
        *(u32x4*)(img + pk_off(row, col, 64)) = o; }
}
__device__ __forceinline__ void p0_prologue(const Params& p, LAS unsigned char* lds, int gw, int NGW, int wave, int lane) {
    LAS unsigned* scr = (LAS unsigned*)(lds + wave * 8448);
    unsigned char* ws = p.ws;
    constexpr int I_IN = 64 * 644, I_KV = 64 * 64, I_PM = 64 * 64, I_PC = 32 * 64, I_PX = 32 * 64, I_O = 64 * 64;
    constexpr int NITEMS = I_IN + I_KV + I_PM + I_PC + I_PX + I_O;
    for (int it = gw; it < NITEMS; it += NGW) {
        int r = it;
        if (r < I_IN) { const int kb = r / 644, nb = r % 644, n0 = nb * 64; int col0, ncv;
            if (n0 < 16384) { col0 = n0; ncv = 64; } else if (n0 < 40960) { col0 = n0 + 16; ncv = 64; } else if (n0 == 40960) { col0 = 16384; ncv = 16; } else { col0 = 0; ncv = 0; }
            transpose_item_pk(p.w_in, DIN, col0, ncv, ws + WS_WINT, 64, n0, kb * 64, scr, lane); continue; }
        r -= I_IN;
        if (r < I_KV) { transpose_item_pk(p.w_mem_kv, 4096, (r % 64) * 64, 64, ws + WS_WKVT, 64, (r % 64) * 64, (r / 64) * 64, scr, lane); continue; }
        r -= I_KV;
        if (r < I_PM) { transpose_item_pk(p.w_proj_m, 4096, (r % 64) * 64, 64, ws + WS_WPMT, 64, (r % 64) * 64, (r / 64) * 64, scr, lane); continue; }
        r -= I_PM;
        if (r < I_PC) { transpose_item_pk(p.w_proj_c, 4096, (r % 64) * 64, 64, ws + WS_WPCXT, 64, (r % 64) * 64, (r / 64) * 64, scr, lane); continue; }
        r -= I_PC;
        if (r < I_PX) { transpose_item_pk(p.w_proj_x, 4096, (r % 64) * 64, 64, ws + WS_WPCXT, 64, (r % 64) * 64, (r / 64) * 64, scr, lane, 2048); continue; }
        r -= I_PX;
        transpose_item_pk(p.w_out, 4096, (r % 64) * 64, 64, ws + WS_WOT, 64, (r % 64) * 64, (r / 64) * 64, scr, lane);
    }
    for (int it = gw; it < (T / 16) * 32; it += NGW) cvt_item_pk(p.x, ws + WS_XB, it, lane);
    for (int it = gw; it < (TM / 16) * 32; it += NGW) cvt_item_pk(p.mem, ws + WS_MEMB, it, lane);
    float* BU = (float*)(ws + WS_BU);
    for (int c = gw * 64 + lane; c < NU; c += NGW * 64) {
        float v = 0.f;
        if (c < 16384) v = p.b_in[c]; else if (c < 40960) v = p.b_in[c + 16]; else if (c < 40976) v = p.b_in[16384 + (c - 40960)];
        BU[c] = v;
    }
}

__device__ __forceinline__ int act_of(int c0) {
    if (c0 >= UO && c0 < UZ) return 1;
    if (c0 >= UZ && c0 < UCB) return 2;
    if (c0 >= UCZ && c0 < UXQ) return 2;
    if (c0 >= UXZ && c0 < UG) return 2;
    if (c0 >= UG && c0 < UI) return 1;
    return 0;
}
struct SchedP1 {
    int G, c; const char *xb, *memb, *wint, *wkvt;
    __device__ __forceinline__ bool next(int i, Unit& u) const {
        long L = (long)i * G + c;
        if (L < 5152) { pg8::tile_map(L, 32, 161, u.pm, u.pn); u.A = xb + (size_t)u.pm * (128 * PKB); u.B = wint + (size_t)u.pn * (128 * PKB); u.nt = 64; u.kind = 0; return true; }
        L -= 5152;
        if (L < 64) { u.pm = (int)L / 16; u.pn = (int)L % 16; u.A = memb + (size_t)u.pm * (128 * PKB); u.B = wkvt + (size_t)u.pn * (128 * PKB); u.nt = 64; u.kind = 1; return true; }
        return false;
    }
};
struct EpiP1 {
    static constexpr bool PERM = true, KEEP = false;
    bf16_t* U; const float* bU; bf16_t* KMEM; bf16_t* VT; LAS unsigned char* lds;
    __device__ __forceinline__ void operator()(f32x4 (&acc)[2][2][4][2], const Unit& u, int wr, int wc, int fr, int fq) const {
        asm volatile("" : "+v"(fr), "+v"(fq));
#if defined(MK_PROBE_EPI_OFF)
        if (u.kind != 77) return;
#endif
        const int row0 = wr * 64 + fr, col0 = wc * 64 + 8 * fq;
        if (u.kind == 1 && u.pn >= 8) {
            bf16_t* vb = VT + (size_t)((u.pn - 8) * 256 + col0) * 1024 + u.pm * 256 + row0;
#pragma unroll
            for (int ai = 0; ai < 2; ++ai)
#pragma unroll
                for (int m = 0; m < 4; ++m)
#pragma unroll
                    for (int bj = 0; bj < 2; ++bj)
#pragma unroll
                        for (int n = 0; n < 2; ++n)
#pragma unroll
                            for (int j = 0; j < 4; j += 2) { const unsigned w = cvt_pk_bf16(acc[ai][bj][m][n][j], acc[ai][bj][m][n][j + 1]);
                                bf16_t* q = vb + (size_t)(bj * 32 + 4 * n + j) * 1024 + ai * 128 + m * 16;
                                q[0] = (bf16_t)(w & 0xffffu); q[1024] = (bf16_t)(w >> 16); }
            return;
        }
        bf16_t* base; int ldc; const float* bias; int act = 0; float sc = 1.f;
        if (u.kind == 0) { const int c0 = u.pn * 256; base = U + (size_t)u.pm * 256 * NU + c0; ldc = NU; bias = bU + c0; act = act_of(c0); if (c0 < UK) sc = 0.0625f; }
        else { base = KMEM + (size_t)u.pm * 256 * 2048 + u.pn * 256; ldc = 2048; bias = nullptr; }
        f32x4 bv[2][2];
#pragma unroll
        for (int bj = 0; bj < 2; ++bj)
#pragma unroll
            for (int n = 0; n < 2; ++n) bv[bj][n] = bias ? *(const f32x4*)(bias + col0 + bj * 32 + 4 * n) : (f32x4){0.f, 0.f, 0.f, 0.f};
        const int wid = wr * 4 + wc, lane = fr + 16 * fq;
        LAS unsigned char* stg = lds + EPI_OFF + wid * EPI_WAVE_BYTES;
        LAS unsigned char* wp = stg + fr * 144 + fq * 16;
        const LAS unsigned char* rp = stg + (lane >> 3) * 144 + (lane & 7) * 16;
        bf16_t* gp = base + (size_t)(wr * 64 + (lane >> 3)) * ldc + wc * 64 + (lane & 7) * 8;
#pragma unroll
        for (int ai = 0; ai < 2; ++ai)
#pragma unroll
            for (int m = 0; m < 4; ++m) {
#pragma unroll
                for (int bj = 0; bj < 2; ++bj) { f32x4 v0 = acc[ai][bj][m][0] + bv[bj][0], v1 = acc[ai][bj][m][1] + bv[bj][1];
                    if (act) {
#pragma unroll
                        for (int j = 0; j < 4; ++j) { const float s0 = sigmoidf_(v0[j]), s1 = sigmoidf_(v1[j]); v0[j] = (act == 1) ? s0 : v0[j] * s0; v1[j] = (act == 1) ? s1 : v1[j] * s1; } }
                    v0 = v0 * sc; v1 = v1 * sc;
                    u32x4 w; w.x = cvt_pk_bf16(v0[0], v0[1]); w.y = cvt_pk_bf16(v0[2], v0[3]); w.z = cvt_pk_bf16(v1[0], v1[1]); w.w = cvt_pk_bf16(v1[2], v1[3]);
                    *(LAS u32x4*)(wp + bj * 64) = w; }
                asm volatile("" ::: "memory");
                const u32x4 o0 = *(const LAS u32x4*)rp, o1 = *(const LAS u32x4*)(rp + 8 * 144);
                asm volatile("" ::: "memory");
                bf16_t* g0 = gp + (size_t)(ai * 128 + m * 16) * ldc;
                __builtin_nontemporal_store(o0, (u32x4*)g0); __builtin_nontemporal_store(o1, (u32x4*)(g0 + (size_t)8 * ldc)); }
    }
};
struct SchedQK {
    int G, c; const char *u, *kmem;
    __device__ __forceinline__ bool next(int i, Unit& un) const {
        const int L = i * G + c; if (L >= 128) return false;
        const int head = L & 3, rt = L >> 2;
        un.pm = rt; un.pn = head; un.A = u + ((size_t)rt * 256 * NU + UXQ + head * 512) * 2; un.B = kmem + ((size_t)(rt >> 3) * 256 * 2048 + head * 512) * 2; un.nt = 8; un.kind = 0; return true;
    }
};
struct EpiSC {
    static constexpr bool PERM = false, KEEP = false;
    float* SC;
    __device__ __forceinline__ void operator()(f32x4 (&acc)[2][2][4][2], const Unit& u, int wr, int wc, int fr, int fq) const {
        asm volatile("" : "+v"(fr), "+v"(fq));
        const float sc = 0.04419417382415922f;
        float* base = SC + (size_t)u.pm * 256 * 1024 + u.pn * 256;
        const int row0 = wr * 64 + fr, col0 = wc * 32 + 4 * fq;
#pragma unroll
        for (int ai = 0; ai < 2; ++ai)
#pragma unroll
            for (int m = 0; m < 4; ++m) { float* rowp = base + (size_t)(row0 + ai * 128 + m * 16) * 1024 + col0;
#pragma unroll
                for (int bj = 0; bj < 2; ++bj)
#pragma unroll
                    for (int n = 0; n < 2; ++n) *(f32x4*)(rowp + bj * 128 + n * 16) = acc[ai][bj][m][n] * sc; }
    }
};
struct SchedPV {
    int G, c; const char *pb, *vt;
    __device__ __forceinline__ bool next(int i, Unit& un) const {
        const int L = i * G + c; if (L >= 256) return false;
        const int n2 = L & 1, head = (L >> 1) & 3, rt = L >> 3;
        un.pm = rt; un.pn = head * 2 + n2; un.A = pb + ((size_t)rt * 256 * 1024 + head * 256) * 2; un.B = vt + ((size_t)(head * 512 + n2 * 256) * 1024 + (rt >> 3) * 256) * 2; un.nt = 4; un.kind = 0; return true;
    }
};
struct EpiPV {
    static constexpr bool PERM = true, KEEP = false;
    const bf16_t* U; bf16_t* YCX;
    __device__ __forceinline__ void operator()(f32x4 (&acc)[2][2][4][2], const Unit& u, int wr, int wc, int fr, int fq) const {
        asm volatile("" : "+v"(fr), "+v"(fq));
        const bf16_t* zb = U + (size_t)u.pm * 256 * NU + UXZ + u.pn * 256;
        const int row0 = wr * 64 + fr, col0 = wc * 32 + 8 * fq;
        const unsigned lane_off = (unsigned)((fr * 64 + fq * 16) ^ (((fr >> 3) & 1) << 5));
        unsigned char* ob = (unsigned char*)YCX + (size_t)(32 + 4 * u.pn + (wc >> 1)) * PKB + (wc & 1) * 1024 + lane_off;
#pragma unroll
        for (int ai = 0; ai < 2; ++ai)
#pragma unroll
            for (int m = 0; m < 4; ++m) { const size_t r = (size_t)(row0 + ai * 128 + m * 16);
#pragma unroll
                for (int bj = 0; bj < 2; ++bj) { const u32x4 z = *(const u32x4*)(zb + r * NU + col0 + bj * 128);
                    const f32x4 v0 = acc[ai][bj][m][0], v1 = acc[ai][bj][m][1];
                    u32x4 w; w.x = cvt_pk_bf16(v0[0] * bf_lo(z.x), v0[1] * bf_hi(z.x)); w.y = cvt_pk_bf16(v0[2] * bf_lo(z.y), v0[3] * bf_hi(z.y));
                    w.z = cvt_pk_bf16(v1[0] * bf_lo(z.z), v1[1] * bf_hi(z.z)); w.w = cvt_pk_bf16(v1[2] * bf_lo(z.w), v1[3] * bf_hi(z.w));
                    *(u32x4*)(ob + ((size_t)(2 * u.pm + ai) * 64 + 2 * bj) * PKB + (size_t)((4 * wr + m) * 2) * 1024) = w; }
                asm volatile("" ::: "memory"); }
    }
};
struct SchedMerge {
    int G, c; const char *ym, *ycx, *wpmt, *wpcxt;
    __device__ __forceinline__ bool next(int i, Unit& u) const {
        const int r = i / 3, br = i - 3 * r;
        if (!pg8::tile_map((long)r * G + c, 32, 16, u.pm, u.pn)) return false;
        u.kind = br;
        if (br == 0) { u.A = ym + (size_t)u.pm * (128 * PKB); u.B = wpmt + (size_t)u.pn * (128 * PKB); u.nt = 64; }
        else { u.A = ycx + (size_t)u.pm * (128 * PKB) + (br == 2 ? 32 * PKB : 0); u.B = wpcxt + (size_t)u.pn * (128 * PKB) + (br == 2 ? 32 * PKB : 0); u.nt = 32; }
        return true;
    }
};
struct EpiMerge {
    static constexpr bool PERM = true, KEEP = true;
    const bf16_t* U; unsigned char* MERGED;
    __device__ __forceinline__ void operator()(f32x4 (&acc)[2][2][4][2], const Unit& u, int wr, int wc, int fr, int fq) const {
        asm volatile("" : "+v"(fr), "+v"(fq));
        const int br = u.kind;
        const bf16_t* gb = U + (size_t)u.pm * 256 * NU + UG + br * 4096 + u.pn * 256;
        const int row0 = wr * 64 + fr, col0 = wc * 64 + 8 * fq;
        unsigned char* mb = MERGED + (size_t)(4 * u.pn + wc) * PKB + (unsigned)((fr * 64 + fq * 16) ^ (((fr >> 3) & 1) << 5));
        const float tiny = 1e-30f;
#pragma unroll
        for (int ai = 0; ai < 2; ++ai)
#pragma unroll
            for (int m = 0; m < 4; ++m) { const size_t r = (size_t)(row0 + ai * 128 + m * 16);
#pragma unroll
                for (int bj = 0; bj < 2; ++bj) { const int cc = col0 + bj * 32;
                    const u32x4 g = *(const u32x4*)(gb + r * NU + cc);
                    float f[8] = {bf_lo(g.x), bf_hi(g.x), bf_lo(g.y), bf_hi(g.y), bf_lo(g.z), bf_hi(g.z), bf_lo(g.w), bf_hi(g.w)};
                    if (br != 0) {
#pragma unroll
                        for (int j = 0; j < 8; ++j) f[j] = fmaxf(f[j], tiny); }
                    if (br != 2) { const u32x4 g2 = *(const u32x4*)(gb + r * NU + cc + 4096);
                        const float d[8] = {bf_lo(g2.x), bf_hi(g2.x), bf_lo(g2.y), bf_hi(g2.y), bf_lo(g2.z), bf_hi(g2.z), bf_lo(g2.w), bf_hi(g2.w)};
#pragma unroll
                        for (int j = 0; j < 8; ++j) f[j] = f[j] * __builtin_amdgcn_rcpf(fmaxf(d[j], tiny)); }
                    f32x4 v0 = acc[ai][bj][m][0], v1 = acc[ai][bj][m][1];
                    v0[0] *= f[0]; v0[1] *= f[1]; v0[2] *= f[2]; v0[3] *= f[3]; v1[0] *= f[4]; v1[1] *= f[5]; v1[2] *= f[6]; v1[3] *= f[7];
                    if (br != 2) { acc[ai][bj][m][0] = v0; acc[ai][bj][m][1] = v1; }
                    else { u32x4 w; w.x = cvt_pk_bf16(v0[0], v0[1]); w.y = cvt_pk_bf16(v0[2], v0[3]); w.z = cvt_pk_bf16(v1[0], v1[1]); w.w = cvt_pk_bf16(v1[2], v1[3]);
                        *(u32x4*)(mb + ((size_t)(2 * u.pm + ai) * 64) * PKB + (size_t)((4 * wr + m) * 2 + bj) * 1024) = w; } }
                asm volatile("" ::: "memory"); }
    }
};
struct SchedOut {
    int G, c; const char *merged, *wot;
    __device__ __forceinline__ bool next(int i, Unit& u) const {
        if (!pg8::tile_map((long)i * G + c, 32, 16, u.pm, u.pn)) return false;
        u.A = merged + (size_t)u.pm * (128 * PKB); u.B = wot + (size_t)u.pn * (128 * PKB); u.nt = 64; u.kind = 0; return true;
    }
};
struct EpiOut {
    static constexpr bool PERM = true, KEEP = false;
    const float* x; float* out;
    __device__ __forceinline__ void operator()(f32x4 (&acc)[2][2][4][2], const Unit& u, int wr, int wc, int fr, int fq) const {
        asm volatile("" : "+v"(fr), "+v"(fq));
        const size_t ob = (size_t)u.pm * 256 * 4096 + u.pn * 256;
        const int row0 = wr * 64 + fr, col0 = wc * 64 + 8 * fq;
#pragma unroll
        for (int ai = 0; ai < 2; ++ai)
#pragma unroll
            for (int m = 0; m < 4; ++m) { const size_t r = (size_t)(row0 + ai * 128 + m * 16);
#pragma unroll
                for (int bj = 0; bj < 2; ++bj)
#pragma unroll
                    for (int n = 0; n < 2; ++n) { const size_t o = ob + r * 4096 + col0 + bj * 32 + n * 4;
                        const f32x4 xv = *(const f32x4*)(x + o);
                        *(f32x4*)(out + o) = xv * DN_ALPHA + acc[ai][bj][m][n]; }
                asm volatile("" ::: "memory"); }
    }
};

__device__ __forceinline__ void conv_phase(const Params& p, int gtid, int NGT) {
    const bf16_t* U = (const bf16_t*)(p.ws + WS_U); bf16_t* YCX = (bf16_t*)(p.ws + WS_YCX);
    for (int idx = gtid; idx < T * 256; idx += NGT) {
        const int t = idx >> 8, c = (idx & 255) * 8, tl = t & (SEQ - 1);
        const bf16_t* row = U + (size_t)t * NU;
        const u32x4 cb = *(const u32x4*)(row + UCB + c), cz = *(const u32x4*)(row + UCZ + c);
        const unsigned cbw[4] = {cb.x, cb.y, cb.z, cb.w}, czw[4] = {cz.x, cz.y, cz.z, cz.w};
        float accv[8];
#pragma unroll
        for (int j = 0; j < 8; ++j) accv[j] = 0.f;
#pragma unroll
        for (int w = 0; w < 3; ++w) {
            const int dt = 2 - w;
            if (tl >= dt) {
                const bf16_t* r2 = row - (size_t)dt * NU;
                const u32x4 a = *(const u32x4*)(r2 + UCC + c), b = *(const u32x4*)(r2 + UCX + c);
                const unsigned aw[4] = {a.x, a.y, a.z, a.w}, bw[4] = {b.x, b.y, b.z, b.w};
                const f32x4 w0 = *(const f32x4*)(p.conv_w + w * 2048 + c), w1 = *(const f32x4*)(p.conv_w + w * 2048 + c + 4);
                const float wv[8] = {w0[0], w0[1], w0[2], w0[3], w1[0], w1[1], w1[2], w1[3]};
#pragma unroll
                for (int j = 0; j < 4; ++j) { accv[2 * j] += wv[2 * j] * (bf_lo(aw[j]) * bf_lo(bw[j])); accv[2 * j + 1] += wv[2 * j + 1] * (bf_hi(aw[j]) * bf_hi(bw[j])); }
            }
        }
        u32x4 o; unsigned ow[4];
#pragma unroll
        for (int j = 0; j < 4; ++j) ow[j] = cvt_pk_bf16(bf_lo(cbw[j]) * accv[2 * j] * bf_lo(czw[j]), bf_hi(cbw[j]) * accv[2 * j + 1] * bf_hi(czw[j]));
        o.x = ow[0]; o.y = ow[1]; o.z = ow[2]; o.w = ow[3];
        *(u32x4*)((unsigned char*)YCX + pk_off(t, c, 64)) = o;
    }
}
__device__ __forceinline__ void softmax_phase(const Params& p, int gw, int NGW, int lane) {
    const float* SC = (const float*)(p.ws + WS_SC); bf16_t* PB = (bf16_t*)(p.ws + WS_PB);
    for (int it = gw; it < T * 4; it += NGW) {
        const f32x4 s = *(const f32x4*)(SC + (size_t)it * 256 + 4 * lane);
        const float mx = wave_max(fmaxf(fmaxf(s[0], s[1]), fmaxf(s[2], s[3])));
        const float e0 = __expf(s[0] - mx), e1 = __expf(s[1] - mx), e2 = __expf(s[2] - mx), e3 = __expf(s[3] - mx);
        const float inv = 1.0f / wave_sum((e0 + e1) + (e2 + e3));
        u32x2 o; o.x = cvt_pk_bf16(e0 * inv, e1 * inv); o.y = cvt_pk_bf16(e2 * inv, e3 * inv);
        *(u32x2*)(PB + (size_t)it * 256 + 4 * lane) = o;
    }
}
__device__ __forceinline__ void ym_phase(const Params& p, int gw, int NGW, int lane) {
    const bf16_t* U = (const bf16_t*)(p.ws + WS_U); const bf16_t* HR = (const bf16_t*)(p.ws + WS_HRAW); bf16_t* YM = (bf16_t*)(p.ws + WS_YM);
    for (int it = gw; it < T * 8; it += NGW) {
        const int t = it >> 3, h = it & 7, c = h * 512 + 8 * lane;
        const u32x4 hv = *(const u32x4*)(HR + (size_t)t * 4096 + c);
        const u32x4 mo = *(const u32x4*)(U + (size_t)t * NU + UO + c), mz = *(const u32x4*)(U + (size_t)t * NU + UZ + c);
        const f32x4 w0 = *(const f32x4*)(p.mh_norm_w + c), w1 = *(const f32x4*)(p.mh_norm_w + c + 4);
        float v[8] = {bf_lo(hv.x), bf_hi(hv.x), bf_lo(hv.y), bf_hi(hv.y), bf_lo(hv.z), bf_hi(hv.z), bf_lo(hv.w), bf_hi(hv.w)};
        float s = 0.f;
#pragma unroll
        for (int j = 0; j < 8; ++j) s += v[j];
        const float mean = wave_sum(s) * (1.0f / 512.0f);
        float q = 0.f;
#pragma unroll
        for (int j = 0; j < 8; ++j) { v[j] -= mean; q += v[j] * v[j]; }
        const float rstd = 1.0f / sqrtf(wave_sum(q) * (1.0f / 512.0f) + LN_EPS);
        const float g[8] = {bf_lo(mo.x) * bf_lo(mz.x), bf_hi(mo.x) * bf_hi(mz.x), bf_lo(mo.y) * bf_lo(mz.y), bf_hi(mo.y) * bf_hi(mz.y),
                            bf_lo(mo.z) * bf_lo(mz.z), bf_hi(mo.z) * bf_hi(mz.z), bf_lo(mo.w) * bf_lo(mz.w), bf_hi(mo.w) * bf_hi(mz.w)};
        const float wv[8] = {w0[0], w0[1], w0[2], w0[3], w1[0], w1[1], w1[2], w1[3]};
        u32x4 o; unsigned ow[4];
#pragma unroll
        for (int j = 0; j < 4; ++j) ow[j] = cvt_pk_bf16(v[2 * j] * rstd * wv[2 * j] * g[2 * j], v[2 * j + 1] * rstd * wv[2 * j + 1] * g[2 * j + 1]);
        o.x = ow[0]; o.y = ow[1]; o.z = ow[2]; o.w = ow[3];
        *(u32x4*)((unsigned char*)YM + pk_off(t, c, 64)) = o;
    }
}
__device__ __forceinline__ void ln_phase(const Params& p, int gw, int NGW, int lane) {
    for (int m = gw; m < T; m += NGW) {
        f32x4* r = (f32x4*)(p.out + (size_t)m * D) + lane;
        f32x4 v[16]; float s = 0.f;
#pragma unroll
        for (int j = 0; j < 16; ++j) { v[j] = r[64 * j]; s += (v[j][0] + v[j][1]) + (v[j][2] + v[j][3]); }
        const float mean = wave_sum(s) * (1.0f / D); float q = 0.f;
#pragma unroll
        for (int j = 0; j < 16; ++j) { v[j] = v[j] - mean; q += (v[j][0] * v[j][0] + v[j][1] * v[j][1]) + (v[j][2] * v[j][2] + v[j][3] * v[j][3]); }
        const float rstd = 1.0f / sqrtf(wave_sum(q) * (1.0f / D) + LN_EPS);
#pragma unroll
        for (int j = 0; j < 16; ++j) { const f32x4 w = *((const f32x4*)p.ln_w + lane + 64 * j), b = *((const f32x4*)p.ln_b + lane + 64 * j); r[64 * j] = v[j] * rstd * w + b; }
    }
}

__device__ __forceinline__ void mlstm_naive(const Params& p, LAS unsigned char* lds, int unit, int wave, int lane) {
    const int s = unit & 7, h = (unit >> 3) & 7, b = unit >> 6;
    LAS float* part = (LAS float*)lds;
    LAS float* pden = part + 2 * 8 * 64;
    const bf16_t* Ub = (const bf16_t*)(p.ws + WS_U) + (size_t)(b * SEQ) * NU;
    bf16_t* HR = (bf16_t*)(p.ws + WS_HRAW) + (size_t)(b * SEQ) * 4096 + h * 512 + s * 64 + lane;
    float C[32], n[32];
#pragma unroll
    for (int d = 0; d < 32; ++d) { C[d] = 0.f; n[d] = 0.f; }
    float m = 0.f;
    for (int t = 0; t < SEQ; ++t) {
        const bf16_t* row = Ub + (size_t)t * NU;
        u32x4 kk[4], qq[4];
#pragma unroll
        for (int j = 0; j < 4; ++j) { kk[j] = *(const u32x4*)(row + UK + h * 256 + wave * 32 + 8 * j); qq[j] = *(const u32x4*)(row + UQ + h * 256 + wave * 32 + 8 * j); }
        const float vv = bf2f(row[UV + h * 512 + s * 64 + lane]);
        const float ig = bf2f(row[UI + h]), fp = bf2f(row[UF + h]);
        const float lf = fminf(fp, 0.f) - log1pf(__expf(-fabsf(fp)));
        const float mn = fmaxf(lf + m, ig), fd = __expf(lf + m - mn), iw = __expf(ig - mn);
        m = mn;
        float num = 0.f, den = 0.f;
#pragma unroll
        for (int j = 0; j < 4; ++j) {
            const unsigned kw[4] = {kk[j].x, kk[j].y, kk[j].z, kk[j].w}, qw[4] = {qq[j].x, qq[j].y, qq[j].z, qq[j].w};
#pragma unroll
            for (int e = 0; e < 4; ++e) {
                const int d = 8 * j + 2 * e;
                const float k0 = iw * bf_lo(kw[e]), k1 = iw * bf_hi(kw[e]), q0 = bf_lo(qw[e]), q1 = bf_hi(qw[e]);
                C[d] = fd * C[d] + k0 * vv; n[d] = fd * n[d] + k0; num += q0 * C[d]; den += q0 * n[d];
                C[d + 1] = fd * C[d + 1] + k1 * vv; n[d + 1] = fd * n[d + 1] + k1; num += q1 * C[d + 1]; den += q1 * n[d + 1];
            }
        }
        const int buf = t & 1;
        part[(buf * 8 + wave) * 64 + lane] = num; if (lane == 0) pden[buf * 8 + wave] = den;
        __syncthreads();
        if (wave == (t & 7)) {
            float nt_ = 0.f, dt_ = 0.f;
#pragma unroll
            for (int w = 0; w < 8; ++w) { nt_ += part[(buf * 8 + w) * 64 + lane]; dt_ += pden[buf * 8 + w]; }
            const float hv = nt_ / fmaxf(fabsf(dt_), __expf(-m));
            HR[(size_t)t * 4096] = (bf16_t)(cvt_pk_bf16(hv, 0.f) & 0xffffu);
        }
    }
    __syncthreads();
}

constexpr int ML_RS = 528, ML_VS = 160;
constexpr int ML_Q = 0, ML_K = 64 * ML_RS, ML_V = 2 * 64 * ML_RS, ML_VSC = ML_V + 64 * ML_VS, ML_CT = ML_VSC + 64 * ML_VS, ML_END = ML_CT + 80 * ML_RS;
static_assert(ML_END <= RING_BYTES, "mLSTM LDS map");
typedef short s16x4 __attribute__((ext_vector_type(4)));
__device__ __forceinline__ bf16x8 tr_pair(const LAS unsigned char* a0, const LAS unsigned char* a1) {
    const s16x4 lo = __builtin_amdgcn_ds_read_tr16_b64_v4i16((LAS s16x4*)a0), hi = __builtin_amdgcn_ds_read_tr16_b64_v4i16((LAS s16x4*)a1);
    return (bf16x8){lo[0], lo[1], lo[2], lo[3], hi[0], hi[1], hi[2], hi[3]};
}
constexpr int ML_TAB_BS = EPI_OFF, ML_TAB_CJ = EPI_OFF + 8192, ML_TAB_CM = EPI_OFF + 16384, ML_TAB_MST = EPI_OFF + 24576;
static_assert(ML_TAB_MST + 256 <= LDS_BYTES, "mLSTM gate tables");
__device__ __forceinline__ void mlstm_unit(const Params& p, LAS unsigned char* lds, int unit, int wave, int lane, int tid) {
    const int s = unit & 7, h = (unit >> 3) & 7, b = unit >> 6;
    const int g = lane >> 4, li = lane & 15, q4 = li >> 2, p4 = lane & 3;
    const int tt = wave >> 1, vh = wave & 1;
    const bf16_t* U = (const bf16_t*)(p.ws + WS_U) + (size_t)(b * SEQ) * NU;
    bf16_t* HR = (bf16_t*)(p.ws + WS_HRAW) + (size_t)(b * SEQ) * 4096 + h * 512 + s * 64;
    const int srow = tid >> 5, sch = tid & 31, vrow = tid >> 3, vch = tid & 7;
    LAS float* tBS = (LAS float*)(lds + ML_TAB_BS); LAS float* tCJ = (LAS float*)(lds + ML_TAB_CJ); LAS float* tCM = (LAS float*)(lds + ML_TAB_CM); LAS float* tMST = (LAS float*)(lds + ML_TAB_MST);
    if (tid < 64) {
        *(LAS u32x4*)(lds + ML_V + tid * ML_VS + 128) = (u32x4){0x3F80u, 0u, 0u, 0u}; *(LAS u32x4*)(lds + ML_V + tid * ML_VS + 144) = (u32x4){0u, 0u, 0u, 0u};
        *(LAS u32x4*)(lds + ML_VSC + tid * ML_VS + 128) = (u32x4){0u, 0u, 0u, 0u}; *(LAS u32x4*)(lds + ML_VSC + tid * ML_VS + 144) = (u32x4){0u, 0u, 0u, 0u};
    }
    for (int cc = wave; cc < SEQ / 64; cc += NWAVES) {
        const size_t tok = (size_t)(cc * 64 + lane);
        const float ig = bf2f(U[tok * NU + UI + h]), fp = bf2f(U[tok * NU + UF + h]);
        const float lf = fminf(fp, 0.f) - log1pf(__expf(-fabsf(fp)));
        float bs = lf;
#pragma unroll
        for (int o = 1; o < 64; o <<= 1) { const float t_ = __shfl_up(bs, o); if (lane >= o) bs += t_; }
        const float Cj = ig - bs; float cm = Cj;
#pragma unroll
        for (int o = 1; o < 64; o <<= 1) { const float t_ = __shfl_up(cm, o); if (lane >= o) cm = fmaxf(cm, t_); }
        tBS[cc * 64 + lane] = bs; tCJ[cc * 64 + lane] = Cj; tCM[cc * 64 + lane] = cm;
    }
    __syncthreads();
    if (tid == 0) { float m = 0.f; for (int c = 0; c < SEQ / 64; ++c) { tMST[c] = m; m = tBS[c * 64 + 63] + fmaxf(tCM[c * 64 + 63], m); } }
    f32x4 cacc[2][5];
#pragma unroll
    for (int a = 0; a < 2; ++a)
#pragma unroll
        for (int v = 0; v < 5; ++v) cacc[a][v] = (f32x4){0.f, 0.f, 0.f, 0.f};
    u32x4 rq[4], rk[4], rv;
#define ML_PREFETCH(c) do { const bf16_t* base_ = U + (size_t)((c) * 64) * NU; \
        _Pragma("unroll") for (int i_ = 0; i_ < 4; ++i_) { rq[i_] = *(const u32x4*)(base_ + (size_t)(srow + 16 * i_) * NU + UQ + h * 256 + sch * 8); \
                                                          rk[i_] = *(const u32x4*)(base_ + (size_t)(srow + 16 * i_) * NU + UK + h * 256 + sch * 8); } \
        rv = *(const u32x4*)(base_ + (size_t)vrow * NU + UV + h * 512 + s * 64 + vch * 8); } while (0)
#define ML_SB __builtin_amdgcn_sched_barrier(0)
#define ML_LDK(dst, jt) do { _Pragma("unroll") for (int ks_ = 0; ks_ < 8; ++ks_) dst[ks_] = *(const LAS bf16x8*)(lds + ML_K + (16 * (jt) + li) * ML_RS + g * 16 + ks_ * 64); } while (0)
#define ML_LDC(dst, vt) do { _Pragma("unroll") for (int ks_ = 0; ks_ < 8; ++ks_) dst[ks_] = *(const LAS bf16x8*)(lds + ML_CT + (16 * (vt) + li) * ML_RS + g * 16 + ks_ * 64); } while (0)
#define ML_MMA8(acc, A, B) do { _Pragma("unroll") for (int ks_ = 0; ks_ < 8; ++ks_) acc = __builtin_amdgcn_mfma_f32_16x16x32_bf16(A[ks_], B[ks_], acc, 0, 0, 0); } while (0)
    ML_PREFETCH(0);
    __syncthreads();
    const int tcol = 16 * tt + li;
    for (int c = 0; c < SEQ / 64; ++c) {
        const float mst = tMST[c], M63 = fmaxf(tCM[c * 64 + 63], mst), decay = __expf(mst - M63);
        const float Mt_t = fmaxf(tCM[c * 64 + tcol], mst), inter_t = __expf(mst - Mt_t), emt_t = __expf(-(tBS[c * 64 + tcol] + Mt_t));
#pragma unroll
        for (int a = 0; a < 2; ++a)
#pragma unroll
            for (int v = 0; v < 5; ++v) { u32x2 w; w.x = cvt_pk_bf16(cacc[a][v][0], cacc[a][v][1]); w.y = cvt_pk_bf16(cacc[a][v][2], cacc[a][v][3]);
                *(LAS u32x2*)(lds + ML_CT + (16 * v + li) * ML_RS + (16 * (2 * wave + a) + 4 * g) * 2) = w; }
#pragma unroll
        for (int i = 0; i < 4; ++i) { *(LAS u32x4*)(lds + ML_Q + (srow + 16 * i) * ML_RS + sch * 16) = rq[i]; *(LAS u32x4*)(lds + ML_K + (srow + 16 * i) * ML_RS + sch * 16) = rk[i]; }
        *(LAS u32x4*)(lds + ML_V + vrow * ML_VS + vch * 16) = rv;
        { const float sc = __expf(tCJ[c * 64 + vrow] - M63); u32x4 o;
          o.x = cvt_pk_bf16(bf_lo(rv.x) * sc, bf_hi(rv.x) * sc); o.y = cvt_pk_bf16(bf_lo(rv.y) * sc, bf_hi(rv.y) * sc);
          o.z = cvt_pk_bf16(bf_lo(rv.z) * sc, bf_hi(rv.z) * sc); o.w = cvt_pk_bf16(bf_lo(rv.w) * sc, bf_hi(rv.w) * sc);
          *(LAS u32x4*)(lds + ML_VSC + vrow * ML_VS + vch * 16) = o; }
        if (tid < 64) *(LAS bf16_t*)(lds + ML_VSC + tid * ML_VS + 128) = (bf16_t)(cvt_pk_bf16(__expf(tCJ[c * 64 + tid] - M63), 0.f) & 0xffffu);
        __syncthreads();
        { const int cn = (c + 1 < SEQ / 64) ? c + 1 : c; ML_PREFETCH(cn); }
        bf16x8 Bq[8], A0[8], A1[8]; f32x4 sacc[4], pacc[3], cj4[4];
#pragma unroll
        for (int j = 0; j < 4; ++j) sacc[j] = (f32x4){0.f, 0.f, 0.f, 0.f};
#pragma unroll
        for (int a = 0; a < 3; ++a) pacc[a] = (f32x4){0.f, 0.f, 0.f, 0.f};
#pragma unroll
        for (int ks = 0; ks < 8; ++ks) Bq[ks] = *(const LAS bf16x8*)(lds + ML_Q + tcol * ML_RS + g * 16 + ks * 64);
        ML_LDK(A0, 0); ML_SB;
        ML_LDK(A1, 1); ML_MMA8(sacc[0], A0, Bq); ML_SB;
        ML_LDK(A0, 2); ML_MMA8(sacc[1], A1, Bq); ML_SB;
        ML_LDK(A1, 3); ML_MMA8(sacc[2], A0, Bq); ML_SB;
        ML_LDC(A0, 2 * vh);
#pragma unroll
        for (int jt = 0; jt < 4; ++jt) cj4[jt] = *(const LAS f32x4*)(tCJ + c * 64 + 16 * jt + 4 * g);
        ML_MMA8(sacc[3], A1, Bq); ML_SB;
        ML_LDC(A1, 2 * vh + 1); ML_MMA8(pacc[0], A0, Bq); ML_SB;
        ML_LDC(A0, 4); ML_MMA8(pacc[1], A1, Bq); ML_SB;
        bf16x8 Av[2][3];
#pragma unroll
        for (int ks2 = 0; ks2 < 2; ++ks2)
#pragma unroll
            for (int a = 0; a < 3; ++a) { const int vt = (a == 2) ? 4 : 2 * vh + a;
                const LAS unsigned char* ad = lds + ML_V + (32 * ks2 + 4 * g + q4) * ML_VS + (16 * vt + 4 * p4) * 2;
                Av[ks2][a] = tr_pair(ad, ad + 16 * ML_VS); }
        ML_MMA8(pacc[2], A0, Bq);
        bf16x8 sp[2];
#pragma unroll
        for (int ks2 = 0; ks2 < 2; ++ks2) {
            float sv[8];
#pragma unroll
            for (int e = 0; e < 8; ++e) { const int jt = 2 * ks2 + (e >> 2), j = 16 * jt + 4 * g + (e & 3);
                sv[e] = (j <= tcol) ? sacc[jt][e & 3] * __expf(cj4[jt][e & 3] - Mt_t) : 0.f; }
            const unsigned w0 = cvt_pk_bf16(sv[0], sv[1]), w1 = cvt_pk_bf16(sv[2], sv[3]), w2 = cvt_pk_bf16(sv[4], sv[5]), w3 = cvt_pk_bf16(sv[6], sv[7]);
            sp[ks2] = (bf16x8){(short)(w0 & 0xffff), (short)(w0 >> 16), (short)(w1 & 0xffff), (short)(w1 >> 16), (short)(w2 & 0xffff), (short)(w2 >> 16), (short)(w3 & 0xffff), (short)(w3 >> 16)};
        }
        ML_SB;
        bf16x8 Ck[2], Cv[5];
#pragma unroll
        for (int a = 0; a < 2; ++a) { const LAS unsigned char* ad = lds + ML_K + (8 * g + q4) * ML_RS + (16 * (2 * wave + a) + 4 * p4) * 2; Ck[a] = tr_pair(ad, ad + 4 * ML_RS); }
#pragma unroll
        for (int v = 0; v < 5; ++v) { const LAS unsigned char* ad = lds + ML_VSC + (8 * g + q4) * ML_VS + (16 * v + 4 * p4) * 2; Cv[v] = tr_pair(ad, ad + 4 * ML_VS); }
#pragma unroll
        for (int a = 0; a < 3; ++a) pacc[a] = pacc[a] * inter_t;
#pragma unroll
        for (int ks2 = 0; ks2 < 2; ++ks2)
#pragma unroll
            for (int a = 0; a < 3; ++a) pacc[a] = __builtin_amdgcn_mfma_f32_16x16x32_bf16(Av[ks2][a], sp[ks2], pacc[a], 0, 0, 0);
#pragma unroll
        for (int a = 0; a < 2; ++a)
#pragma unroll
            for (int v = 0; v < 5; ++v) cacc[a][v] = cacc[a][v] * decay;
        ML_SB;
        bf16x8 Dk[2], Dv[5];
#pragma unroll
        for (int a = 0; a < 2; ++a) { const LAS unsigned char* ad = lds + ML_K + (32 + 8 * g + q4) * ML_RS + (16 * (2 * wave + a) + 4 * p4) * 2; Dk[a] = tr_pair(ad, ad + 4 * ML_RS); }
#pragma unroll
        for (int v = 0; v < 5; ++v) { const LAS unsigned char* ad = lds + ML_VSC + (32 + 8 * g + q4) * ML_VS + (16 * v + 4 * p4) * 2; Dv[v] = tr_pair(ad, ad + 4 * ML_VS); }
#pragma unroll
        for (int v = 0; v < 5; ++v)
#pragma unroll
            for (int a = 0; a < 2; ++a) cacc[a][v] = __builtin_amdgcn_mfma_f32_16x16x32_bf16(Ck[a], Cv[v], cacc[a][v], 0, 0, 0);
        { const float den = __shfl(pacc[2][0], li);
          const float inv = 1.0f / fmaxf(fabsf(den), emt_t);
          bf16_t* hp = HR + (size_t)(c * 64 + tcol) * 4096 + 4 * g;
#pragma unroll
          for (int a = 0; a < 2; ++a) { u32x2 w; w.x = cvt_pk_bf16(pacc[a][0] * inv, pacc[a][1] * inv); w.y = cvt_pk_bf16(pacc[a][2] * inv, pacc[a][3] * inv);
              *(u32x2*)(hp + 16 * (2 * vh + a)) = w; } }
        ML_SB;
#pragma unroll
        for (int v = 0; v < 5; ++v)
#pragma unroll
            for (int a = 0; a < 2; ++a) cacc[a][v] = __builtin_amdgcn_mfma_f32_16x16x32_bf16(Dk[a], Dv[v], cacc[a][v], 0, 0, 0);
        __syncthreads();
    }
#undef ML_PREFETCH
#undef ML_SB
#undef ML_LDK
#undef ML_LDC
#undef ML_MMA8
}

__global__ void __launch_bounds__(NWAVES * 64, 2) mk_fwd(Params p) {
    extern __shared__ __attribute__((aligned(16))) unsigned char lds_raw[];
    LAS unsigned char* lds = (LAS unsigned char*)lds_raw;
    volatile LAS unsigned* MISC = (volatile LAS unsigned*)(lds + MISC_OFF);
    const int tid = threadIdx.x, lane = tid & 63, wave = __builtin_amdgcn_readfirstlane(tid >> 6);
    const int G = gridDim.x, bx = blockIdx.x;
    const int vcu = (G % 8 == 0) ? (bx % 8) * (G / 8) + bx / 8 : bx;
    const int gw = vcu * NWAVES + wave, NGW = G * NWAVES;
    unsigned char* ws = p.ws;
    unsigned* ctl = (unsigned*)(ws + WS_CTL);
    for (int u = tid; u < 1024 / 4; u += NWAVES * 64) ((LAS unsigned*)(lds + LDSCTL_OFF))[u] = 0u;
    __syncthreads();
    const bool one_launch = (p.ph_lo == 0 && p.ph_hi >= 8);
    XcdBarrier bar; bar.bar = ctl + CW_BAR; bar.x = 0; bar.st = nullptr;
    if (one_launch) bar = xcd_barrier_post(ctl + CW_BAR, MISC + 8);
    const int lo = p.ph_lo, hi = p.ph_hi;
#define IN(k) (lo <= (k) && (k) < hi)
#ifndef MK_DUP
#define MK_DUP -1
#endif
#define REP(k) for (int rep_ = 0; rep_ < ((MK_DUP) == (k) ? 2 : 1); ++rep_)
#define GRID_BAR() do { if (one_launch) xcd_barrier(bar); } while (0)

    if (IN(0)) { REP(0) p0_prologue(p, lds, gw, NGW, wave, lane); GRID_BAR(); }
    if (IN(1)) {
        SchedP1 S{G, bx, (const char*)(ws + WS_XB), (const char*)(ws + WS_MEMB), (const char*)(ws + WS_WINT), (const char*)(ws + WS_WKVT)};
        EpiP1 E{(bf16_t*)(ws + WS_U), (const float*)(ws + WS_BU), (bf16_t*)(ws + WS_KMEM), (bf16_t*)(ws + WS_VT), lds};
        REP(1) pg8::gemm_phase<EpiP1, SchedP1, true, true, true, true>(lds, 64 * 16384, 64 * 16384, S, E);
        GRID_BAR();
    }
    if (IN(2)) {
        { SchedQK S{G, bx, (const char*)(ws + WS_U), (const char*)(ws + WS_KMEM)}; EpiSC E{(float*)(ws + WS_SC)};
          REP(2) pg8::gemm_phase<EpiSC, SchedQK, true, true, false, false>(lds, NU * 2, 4096, S, E); }
        REP(8) conv_phase(p, vcu * (NWAVES * 64) + tid, G * NWAVES * 64);
        __syncthreads();
        #if defined(MK_NAIVE_MLSTM)
        for (int unit = bx; unit < 256; unit += G) mlstm_naive(p, lds, unit, wave, lane);
#else
        REP(9) for (int unit = vcu; unit < 256; unit += G) mlstm_unit(p, lds, unit, wave, lane, tid);
#endif
        GRID_BAR();
    }
    if (IN(3)) { REP(3) softmax_phase(p, gw, NGW, lane); REP(10) ym_phase(p, gw, NGW, lane); GRID_BAR(); }
    if (IN(4)) {
        SchedPV S{G, bx, (const char*)(ws + WS_PB), (const char*)(ws + WS_VT)}; EpiPV E{(const bf16_t*)(ws + WS_U), (bf16_t*)(ws + WS_YCX)};
        REP(4) pg8::gemm_phase<EpiPV, SchedPV, true, true, false, false>(lds, 2048, 2048, S, E);
        GRID_BAR();
    }
    if (IN(5)) {
        SchedMerge S{G, bx, (const char*)(ws + WS_YM), (const char*)(ws + WS_YCX), (const char*)(ws + WS_WPMT), (const char*)(ws + WS_WPCXT)};
        EpiMerge E{(const bf16_t*)(ws + WS_U), ws + WS_MERGED};
        REP(5) pg8::gemm_phase<EpiMerge, SchedMerge, true, true, true, true>(lds, 64 * 16384, 64 * 16384, S, E);
        GRID_BAR();
    }
    if (IN(6)) {
        SchedOut S{G, bx, (const char*)(ws + WS_MERGED), (const char*)(ws + WS_WOT)}; EpiOut E{p.x, p.out};
        REP(6) pg8::gemm_phase<EpiOut, SchedOut, true, true, true, true>(lds, 64 * 16384, 64 * 16384, S, E);
        GRID_BAR();
    }
    if (IN(7)) ln_phase(p, gw, NGW, lane);
#undef IN
#undef GRID_BAR
}

#ifndef MK_N_LAUNCHES
#define MK_N_LAUNCHES 1
#endif
extern "C" void kernel_launch(void* const* d_in, const int* in_sizes, int n_in, void* d_out, int out_size, void* d_ws, size_t ws_size, hipStream_t stream) {
    static int grid = 0;
    if (grid == 0) {
        if (n_in != 13 || out_size != T * D || ws_size < WS_END) { fprintf(stderr, "kernel_launch: unexpected shapes (n_in %d out %d ws %zu)\n", n_in, out_size, ws_size); grid = -1; return; }
        int dev = 0, cus = 0, per_cu = 0;
        if (hipGetDevice(&dev) != hipSuccess || hipDeviceGetAttribute(&cus, hipDeviceAttributeMultiprocessorCount, dev) != hipSuccess) { grid = -1; return; }
        if (hipFuncSetAttribute((const void*)mk_fwd, hipFuncAttributeMaxDynamicSharedMemorySize, LDS_BYTES) != hipSuccess) { fprintf(stderr, "kernel_launch: hipFuncSetAttribute failed\n"); grid = -1; return; }
        if (hipOccupancyMaxActiveBlocksPerMultiprocessor(&per_cu, (const void*)mk_fwd, NWAVES * 64, LDS_BYTES) != hipSuccess || per_cu < 1)
            fprintf(stderr, "kernel_launch: note: occupancy query reports %d\n", per_cu);
        (void)hipGetLastError();
        grid = cus;
    }
    if (grid < 0) return;
    (void)hipMemsetAsync((char*)d_ws + WS_CTL, 0, CTL_ZERO_BYTES, stream);
    Params p{};
    p.x = (const float*)d_in[0]; p.mem = (const float*)d_in[1]; p.w_in = (const float*)d_in[2]; p.b_in = (const float*)d_in[3];
    p.conv_w = (const float*)d_in[4]; p.mh_norm_w = (const float*)d_in[5]; p.w_mem_kv = (const float*)d_in[6]; p.w_proj_m = (const float*)d_in[7];
    p.w_proj_c = (const float*)d_in[8]; p.w_proj_x = (const float*)d_in[9]; p.w_out = (const float*)d_in[10]; p.ln_w = (const float*)d_in[11]; p.ln_b = (const float*)d_in[12];
    p.out = (float*)d_out; p.ws = (unsigned char*)d_ws;
    if (MK_N_LAUNCHES == 1) { p.ph_lo = 0; p.ph_hi = 8; hipLaunchKernelGGL(mk_fwd, dim3(grid), dim3(NWAVES * 64), LDS_BYTES, stream, p); }
    else for (int k = 0; k < 8; ++k) { p.ph_lo = k; p.ph_hi = k + 1; hipLaunchKernelGGL(mk_fwd, dim3(grid), dim3(NWAVES * 64), LDS_BYTES, stream, p); }
}
```

```cpp
#include <hip/hip_runtime.h>
#include <cstdio>
#include <cstdint>

#define LAS __attribute__((address_space(3)))
#define GAS __attribute__((address_space(1)))
typedef unsigned short bf16_t;
typedef short bf16x8 __attribute__((ext_vector_type(8)));
typedef float f32x4 __attribute__((ext_vector_type(4)));
typedef float f32x2 __attribute__((ext_vector_type(2)));
typedef unsigned u32x4 __attribute__((ext_vector_type(4)));
typedef unsigned u32x2 __attribute__((ext_vector_type(2)));

constexpr int NB = 4, SEQ = 2048, T = NB * SEQ, D = 4096;
constexpr int DIN = 40976, NU = 41216;
constexpr int MEMLEN = 256, TM = NB * MEMLEN;
constexpr int UQ = 0, UK = 2048, UV = 4096, UO = 8192, UZ = 12288, UCB = 16384, UCC = 18432, UCX = 20480, UCZ = 22528,
              UXQ = 24576, UXZ = 26624, UG = 28672, UI = 40960, UF = 40968;
constexpr float LN_EPS = 1e-5f;
constexpr float DN_ALPHA = 1.189207115002721f;

constexpr size_t MiB = 1u << 20;
constexpr size_t WS_CTL = 0, CTL_ZERO_BYTES = 1 * MiB;
constexpr size_t WS_BU = 1 * MiB;
constexpr size_t WS_XB = 2 * MiB;
constexpr size_t WS_MEMB = 66 * MiB;
constexpr size_t WS_WINT = 74 * MiB;
constexpr size_t WS_WKVT = 396 * MiB;
constexpr size_t WS_WPMT = 428 * MiB;
constexpr size_t WS_WPCXT = 460 * MiB;
constexpr size_t WS_WOT = 492 * MiB;
constexpr size_t WS_U = 524 * MiB;
constexpr size_t WS_KMEM = 1168 * MiB;
constexpr size_t WS_VT = 1172 * MiB;
constexpr size_t WS_SC = 1176 * MiB;
constexpr size_t WS_PB = 1208 * MiB;
constexpr size_t WS_HRAW = 1224 * MiB;
constexpr size_t WS_YM = 1288 * MiB;
constexpr size_t WS_YCX = 1352 * MiB;
constexpr size_t WS_MERGED = 1416 * MiB;
constexpr size_t WS_END = 1480 * MiB;
constexpr int CW_BAR = 4096;

constexpr int RING_BYTES = 131072;
constexpr int LDSCTL_OFF = RING_BYTES, MISC_OFF = LDSCTL_OFF + 320;
constexpr int EPI_OFF = RING_BYTES + 1024, EPI_WAVE_BYTES = 16 * 144;
constexpr int LDS_BYTES = 163840;
static_assert(EPI_OFF + 8 * EPI_WAVE_BYTES <= LDS_BYTES, "LDS map");
constexpr int NWAVES = 8;

typedef __bf16 bf16x2_t __attribute__((ext_vector_type(2)));
__device__ __forceinline__ unsigned cvt_pk_bf16_asm(float lo, float hi) { unsigned r; asm("v_cvt_pk_bf16_f32 %0, %1, %2" : "=v"(r) : "v"(lo), "v"(hi)); return r; }
__device__ __forceinline__ unsigned cvt_pk_bf16(float lo, float hi) { const bf16x2_t v = __builtin_convertvector((f32x2){lo, hi}, bf16x2_t); return __builtin_bit_cast(unsigned, v); }
__device__ __forceinline__ float bf_lo(unsigned w) { return __uint_as_float(w << 16); }
__device__ __forceinline__ float bf_hi(unsigned w) { return __uint_as_float(w & 0xffff0000u); }
__device__ __forceinline__ float bf2f(bf16_t h) { return __uint_as_float(((unsigned)h) << 16); }
__device__ __forceinline__ float sigmoidf_(float x) { return __builtin_amdgcn_rcpf(1.0f + __expf(-x)); }
__device__ __forceinline__ float wave_sum(float v) {
#pragma unroll
    for (int o = 1; o < 64; o <<= 1) v += __shfl_xor(v, o);
    return v;
}
__device__ __forceinline__ float wave_max(float v) {
#pragma unroll
    for (int o = 1; o < 64; o <<= 1) v = fmaxf(v, __shfl_xor(v, o));
    return v;
}
#define LDS_WAIT() asm volatile("s_waitcnt lgkmcnt(0)" ::: "memory")
#define VM_WAIT() asm volatile("s_waitcnt vmcnt(0)" ::: "memory")

namespace pg8 {
constexpr int BM = 256, BK = 64, HALF = 128, HTB = HALF * BK * 2, STAGE_BYTES = 8 * HTB;
__host__ __device__ __forceinline__ int lds_byte(int r, int c) { const int st = (r >> 4) * 2 + (c >> 5), rr = r & 15, cc = c & 31, ob = rr * 64 + cc * 2; return st * 1024 + (ob ^ (((ob >> 9) & 1) << 5)); }
__host__ __device__ __forceinline__ void stage_rc(int b, int& R, int& C) { const int st = b / 1024, sb = b % 1024, swz = sb ^ (((sb >> 9) & 1) << 5); R = (st >> 1) * 16 + swz / 64; C = (st & 1) * 32 + (swz % 64) / 2; }
__host__ __device__ __forceinline__ int perm32(int rho) { const int n = rho >> 4, i = rho & 15; return 8 * (i >> 2) + 4 * n + (i & 3); }

struct Unit { unsigned A; unsigned B; int nt, pm, pn, kind; };

__device__ __forceinline__ bool tile_map(long L, int nM, int nN, int& pm, int& pn) {
    const int nwg = nM * nN; if (L >= nwg) return false;
    int wgid = (int)L; { const int q = nwg / 8, r = nwg % 8, xcd = wgid % 8, off = wgid / 8; wgid = (xcd < r ? xcd * (q + 1) : r * (q + 1) + (xcd - r) * q) + off; }
    const int nig = 8 * nN, gid = wgid / nig, fm = gid * 8, gsz = (nM - fm) < 8 ? (nM - fm) : 8;
    pm = fm + ((wgid % nig) % gsz); pn = (wgid % nig) / gsz; return true;
}

template <class Epi, class Sched, bool ALIGN_EPI, bool SP2, bool APACK, bool BPACK>
__device__ __forceinline__ void gemm_phase(LAS unsigned char* lds, const unsigned char* wsbase, const int lda, const int ldb, const Sched& S, const Epi& E) {
    const int tid = threadIdx.x, wid = __builtin_amdgcn_readfirstlane(tid >> 6), lane = tid & 63, wr = wid >> 2, wc = wid & 3, fr = lane & 15, fq = lane >> 4;
    unsigned voffA[2], voffB[2];
#pragma unroll
    for (int i = 0; i < 2; ++i) { int R, C; stage_rc(tid * 16 + i * 8192, R, C); const int Rb = Epi::PERM ? ((R & ~31) + perm32(R & 31)) : R;
        voffA[i] = APACK ? (unsigned)(tid * 16 + i * 8192) : (unsigned)(R * lda + C * 2); voffB[i] = BPACK ? (unsigned)(tid * 16 + i * 8192) : (unsigned)(Rb * ldb + C * 2); }
    const unsigned kstepA = APACK ? 16384u : (unsigned)(BK * 2), kstepB = BPACK ? 16384u : (unsigned)(BK * 2);
    const unsigned hstepA = APACK ? (unsigned)lda : (unsigned)(HALF * lda), hstepB = BPACK ? (unsigned)ldb : (unsigned)(HALF * ldb);
    const __amdgpu_buffer_rsrc_t rsrc = __builtin_amdgcn_make_buffer_rsrc((void*)wsbase, 0, 0xFFFFFFFFu, 0x00020000);
    const unsigned ldsw = (unsigned)wid * 1024u;
    const int aoff = lds_byte(wr * 64 + fr, fq * 8), boff = lds_byte(wc * 32 + fr, fq * 8);
#define PG8_SA(b, h) (((b) * 2 + (h)) * HTB)
#define PG8_SB(b, h) ((4 + (b) * 2 + (h)) * HTB)
#define PG8_STAGE(bufoff, goff, voff) do { _Pragma("unroll") for (int _i = 0; _i < 2; ++_i) \
        __builtin_amdgcn_raw_ptr_buffer_load_lds(rsrc, (LAS void*)(lds + (bufoff) + ldsw + _i * 8192), 16, (int)(voff)[_i], (int)(goff), 0, 0); } while (0)
#define PG8_LDA(dst, b, h) do { _Pragma("unroll") for (int m = 0; m < 4; ++m) _Pragma("unroll") for (int k = 0; k < 2; ++k) dst[m][k] = *(const LAS bf16x8*)(lds + PG8_SA(b, h) + aoff + m * 2048 + k * 1024); } while (0)
#define PG8_LDB(dst, b, h) do { _Pragma("unroll") for (int n = 0; n < 2; ++n) _Pragma("unroll") for (int k = 0; k < 2; ++k) dst[n][k] = *(const LAS bf16x8*)(lds + PG8_SB(b, h) + boff + n * 2048 + k * 1024); } while (0)
#define PG8_MMA(ai, bj, At, Bt) do { __builtin_amdgcn_s_setprio(1); _Pragma("unroll") for (int m = 0; m < 4; ++m) _Pragma("unroll") for (int n = 0; n < 2; ++n) _Pragma("unroll") for (int k = 0; k < 2; ++k) \
        acc[ai][bj][m][n] = __builtin_amdgcn_mfma_f32_16x16x32_bf16(Bt[n][k], At[m][k], acc[ai][bj][m][n], 0, 0, 0); __builtin_amdgcn_s_setprio(0); } while (0)
#define PG8_WAIT_V(n) asm volatile("s_waitcnt vmcnt(" #n ")" ::: "memory")
#define PG8_WAIT_L(n) asm volatile("s_waitcnt lgkmcnt(" #n ")" ::: "memory")
#define PG8_BAR __builtin_amdgcn_s_barrier()
#define PG8_SCHED __builtin_amdgcn_sched_barrier(0)
    Unit cur, nxt; int ui = 0;
    if (!S.next(0, cur)) return;
    f32x4 acc[2][2][4][2];
#pragma unroll
    for (int a = 0; a < 2; ++a)
#pragma unroll
        for (int b = 0; b < 2; ++b)
#pragma unroll
            for (int m = 0; m < 4; ++m)
#pragma unroll
                for (int n = 0; n < 2; ++n) acc[a][b][m][n] = (f32x4){0.f, 0.f, 0.f, 0.f};
    bf16x8 At[4][2], B0[2][2], B1[2][2];
    unsigned cA = cur.A, cB = cur.B;
    if constexpr (SP2) {
        PG8_STAGE(PG8_SB(0, 0), cB, voffB); PG8_STAGE(PG8_SB(0, 1), cB + hstepB, voffB); PG8_STAGE(PG8_SA(0, 0), cA, voffA); PG8_STAGE(PG8_SA(0, 1), cA + hstepA, voffA);
        if (wr == 1) PG8_BAR;
        PG8_WAIT_V(2); PG8_BAR;
        PG8_STAGE(PG8_SB(1, 0), cB + kstepB, voffB); PG8_STAGE(PG8_SA(1, 0), cA + kstepA, voffA); PG8_STAGE(PG8_SB(1, 1), cB + hstepB + kstepB, voffB);
        PG8_WAIT_V(6); PG8_BAR;
    } else {
        PG8_STAGE(PG8_SB(0, 0), cB, voffB); PG8_STAGE(PG8_SA(0, 0), cA, voffA); PG8_STAGE(PG8_SB(0, 1), cB + hstepB, voffB); PG8_STAGE(PG8_SA(0, 1), cA + hstepA, voffA);
        if (wr == 1) PG8_BAR;
        PG8_WAIT_V(4); PG8_BAR;
        PG8_STAGE(PG8_SB(1, 0), cB + kstepB, voffB); PG8_STAGE(PG8_SA(1, 0), cA + kstepA, voffA); PG8_STAGE(PG8_SB(1, 1), cB + hstepB + kstepB, voffB);
        PG8_WAIT_V(6); PG8_BAR;
    }
    for (;;) {
        const bool has_next = S.next(ui + 1, nxt);
        const unsigned nA = has_next ? nxt.A : cA, nB = has_next ? nxt.B : cB;
        const int nt = cur.nt;
#pragma clang loop unroll(disable)
        for (int t = 0; t < nt; t += 2) {
            const bool last = (t == nt - 2);
            const unsigned a1 = cA + (unsigned)(t + 1) * kstepA;
            const unsigned a2 = last ? nA : cA + (unsigned)(t + 2) * kstepA, b2 = last ? nB : cB + (unsigned)(t + 2) * kstepB;
            const unsigned a3 = a2 + kstepA, b3 = b2 + kstepB;
            if constexpr (SP2) {
            PG8_LDB(B0, 0, 0); PG8_LDB(B1, 0, 1); PG8_SCHED; PG8_LDA(At, 0, 0); PG8_STAGE(PG8_SA(1, 1), a1 + hstepA, voffA);
            PG8_WAIT_V(8); PG8_WAIT_L(0); PG8_BAR; PG8_MMA(0, 0, At, B0); PG8_MMA(0, 1, At, B1); PG8_BAR; PG8_SCHED;
            PG8_LDA(At, 0, 1); PG8_STAGE(PG8_SB(0, 0), b2, voffB); PG8_STAGE(PG8_SB(0, 1), b2 + hstepB, voffB); PG8_STAGE(PG8_SA(0, 0), a2, voffA);
            PG8_WAIT_V(8); PG8_WAIT_L(0); PG8_BAR; PG8_MMA(1, 0, At, B0); PG8_MMA(1, 1, At, B1); PG8_BAR; PG8_SCHED;
            PG8_LDB(B0, 1, 0); PG8_LDB(B1, 1, 1); PG8_SCHED; PG8_LDA(At, 1, 0); PG8_STAGE(PG8_SA(0, 1), a2 + hstepA, voffA);
            PG8_WAIT_V(8); PG8_WAIT_L(0); PG8_BAR; PG8_MMA(0, 0, At, B0); PG8_MMA(0, 1, At, B1); PG8_BAR; PG8_SCHED;
            PG8_LDA(At, 1, 1); PG8_STAGE(PG8_SB(1, 0), b3, voffB); PG8_STAGE(PG8_SB(1, 1), b3 + hstepB, voffB); PG8_STAGE(PG8_SA(1, 0), a3, voffA);
            PG8_WAIT_V(8); PG8_WAIT_L(0); PG8_BAR; PG8_MMA(1, 0, At, B0); PG8_MMA(1, 1, At, B1); PG8_BAR; PG8_SCHED;
            } else {
            PG8_LDB(B0, 0, 0); PG8_SCHED; PG8_LDA(At, 0, 0); PG8_STAGE(PG8_SA(1, 1), a1 + hstepA, voffA);
            PG8_WAIT_L(8); PG8_BAR; PG8_WAIT_L(0); PG8_MMA(0, 0, At, B0); PG8_BAR; PG8_SCHED;
            PG8_LDB(B1, 0, 1); PG8_STAGE(PG8_SB(0, 0), b2, voffB);
            PG8_BAR; PG8_WAIT_L(0); PG8_MMA(0, 1, At, B1); PG8_BAR;
            PG8_LDA(At, 0, 1); PG8_STAGE(PG8_SA(0, 0), a2, voffA);
            PG8_BAR; PG8_WAIT_L(0); PG8_MMA(1, 0, At, B0); PG8_BAR; PG8_SCHED;
            PG8_STAGE(PG8_SB(0, 1), b2 + hstepB, voffB);
            PG8_WAIT_V(6); PG8_BAR; PG8_MMA(1, 1, At, B1); PG8_BAR;
            PG8_LDB(B0, 1, 0); PG8_SCHED; PG8_LDA(At, 1, 0); PG8_STAGE(PG8_SA(0, 1), a2 + hstepA, voffA);
            PG8_WAIT_L(8); PG8_BAR; PG8_WAIT_L(0); PG8_MMA(0, 0, At, B0); PG8_BAR; PG8_SCHED;
            PG8_LDB(B1, 1, 1); PG8_STAGE(PG8_SB(1, 0), b3, voffB);
            PG8_BAR; PG8_WAIT_L(0); PG8_MMA(0, 1, At, B1); PG8_BAR;
            PG8_LDA(At, 1, 1); PG8_STAGE(PG8_SA(1, 0), a3, voffA);
            PG8_BAR; PG8_WAIT_L(0); PG8_MMA(1, 0, At, B0); PG8_BAR; PG8_SCHED;
            PG8_STAGE(PG8_SB(1, 1), b3 + hstepB, voffB);
            PG8_WAIT_V(6); PG8_BAR; PG8_MMA(1, 1, At, B1); PG8_BAR;
            }
        }
        if constexpr (ALIGN_EPI) { if (wr == 0) PG8_BAR; }
        E(acc, cur, wr, wc, fr, fq);
        if (!has_next) break;
        if (!(Epi::KEEP && cur.kind != 2)) {
#pragma unroll
        for (int a = 0; a < 2; ++a)
#pragma unroll
            for (int b = 0; b < 2; ++b)
#pragma unroll
                for (int m = 0; m < 4; ++m)
#pragma unroll
                    for (int n = 0; n < 2; ++n) acc[a][b][m][n] = (f32x4){0.f, 0.f, 0.f, 0.f};
        }
        cur = nxt; cA = nA; cB = nB; ++ui;
        if constexpr (ALIGN_EPI) { if (wr == 1) PG8_BAR; }
    }
    PG8_WAIT_V(0);
    if constexpr (!ALIGN_EPI) { if (wr == 0) PG8_BAR; }
    PG8_BAR;
#undef PG8_SA
#undef PG8_SB
#undef PG8_STAGE
#undef PG8_LDA
#undef PG8_LDB
#undef PG8_MMA
#undef PG8_WAIT_V
#undef PG8_WAIT_L
#undef PG8_BAR
#undef PG8_SCHED
}
}
using pg8::Unit;
constexpr size_t PKB = 16384;
__device__ __forceinline__ size_t pk_off(int row, int col, int ktiles) { return ((size_t)(row >> 7) * ktiles + (col >> 6)) * PKB + pg8::lds_byte(row & 127, col & 63); }

#define XB_TMO      128
#define XB_XCNT(j)  (256  + 64 * (j))
#define XB_XSUB(j)  (1280 + 64 * (j))
#define XB_XGEN(j)  (2304 + 64 * (j))
#define XB_TOP      3328
#define XB_TOPGEN   3392
#define XCD_BAR_WORDS 3456
#define XB_SPIN_CAP (1u << 18)

__device__ __forceinline__ unsigned xb_ld(unsigned* p)              { return __hip_atomic_load(p, __ATOMIC_RELAXED, __HIP_MEMORY_SCOPE_AGENT); }
__device__ __forceinline__ unsigned xb_add(unsigned* p, unsigned v) { return __hip_atomic_fetch_add(p, v, __ATOMIC_RELAXED, __HIP_MEMORY_SCOPE_AGENT); }
__device__ __forceinline__ unsigned xb_xcc_id() { return (unsigned)__builtin_amdgcn_s_getreg((3 << 11) | 20) & 0xFu; }
#define XB_SPIN(cond, bar) do { unsigned _sp = 0; while (cond) { __builtin_amdgcn_s_sleep(1); \
    if ((++_sp & 255u) == 0u) { if (xb_ld(&(bar)[XB_TMO])) break; if (_sp > XB_SPIN_CAP) { atomicAdd(&(bar)[XB_TMO], 1u); break; } } } } while (0)

struct XcdBarrier { unsigned* bar; unsigned x; volatile LAS unsigned* st; };

__device__ __forceinline__ XcdBarrier xcd_barrier_post(unsigned* bar, volatile LAS unsigned* st) {
    XcdBarrier b; b.bar = bar; b.x = xb_xcc_id(); b.st = st;
    if (threadIdx.x == 0) (void)xb_add(&bar[XB_XCNT(b.x)], 1u);
    return b;
}
__device__ __forceinline__ void xcd_barrier_complete(unsigned* bar, unsigned x, unsigned& nloc, unsigned& nx) {
    const unsigned G = gridDim.x * gridDim.y * gridDim.z;
    unsigned sum, cnt, mine, sp = 0u;
    for (;;) {
        sum = 0u; cnt = 0u; mine = 0u;
#pragma unroll
        for (unsigned j = 0; j < 16; ++j) { const unsigned c = xb_ld(&bar[XB_XCNT(j)]); sum += c; cnt += (c > 0u) ? 1u : 0u; mine = (j == x) ? c : mine; }
        if (sum == G) break;
        __builtin_amdgcn_s_sleep(1);
        if ((++sp & 255u) == 0u) { if (xb_ld(&bar[XB_TMO])) break; if (sp > XB_SPIN_CAP) { atomicAdd(&bar[XB_TMO], 1u); break; } }
    }
    nloc = mine > 0u ? mine : 1u; nx = cnt > 0u ? cnt : 1u;
}
__device__ __forceinline__ void xcd_barrier(const XcdBarrier& b) {
    asm volatile("s_waitcnt vmcnt(0)" ::: "memory");
    __syncthreads();
    if (threadIdx.x == 0) {
        unsigned* bar = b.bar;
        __builtin_amdgcn_s_waitcnt(0);
        unsigned nloc = b.st[0], nx = b.st[1];
        if (nloc == 0u) { xcd_barrier_complete(bar, b.x, nloc, nx); b.st[0] = nloc; b.st[1] = nx; }
        const unsigned old = xb_add(&bar[XB_XSUB(b.x)], 1u);
        const unsigned gen = old / nloc;
        if (old + 1u == (gen + 1u) * nloc) {
            __builtin_amdgcn_fence(__ATOMIC_RELEASE, "agent");
            asm volatile("s_waitcnt vmcnt(0)" ::: "memory");
            const unsigned og = xb_add(&bar[XB_TOP], 1u);
            const unsigned tg = og / nx;
            if (og + 1u == (tg + 1u) * nx) xb_add(&bar[XB_TOPGEN], 1u);
            else XB_SPIN(xb_ld(&bar[XB_TOPGEN]) == tg, bar);
            __builtin_amdgcn_fence(__ATOMIC_ACQUIRE, "agent");
            xb_add(&bar[XB_XGEN(b.x)], 1u);
            asm volatile("s_waitcnt vmcnt(0)" ::: "memory");
        } else {
            XB_SPIN(xb_ld(&bar[XB_XGEN(b.x)]) == gen, bar);
            __builtin_amdgcn_fence(__ATOMIC_ACQUIRE, "agent");
            asm volatile("s_waitcnt vmcnt(0)" ::: "memory");
        }
    }
    __syncthreads();
}

struct Params {
    const float *x, *mem, *w_in, *b_in, *conv_w, *mh_norm_w, *w_mem_kv, *w_proj_m, *w_proj_c, *w_proj_x, *w_out, *ln_w, *ln_b;
    float* out; unsigned char* ws;
    int ph_lo, ph_hi;
};

__device__ __forceinline__ void transpose_item_pk(const float* src, size_t src_ld, int col0, int ncv, unsigned char* img, int ktiles, int n0, int k0, LAS unsigned* scr, int lane, int kdst_off = 0) {
    const float* sp = src + (size_t)k0 * src_ld + col0 + lane;
    if (ncv > 0) {
        float a[32], b[32];
#pragma unroll
        for (int i = 0; i < 32; ++i) { a[i] = 0.f; b[i] = 0.f; if (lane < ncv) { a[i] = __builtin_nontemporal_load(sp + (size_t)(2 * i) * src_ld); b[i] = __builtin_nontemporal_load(sp + (size_t)(2 * i + 1) * src_ld); } }
#pragma unroll
        for (int i = 0; i < 32; ++i) scr[i * 66 + lane] = cvt_pk_bf16_asm(a[i], b[i]);
    } else {
#pragma unroll 8
        for (int i = 0; i < 32; ++i) scr[i * 66 + lane] = 0u;
    }
    LDS_WAIT(); asm volatile("" ::: "memory");
    const int rr = lane >> 2, ch = lane & 3;
    unsigned char* blk = img + ((size_t)(2 * (n0 >> 8)) * ktiles + ((k0 + kdst_off) >> 6)) * PKB;
    const int wcs = (n0 >> 6) & 3;
#pragma unroll
    for (int sub = 0; sub < 8; ++sub) {
        const int grp = sub >> 2, np = (sub >> 1) & 1, k32 = sub & 1;
        const int nl = 32 * grp + 8 * (rr >> 2) + 4 * np + (rr & 3);
        const LAS unsigned* s = scr + (16 * k32 + 4 * ch) * 66 + nl;
        u32x4 o; o.x = s[0]; o.y = s[66]; o.z = s[132]; o.w = s[198];
        const int rho = 32 * wcs + 16 * np + rr;
        *(u32x4*)(blk + (size_t)grp * ktiles * PKB + pg8::lds_byte(rho, 32 * k32 + 8 * ch)) = o;
    }
    LDS_WAIT(); asm volatile("" ::: "memory");
}
__device__ __forceinline__ void cvt_item_pk(const float* src, unsigned char* img, int item, int lane) {
    const int rg = item >> 5, cg4 = item & 31, rr = lane >> 2, ch = lane & 3, row = rg * 16 + rr;
    f32x4 a[4], b[4];
#pragma unroll
    for (int q = 0; q < 4; ++q) { const int col = (cg4 * 4 + q) * 32 + 8 * ch;
        a[q] = __builtin_nontemporal_load((const f32x4*)(src + (size_t)row * 4096 + col)); b[q] = __builtin_nontemporal_load((const f32x4*)(src + (size_t)row * 4096 + col + 4)); }
#pragma unroll
    for (int q = 0; q < 4; ++q) { const int col = (cg4 * 4 + q) * 32 + 8 * ch;
        u32x4 o; o.x = cvt_pk_bf16_asm(a[q][0], a[q][1]); o.y = cvt_pk_bf16_asm(a[q][2], a[q][3]); o.z = cvt_pk_bf16_asm(b[q][0], b[q][1]); o.w = cvt_pk_bf16_asm(b[q][2], b[q][3]);
        *(u32x4*)(img + pk_off(row, col, 64)) = o; }
}
__device__ __forceinline__ void p0_prologue(const Params& p, LAS unsigned char* lds, int gw, int NGW, int wave, int lane) {
    LAS unsigned* scr = (LAS unsigned*)(lds + wave * 8448);
    unsigned char* ws = p.ws;
    constexpr int I_IN = 64 * 644, I_KV = 64 * 64, I_PM = 64 * 64, I_PC = 32 * 64, I_PX = 32 * 64, I_O = 64 * 64;
    constexpr int NITEMS = I_IN + I_KV + I_PM + I_PC + I_PX + I_O;
    for (int it = gw; it < NITEMS; it += NGW) {
        int r = it;
        if (r < I_IN) { const int kb = r / 644, nb = r % 644, n0 = nb * 64; int col0, ncv;
            if (n0 < 16384) { col0 = n0; ncv = 64; } else if (n0 < 40960) { col0 = n0 + 16; ncv = 64; } else if (n0 == 40960) { col0 = 16384; ncv = 16; } else { col0 = 0; ncv = 0; }
            transpose_item_pk(p.w_in, DIN, col0, ncv, ws + WS_WINT, 64, n0, kb * 64, scr, lane); continue; }
        r -= I_IN;
        if (r < I_KV) { transpose_item_pk(p.w_mem_kv, 4096, (r % 64) * 64, 64, ws + WS_WKVT, 64, (r % 64) * 64, (r / 64) * 64, scr, lane); continue; }
        r -= I_KV;
        if (r < I_PM) { transpose_item_pk(p.w_proj_m, 4096, (r % 64) * 64, 64, ws + WS_WPMT, 64, (r % 64) * 64, (r / 64) * 64, scr, lane); continue; }
        r -= I_PM;
        if (r < I_PC) { transpose_item_pk(p.w_proj_c, 4096, (r % 64) * 64, 64, ws + WS_WPCXT, 64, (r % 64) * 64, (r / 64) * 64, scr, lane); continue; }
        r -= I_PC;
        if (r < I_PX) { transpose_item_pk(p.w_proj_x, 4096, (r % 64) * 64, 64, ws + WS_WPCXT, 64, (r % 64) * 64, (r / 64) * 64, scr, lane, 2048); continue; }
        r -= I_PX;
        transpose_item_pk(p.w_out, 4096, (r % 64) * 64, 64, ws + WS_WOT, 64, (r % 64) * 64, (r / 64) * 64, scr, lane);
    }
    for (int it = gw; it < (T / 16) * 32; it += NGW) cvt_item_pk(p.x, ws + WS_XB, it, lane);
    for (int it = gw; it < (TM / 16) * 32; it += NGW) cvt_item_pk(p.mem, ws + WS_MEMB, it, lane);
    float* BU = (float*)(ws + WS_BU);
    for (int c = gw * 64 + lane; c < NU; c += NGW * 64) {
        float v = 0.f;
        if (c < 16384) v = p.b_in[c]; else if (c < 40960) v = p.b_in[c + 16]; else if (c < 40976) v = p.b_in[16384 + (c - 40960)];
        BU[c] = v;
    }
}

__device__ __forceinline__ int act_of(int c0) {
    if (c0 >= UXZ && c0 < UG) return 2;
    if (c0 >= UG && c0 < UI) return 1;
    return 0;
}
struct SchedP1 {
    int G, c; unsigned xb, memb, wint, wkvt;
    __device__ __forceinline__ bool next(int i, Unit& u) const {
        long L = (long)i * G + c;
        if (L < 5152) { pg8::tile_map(L, 32, 161, u.pm, u.pn); u.A = xb + (unsigned)u.pm * (unsigned)(128 * PKB); u.B = wint + (unsigned)u.pn * (unsigned)(128 * PKB); u.nt = 64; u.kind = 0; return true; }
        L -= 5152;
        if (L < 64) { u.pm = (int)L / 16; u.pn = (int)L % 16; u.A = memb + (unsigned)u.pm * (unsigned)(128 * PKB); u.B = wkvt + (unsigned)u.pn * (unsigned)(128 * PKB); u.nt = 64; u.kind = 1; return true; }
        return false;
    }
};
struct EpiP1 {
    static constexpr bool PERM = true, KEEP = false;
    bf16_t* U; const float* bU; bf16_t* KMEM; bf16_t* VT; LAS unsigned char* lds;
    __device__ __forceinline__ void operator()(f32x4 (&acc)[2][2][4][2], const Unit& u, int wr, int wc, int fr, int fq) const {
        asm volatile("" : "+v"(fr), "+v"(fq));
#if defined(MK_PROBE_EPI_OFF)
        if (u.kind != 77) return;
#endif
        const int row0 = wr * 64 + fr, col0 = wc * 64 + 8 * fq;
        if (u.kind == 1 && u.pn >= 8) {
            bf16_t* vb = VT + (size_t)((u.pn - 8) * 256 + col0) * 1024 + u.pm * 256 + row0;
#pragma unroll
            for (int ai = 0; ai < 2; ++ai)
#pragma unroll
                for (int m = 0; m < 4; ++m)
#pragma unroll
                    for (int bj = 0; bj < 2; ++bj)
#pragma unroll
                        for (int n = 0; n < 2; ++n)
#pragma unroll
                            for (int j = 0; j < 4; j += 2) { const unsigned w = cvt_pk_bf16(acc[ai][bj][m][n][j], acc[ai][bj][m][n][j + 1]);
                                bf16_t* q = vb + (size_t)(bj * 32 + 4 * n + j) * 1024 + ai * 128 + m * 16;
                                q[0] = (bf16_t)(w & 0xffffu); q[1024] = (bf16_t)(w >> 16); }
            return;
        }
        bf16_t* base; int ldc; const float* bias; int act = 0; float sc = 1.f;
        if (u.kind == 0) { const int c0 = u.pn * 256; base = U + (size_t)u.pm * 256 * NU + c0; ldc = NU; bias = bU + c0; act = act_of(c0); if (c0 < UK) sc = 0.0625f; }
        else { base = KMEM + (size_t)u.pm * 256 * 2048 + u.pn * 256; ldc = 2048; bias = nullptr; }
        f32x4 bv[2][2];
#pragma unroll
        for (int bj = 0; bj < 2; ++bj)
#pragma unroll
            for (int n = 0; n < 2; ++n) bv[bj][n] = bias ? *(const f32x4*)(bias + col0 + bj * 32 + 4 * n) : (f32x4){0.f, 0.f, 0.f, 0.f};
        const int wid = wr * 4 + wc, lane = fr + 16 * fq;
        LAS unsigned char* stg = lds + EPI_OFF + wid * EPI_WAVE_BYTES;
        LAS unsigned char* wp = stg + fr * 144 + fq * 16;
        const LAS unsigned char* rp = stg + (lane >> 3) * 144 + (lane & 7) * 16;
        bf16_t* gp = base + (size_t)(wr * 64 + (lane >> 3)) * ldc + wc * 64 + (lane & 7) * 8;
#pragma unroll
        for (int ai = 0; ai < 2; ++ai)
#pragma unroll
            for (int m = 0; m < 4; ++m) {
#pragma unroll
                for (int bj = 0; bj < 2; ++bj) { f32x4 v0 = acc[ai][bj][m][0] + bv[bj][0], v1 = acc[ai][bj][m][1] + bv[bj][1];
                    if (act) {
#pragma unroll
                        for (int j = 0; j < 4; ++j) { const float s0 = sigmoidf_(v0[j]), s1 = sigmoidf_(v1[j]); v0[j] = (act == 1) ? s0 : v0[j] * s0; v1[j] = (act == 1) ? s1 : v1[j] * s1; } }
                    v0 = v0 * sc; v1 = v1 * sc;
                    u32x4 w; w.x = cvt_pk_bf16(v0[0], v0[1]); w.y = cvt_pk_bf16(v0[2], v0[3]); w.z = cvt_pk_bf16(v1[0], v1[1]); w.w = cvt_pk_bf16(v1[2], v1[3]);
                    *(LAS u32x4*)(wp + bj * 64) = w; }
                asm volatile("" ::: "memory");
                const u32x4 o0 = *(const LAS u32x4*)rp, o1 = *(const LAS u32x4*)(rp + 8 * 144);
                asm volatile("" ::: "memory");
                bf16_t* g0 = gp + (size_t)(ai * 128 + m * 16) * ldc;
                __builtin_nontemporal_store(o0, (u32x4*)g0); __builtin_nontemporal_store(o1, (u32x4*)(g0 + (size_t)8 * ldc)); }
    }
};
struct SchedQK {
    int G, c; unsigned u, kmem;
    __device__ __forceinline__ bool next(int i, Unit& un) const {
        const int L = i * G + c; if (L >= 128) return false;
        const int head = L & 3, rt = L >> 2;
        un.pm = rt; un.pn = head; un.A = u + (unsigned)(((size_t)rt * 256 * NU + UXQ + head * 512) * 2); un.B = kmem + (unsigned)(((size_t)(rt >> 3) * 256 * 2048 + head * 512) * 2); un.nt = 8; un.kind = 0; return true;
    }
};
struct EpiSoftmax {
    static constexpr bool PERM = false, KEEP = false;
    bf16_t* PB; LAS unsigned char* lds;
    __device__ __forceinline__ void operator()(f32x4 (&acc)[2][2][4][2], const Unit& u, int wr, int wc, int fr, int fq) const {
        asm volatile("" : "+v"(fr), "+v"(fq));
        const float sc = 0.04419417382415922f * 1.4426950408889634f;
        LAS float* MX = (LAS float*)(lds + EPI_OFF);
        LAS float* SX = MX + 1024;
        float mrow[2][4];
#pragma unroll
        for (int ai = 0; ai < 2; ++ai)
#pragma unroll
            for (int m = 0; m < 4; ++m) { float mx = -3.0e38f;
#pragma unroll
                for (int bj = 0; bj < 2; ++bj)
#pragma unroll
                    for (int n = 0; n < 2; ++n) { acc[ai][bj][m][n] = acc[ai][bj][m][n] * sc; const f32x4 v = acc[ai][bj][m][n]; mx = fmaxf(mx, fmaxf(fmaxf(v[0], v[1]), fmaxf(v[2], v[3]))); }
                mx = fmaxf(mx, __shfl_xor(mx, 16)); mx = fmaxf(mx, __shfl_xor(mx, 32));
                if (fq == 0) MX[(ai * 128 + wr * 64 + m * 16 + fr) * 4 + wc] = mx; }
        asm volatile("s_waitcnt lgkmcnt(0)" ::: "memory"); __builtin_amdgcn_s_barrier(); asm volatile("" ::: "memory");
#pragma unroll
        for (int ai = 0; ai < 2; ++ai)
#pragma unroll
            for (int m = 0; m < 4; ++m) { const f32x4 q = *(const LAS f32x4*)(MX + (ai * 128 + wr * 64 + m * 16 + fr) * 4);
                const float mx = fmaxf(fmaxf(q[0], q[1]), fmaxf(q[2], q[3])); mrow[ai][m] = mx; float s = 0.f;
#pragma unroll
                for (int bj = 0; bj < 2; ++bj)
#pragma unroll
                    for (int n = 0; n < 2; ++n) { f32x4 v = acc[ai][bj][m][n];
#pragma unroll
                        for (int j = 0; j < 4; ++j) { v[j] = __builtin_amdgcn_exp2f(v[j] - mx); s += v[j]; }
                        acc[ai][bj][m][n] = v; }
                s += __shfl_xor(s, 16); s += __shfl_xor(s, 32);
                if (fq == 0) SX[(ai * 128 + wr * 64 + m * 16 + fr) * 4 + wc] = s; }
        asm volatile("s_waitcnt lgkmcnt(0)" ::: "memory"); __builtin_amdgcn_s_barrier(); asm volatile("" ::: "memory");
        bf16_t* base = PB + (size_t)u.pm * 256 * 1024 + u.pn * 256;
        const int row0 = wr * 64 + fr, col0 = wc * 32 + 4 * fq;
#pragma unroll
        for (int ai = 0; ai < 2; ++ai)
#pragma unroll
            for (int m = 0; m < 4; ++m) { const f32x4 q = *(const LAS f32x4*)(SX + (ai * 128 + wr * 64 + m * 16 + fr) * 4);
                const float inv = 1.0f / ((q[0] + q[1]) + (q[2] + q[3]));
                bf16_t* rowp = base + (size_t)(row0 + ai * 128 + m * 16) * 1024 + col0;
#pragma unroll
                for (int bj = 0; bj < 2; ++bj)
#pragma unroll
                    for (int n = 0; n < 2; ++n) { const f32x4 v = acc[ai][bj][m][n] * inv; u32x2 w; w.x = cvt_pk_bf16(v[0], v[1]); w.y = cvt_pk_bf16(v[2], v[3]);
                        *(u32x2*)(rowp + bj * 128 + n * 16) = w; } }
        (void)mrow;
    }
};
struct SchedPV {
    int G, c; unsigned pb, vt;
    __device__ __forceinline__ bool next(int i, Unit& un) const {
        if (i >= 2 || c >= 128) return false;
        const int L = c * 2 + i;
        const int n2 = L & 1, head = (L >> 1) & 3, rt = L >> 3;
        un.pm = rt; un.pn = head * 2 + n2; un.A = pb + (unsigned)(((size_t)rt * 256 * 1024 + head * 256) * 2); un.B = vt + (unsigned)(((size_t)(head * 512 + n2 * 256) * 1024 + (rt >> 3) * 256) * 2); un.nt = 4; un.kind = 0; return true;
    }
};
struct EpiPV {
    static constexpr bool PERM = true, KEEP = false;
    const bf16_t* U; bf16_t* YCX;
    __device__ __forceinline__ void operator()(f32x4 (&acc)[2][2][4][2], const Unit& u, int wr, int wc, int fr, int fq) const {
        asm volatile("" : "+v"(fr), "+v"(fq));
        const bf16_t* zb = U + (size_t)u.pm * 256 * NU + UXZ + u.pn * 256;
        const int row0 = wr * 64 + fr, col0 = wc * 32 + 8 * fq;
        const unsigned lane_off = (unsigned)((fr * 64 + fq * 16) ^ (((fr >> 3) & 1) << 5));
        unsigned char* ob = (unsigned char*)YCX + (size_t)(32 + 4 * u.pn + (wc >> 1)) * PKB + (wc & 1) * 1024 + lane_off;
#pragma unroll
        for (int ai = 0; ai < 2; ++ai)
#pragma unroll
            for (int m = 0; m < 4; ++m) { const size_t r = (size_t)(row0 + ai * 128 + m * 16);
#pragma unroll
                for (int bj = 0; bj < 2; ++bj) { const u32x4 z = *(const u32x4*)(zb + r * NU + col0 + bj * 128);
                    const f32x4 v0 = acc[ai][bj][m][0], v1 = acc[ai][bj][m][1];
                    u32x4 w; w.x = cvt_pk_bf16(v0[0] * bf_lo(z.x), v0[1] * bf_hi(z.x)); w.y = cvt_pk_bf16(v0[2] * bf_lo(z.y), v0[3] * bf_hi(z.y));
                    w.z = cvt_pk_bf16(v1[0] * bf_lo(z.z), v1[1] * bf_hi(z.z)); w.w = cvt_pk_bf16(v1[2] * bf_lo(z.w), v1[3] * bf_hi(z.w));
                    *(u32x4*)(ob + ((size_t)(2 * u.pm + ai) * 64 + 2 * bj) * PKB + (size_t)((4 * wr + m) * 2) * 1024) = w; }
                asm volatile("" ::: "memory"); }
    }
};
struct SchedMerge {
    int G, c; unsigned ym, ycx, wpmt, wpcxt;
    __device__ __forceinline__ bool next(int i, Unit& u) const {
        const int r = i / 3, br = i - 3 * r;
        if (!pg8::tile_map((long)r * G + c, 32, 16, u.pm, u.pn)) return false;
        u.kind = br;
        if (br == 0) { u.A = ym + (unsigned)u.pm * (unsigned)(128 * PKB); u.B = wpmt + (unsigned)u.pn * (unsigned)(128 * PKB); u.nt = 64; }
        else { u.A = ycx + (unsigned)u.pm * (unsigned)(128 * PKB) + (br == 2 ? (unsigned)(32 * PKB) : 0u); u.B = wpcxt + (unsigned)u.pn * (unsigned)(128 * PKB) + (br == 2 ? (unsigned)(32 * PKB) : 0u); u.nt = 32; }
        return true;
    }
};
struct EpiMerge {
    static constexpr bool PERM = true, KEEP = true;
    const bf16_t* U; unsigned char* MERGED;
    __device__ __forceinline__ void operator()(f32x4 (&acc)[2][2][4][2], const Unit& u, int wr, int wc, int fr, int fq) const {
        asm volatile("" : "+v"(fr), "+v"(fq));
        const int br = u.kind;
        const bf16_t* gb = U + (size_t)u.pm * 256 * NU + UG + br * 4096 + u.pn * 256;
        const int row0 = wr * 64 + fr, col0 = wc * 64 + 8 * fq;
        unsigned char* mb = MERGED + (size_t)(4 * u.pn + wc) * PKB + (unsigned)((fr * 64 + fq * 16) ^ (((fr >> 3) & 1) << 5));
        const float tiny = 1e-30f;
#pragma unroll
        for (int ai = 0; ai < 2; ++ai)
#pragma unroll
            for (int m = 0; m < 4; ++m) { const size_t r = (size_t)(row0 + ai * 128 + m * 16);
#pragma unroll
                for (int bj = 0; bj < 2; ++bj) { const int cc = col0 + bj * 32;
                    const u32x4 g = *(const u32x4*)(gb + r * NU + cc);
                    float f[8] = {bf_lo(g.x), bf_hi(g.x), bf_lo(g.y), bf_hi(g.y), bf_lo(g.z), bf_hi(g.z), bf_lo(g.w), bf_hi(g.w)};
                    if (br != 0) {
#pragma unroll
                        for (int j = 0; j < 8; ++j) f[j] = fmaxf(f[j], tiny); }
                    if (br != 2) { const u32x4 g2 = *(const u32x4*)(gb + r * NU + cc + 4096);
                        const float d[8] = {bf_lo(g2.x), bf_hi(g2.x), bf_lo(g2.y), bf_hi(g2.y), bf_lo(g2.z), bf_hi(g2.z), bf_lo(g2.w), bf_hi(g2.w)};
#pragma unroll
                        for (int j = 0; j < 8; ++j) f[j] = f[j] * __builtin_amdgcn_rcpf(fmaxf(d[j], tiny)); }
                    f32x4 v0 = acc[ai][bj][m][0], v1 = acc[ai][bj][m][1];
                    v0[0] *= f[0]; v0[1] *= f[1]; v0[2] *= f[2]; v0[3] *= f[3]; v1[0] *= f[4]; v1[1] *= f[5]; v1[2] *= f[6]; v1[3] *= f[7];
                    if (br != 2) { acc[ai][bj][m][0] = v0; acc[ai][bj][m][1] = v1; }
                    else { u32x4 w; w.x = cvt_pk_bf16(v0[0], v0[1]); w.y = cvt_pk_bf16(v0[2], v0[3]); w.z = cvt_pk_bf16(v1[0], v1[1]); w.w = cvt_pk_bf16(v1[2], v1[3]);
                        *(u32x4*)(mb + ((size_t)(2 * u.pm + ai) * 64) * PKB + (size_t)((4 * wr + m) * 2 + bj) * 1024) = w; } }
                asm volatile("" ::: "memory"); }
    }
};
struct SchedOut {
    int G, c; unsigned merged, wot;
    __device__ __forceinline__ bool next(int i, Unit& u) const {
        if (!pg8::tile_map((long)i * G + c, 32, 16, u.pm, u.pn)) return false;
        u.A = merged + (unsigned)u.pm * (unsigned)(128 * PKB); u.B = wot + (unsigned)u.pn * (unsigned)(128 * PKB); u.nt = 64; u.kind = 0; return true;
    }
};
struct EpiOut {
    static constexpr bool PERM = true, KEEP = false;
    const float* x; float* out;
    __device__ __forceinline__ void operator()(f32x4 (&acc)[2][2][4][2], const Unit& u, int wr, int wc, int fr, int fq) const {
        asm volatile("" : "+v"(fr), "+v"(fq));
        const size_t ob = (size_t)u.pm * 256 * 4096 + u.pn * 256;
        const int row0 = wr * 64 + fr, col0 = wc * 64 + 8 * fq;
#pragma unroll
        for (int ai = 0; ai < 2; ++ai)
#pragma unroll
            for (int m = 0; m < 4; ++m) { const size_t r = (size_t)(row0 + ai * 128 + m * 16);
#pragma unroll
                for (int bj = 0; bj < 2; ++bj)
#pragma unroll
                    for (int n = 0; n < 2; ++n) { const size_t o = ob + r * 4096 + col0 + bj * 32 + n * 4;
                        const f32x4 xv = *(const f32x4*)(x + o);
                        *(f32x4*)(out + o) = xv * DN_ALPHA + acc[ai][bj][m][n]; }
                asm volatile("" ::: "memory"); }
    }
};

__device__ __forceinline__ void conv_phase(const Params& p, int gtid, int NGT, int idx_lo, int idx_hi) {
    const bf16_t* U = (const bf16_t*)(p.ws + WS_U); bf16_t* YCX = (bf16_t*)(p.ws + WS_YCX);
    for (int idx = idx_lo + gtid; idx < idx_hi; idx += NGT) {
        const int t0 = (idx >> 8) * 16, c = (idx & 255) * 8;
        const bf16_t* row0 = U + (size_t)t0 * NU;
        const f32x4 wa0 = *(const f32x4*)(p.conv_w + c), wa1 = *(const f32x4*)(p.conv_w + c + 4);
        const f32x4 wb0 = *(const f32x4*)(p.conv_w + 2048 + c), wb1 = *(const f32x4*)(p.conv_w + 2048 + c + 4);
        const f32x4 wc0 = *(const f32x4*)(p.conv_w + 4096 + c), wc1 = *(const f32x4*)(p.conv_w + 4096 + c + 4);
        const float w0[8] = {wa0[0], wa0[1], wa0[2], wa0[3], wa1[0], wa1[1], wa1[2], wa1[3]};
        const float w1[8] = {wb0[0], wb0[1], wb0[2], wb0[3], wb1[0], wb1[1], wb1[2], wb1[3]};
        const float w2[8] = {wc0[0], wc0[1], wc0[2], wc0[3], wc1[0], wc1[1], wc1[2], wc1[3]};
        float pm2[8], pm1[8];
        if ((t0 & (SEQ - 1)) != 0) {
            const u32x4 a2 = *(const u32x4*)(row0 - (size_t)2 * NU + UCC + c), b2 = *(const u32x4*)(row0 - (size_t)2 * NU + UCX + c);
            const u32x4 a1 = *(const u32x4*)(row0 - (size_t)1 * NU + UCC + c), b1 = *(const u32x4*)(row0 - (size_t)1 * NU + UCX + c);
            const unsigned a2w[4] = {a2.x, a2.y, a2.z, a2.w}, b2w[4] = {b2.x, b2.y, b2.z, b2.w}, a1w[4] = {a1.x, a1.y, a1.z, a1.w}, b1w[4] = {b1.x, b1.y, b1.z, b1.w};
#pragma unroll
            for (int j = 0; j < 4; ++j) { pm2[2 * j] = bf_lo(a2w[j]) * bf_lo(b2w[j]); pm2[2 * j + 1] = bf_hi(a2w[j]) * bf_hi(b2w[j]); pm1[2 * j] = bf_lo(a1w[j]) * bf_lo(b1w[j]); pm1[2 * j + 1] = bf_hi(a1w[j]) * bf_hi(b1w[j]); }
        } else {
#pragma unroll
            for (int j = 0; j < 8; ++j) { pm2[j] = 0.f; pm1[j] = 0.f; }
        }
#pragma unroll 1
        for (int tq = 0; tq < 16; tq += 4) {
            u32x4 cb[4], cc[4], cx[4], cz[4];
#pragma unroll
            for (int q = 0; q < 4; ++q) { const bf16_t* row = row0 + (size_t)(tq + q) * NU;
                cb[q] = *(const u32x4*)(row + UCB + c); cc[q] = *(const u32x4*)(row + UCC + c); cx[q] = *(const u32x4*)(row + UCX + c); cz[q] = *(const u32x4*)(row + UCZ + c); }
#pragma unroll
            for (int q = 0; q < 4; ++q) {
                const unsigned cbw[4] = {cb[q].x, cb[q].y, cb[q].z, cb[q].w}, ccw[4] = {cc[q].x, cc[q].y, cc[q].z, cc[q].w}, cxw[4] = {cx[q].x, cx[q].y, cx[q].z, cx[q].w}, czw[4] = {cz[q].x, cz[q].y, cz[q].z, cz[q].w};
                float pc[8], o[8];
#pragma unroll
                for (int j = 0; j < 4; ++j) { pc[2 * j] = bf_lo(ccw[j]) * bf_lo(cxw[j]); pc[2 * j + 1] = bf_hi(ccw[j]) * bf_hi(cxw[j]); }
#pragma unroll
                for (int j = 0; j < 8; ++j) { o[j] = (w0[j] * pm2[j] + w1[j] * pm1[j]) + w2[j] * pc[j]; pm2[j] = pm1[j]; pm1[j] = pc[j]; }
                u32x4 ov; unsigned ow[4];
#pragma unroll
                for (int j = 0; j < 4; ++j) { const float z0 = bf_lo(czw[j]), z1 = bf_hi(czw[j]);
                    ow[j] = cvt_pk_bf16(bf_lo(cbw[j]) * o[2 * j] * (z0 * sigmoidf_(z0)), bf_hi(cbw[j]) * o[2 * j + 1] * (z1 * sigmoidf_(z1))); }
                ov.x = ow[0]; ov.y = ow[1]; ov.z = ow[2]; ov.w = ow[3];
                *(u32x4*)((unsigned char*)YCX + pk_off(t0 + tq + q, c, 64)) = ov;
            }
        }
    }
}
__device__ __forceinline__ void softmax_unit(const Params& p, int rt, int head, int wave, int lane) {
    const float* SC = (const float*)(p.ws + WS_SC); bf16_t* PB = (bf16_t*)(p.ws + WS_PB);
    for (int r = wave; r < 256; r += NWAVES) {
        const int it = (rt * 256 + r) * 4 + head;
        const f32x4 s = *(const f32x4*)(SC + (size_t)it * 256 + 4 * lane);
        const float mx = wave_max(fmaxf(fmaxf(s[0], s[1]), fmaxf(s[2], s[3])));
        const float e0 = __expf(s[0] - mx), e1 = __expf(s[1] - mx), e2 = __expf(s[2] - mx), e3 = __expf(s[3] - mx);
        const float inv = 1.0f / wave_sum((e0 + e1) + (e2 + e3));
        u32x2 o; o.x = cvt_pk_bf16(e0 * inv, e1 * inv); o.y = cvt_pk_bf16(e2 * inv, e3 * inv);
        *(u32x2*)(PB + (size_t)it * 256 + 4 * lane) = o;
    }
}
__device__ __forceinline__ void ym_phase(const Params& p, int gw, int NGW, int lane) {
    const bf16_t* U = (const bf16_t*)(p.ws + WS_U); const bf16_t* HR = (const bf16_t*)(p.ws + WS_HRAW); bf16_t* YM = (bf16_t*)(p.ws + WS_YM);
    for (int it0 = gw * 2; it0 < T * 8; it0 += NGW * 2) {
        u32x4 hv[2], mo[2], mz[2];
#pragma unroll
        for (int q = 0; q < 2; ++q) { const int it = it0 + q, t = it >> 3, c = (it & 7) * 512 + 8 * lane;
            hv[q] = *(const u32x4*)(HR + (size_t)t * 4096 + c); mo[q] = *(const u32x4*)(U + (size_t)t * NU + UO + c); mz[q] = *(const u32x4*)(U + (size_t)t * NU + UZ + c); }
#pragma unroll
        for (int q = 0; q < 2; ++q) { const int it = it0 + q, t = it >> 3, c = (it & 7) * 512 + 8 * lane;
            const f32x4 w0 = *(const f32x4*)(p.mh_norm_w + c), w1 = *(const f32x4*)(p.mh_norm_w + c + 4);
            float v[8] = {bf_lo(hv[q].x), bf_hi(hv[q].x), bf_lo(hv[q].y), bf_hi(hv[q].y), bf_lo(hv[q].z), bf_hi(hv[q].z), bf_lo(hv[q].w), bf_hi(hv[q].w)};
            float s = 0.f;
#pragma unroll
            for (int j = 0; j < 8; ++j) s += v[j];
            const float mean = wave_sum(s) * (1.0f / 512.0f);
            float qq = 0.f;
#pragma unroll
            for (int j = 0; j < 8; ++j) { v[j] -= mean; qq += v[j] * v[j]; }
            const float rstd = 1.0f / sqrtf(wave_sum(qq) * (1.0f / 512.0f) + LN_EPS);
            const float ov[8] = {bf_lo(mo[q].x), bf_hi(mo[q].x), bf_lo(mo[q].y), bf_hi(mo[q].y), bf_lo(mo[q].z), bf_hi(mo[q].z), bf_lo(mo[q].w), bf_hi(mo[q].w)};
            const float zv[8] = {bf_lo(mz[q].x), bf_hi(mz[q].x), bf_lo(mz[q].y), bf_hi(mz[q].y), bf_lo(mz[q].z), bf_hi(mz[q].z), bf_lo(mz[q].w), bf_hi(mz[q].w)};
            const float wv[8] = {w0[0], w0[1], w0[2], w0[3], w1[0], w1[1], w1[2], w1[3]};
            u32x4 o; unsigned ow[4];
#pragma unroll
            for (int j = 0; j < 4; ++j) { const float g0 = sigmoidf_(ov[2 * j]) * (zv[2 * j] * sigmoidf_(zv[2 * j])), g1 = sigmoidf_(ov[2 * j + 1]) * (zv[2 * j + 1] * sigmoidf_(zv[2 * j + 1]));
                ow[j] = cvt_pk_bf16(v[2 * j] * rstd * wv[2 * j] * g0, v[2 * j + 1] * rstd * wv[2 * j + 1] * g1); }
            o.x = ow[0]; o.y = ow[1]; o.z = ow[2]; o.w = ow[3];
            *(u32x4*)((unsigned char*)YM + pk_off(t, c, 64)) = o; }
    }
}
__device__ __forceinline__ void ln_phase(const Params& p, int gw, int NGW, int lane) {
    for (int m = gw; m < T; m += NGW) {
        f32x4* r = (f32x4*)(p.out + (size_t)m * D) + lane;
        f32x4 v[16]; float s = 0.f;
#pragma unroll
        for (int j = 0; j < 16; ++j) { v[j] = r[64 * j]; s += (v[j][0] + v[j][1]) + (v[j][2] + v[j][3]); }
        const float mean = wave_sum(s) * (1.0f / D); float q = 0.f;
#pragma unroll
        for (int j = 0; j < 16; ++j) { v[j] = v[j] - mean; q += (v[j][0] * v[j][0] + v[j][1] * v[j][1]) + (v[j][2] * v[j][2] + v[j][3] * v[j][3]); }
        const float rstd = 1.0f / sqrtf(wave_sum(q) * (1.0f / D) + LN_EPS);
#pragma unroll
        for (int j = 0; j < 16; ++j) { const f32x4 w = *((const f32x4*)p.ln_w + lane + 64 * j), b = *((const f32x4*)p.ln_b + lane + 64 * j); r[64 * j] = v[j] * rstd * w + b; }
    }
}

__device__ __forceinline__ void mlstm_naive(const Params& p, LAS unsigned char* lds, int unit, int wave, int lane) {
    const int s = unit & 7, h = (unit >> 3) & 7, b = unit >> 6;
    LAS float* part = (LAS float*)lds;
    LAS float* pden = part + 2 * 8 * 64;
    const bf16_t* Ub = (const bf16_t*)(p.ws + WS_U) + (size_t)(b * SEQ) * NU;
    bf16_t* HR = (bf16_t*)(p.ws + WS_HRAW) + (size_t)(b * SEQ) * 4096 + h * 512 + s * 64 + lane;
    float C[32], n[32];
#pragma unroll
    for (int d = 0; d < 32; ++d) { C[d] = 0.f; n[d] = 0.f; }
    float m = 0.f;
    for (int t = 0; t < SEQ; ++t) {
        const bf16_t* row = Ub + (size_t)t * NU;
        u32x4 kk[4], qq[4];
#pragma unroll
        for (int j = 0; j < 4; ++j) { kk[j] = *(const u32x4*)(row + UK + h * 256 + wave * 32 + 8 * j); qq[j] = *(const u32x4*)(row + UQ + h * 256 + wave * 32 + 8 * j); }
        const float vv = bf2f(row[UV + h * 512 + s * 64 + lane]);
        const float ig = bf2f(row[UI + h]), fp = bf2f(row[UF + h]);
        const float lf = fminf(fp, 0.f) - log1pf(__expf(-fabsf(fp)));
        const float mn = fmaxf(lf + m, ig), fd = __expf(lf + m - mn), iw = __expf(ig - mn);
        m = mn;
        float num = 0.f, den = 0.f;
#pragma unroll
        for (int j = 0; j < 4; ++j) {
            const unsigned kw[4] = {kk[j].x, kk[j].y, kk[j].z, kk[j].w}, qw[4] = {qq[j].x, qq[j].y, qq[j].z, qq[j].w};
#pragma unroll
            for (int e = 0; e < 4; ++e) {
                const int d = 8 * j + 2 * e;
                const float k0 = iw * bf_lo(kw[e]), k1 = iw * bf_hi(kw[e]), q0 = bf_lo(qw[e]), q1 = bf_hi(qw[e]);
                C[d] = fd * C[d] + k0 * vv; n[d] = fd * n[d] + k0; num += q0 * C[d]; den += q0 * n[d];
                C[d + 1] = fd * C[d + 1] + k1 * vv; n[d + 1] = fd * n[d + 1] + k1; num += q1 * C[d + 1]; den += q1 * n[d + 1];
            }
        }
        const int buf = t & 1;
        part[(buf * 8 + wave) * 64 + lane] = num; if (lane == 0) pden[buf * 8 + wave] = den;
        __syncthreads();
        if (wave == (t & 7)) {
            float nt_ = 0.f, dt_ = 0.f;
#pragma unroll
            for (int w = 0; w < 8; ++w) { nt_ += part[(buf * 8 + w) * 64 + lane]; dt_ += pden[buf * 8 + w]; }
            const float hv = nt_ / fmaxf(fabsf(dt_), __expf(-m));
            HR[(size_t)t * 4096] = (bf16_t)(cvt_pk_bf16(hv, 0.f) & 0xffffu);
        }
    }
    __syncthreads();
}

constexpr int ML_RS = 528, ML_VS = 160;
constexpr int ML_Q = 0, ML_K = 64 * ML_RS, ML_V = 2 * 64 * ML_RS, ML_VSC = ML_V + 64 * ML_VS, ML_CT = ML_VSC + 64 * ML_VS, ML_END = ML_CT + 80 * ML_RS;
static_assert(ML_END <= RING_BYTES, "mLSTM LDS map");
typedef short s16x4 __attribute__((ext_vector_type(4)));
__device__ __forceinline__ bf16x8 tr_pair(const LAS unsigned char* a0, const LAS unsigned char* a1) {
    const s16x4 lo = __builtin_amdgcn_ds_read_tr16_b64_v4i16((LAS s16x4*)a0), hi = __builtin_amdgcn_ds_read_tr16_b64_v4i16((LAS s16x4*)a1);
    return (bf16x8){lo[0], lo[1], lo[2], lo[3], hi[0], hi[1], hi[2], hi[3]};
}
constexpr int ML_TAB_BS = EPI_OFF, ML_TAB_CJ = EPI_OFF + 8192, ML_TAB_CM = EPI_OFF + 16384, ML_TAB_MST = EPI_OFF + 24576;
static_assert(ML_TAB_MST + 256 <= LDS_BYTES, "mLSTM gate tables");
__device__ __forceinline__ void mlstm_unit(const Params& p, LAS unsigned char* lds, int unit, int wave, int lane, int tid) {
    const int s = unit & 7, h = (unit >> 3) & 7, b = unit >> 6;
    const int g = lane >> 4, li = lane & 15, q4 = li >> 2, p4 = lane & 3;
    const int tt = wave >> 1, vh = wave & 1;
    const bf16_t* U = (const bf16_t*)(p.ws + WS_U) + (size_t)(b * SEQ) * NU;
    bf16_t* HR = (bf16_t*)(p.ws + WS_HRAW) + (size_t)(b * SEQ) * 4096 + h * 512 + s * 64;
    const int srow = tid >> 5, sch = tid & 31, vrow = tid >> 3, vch = tid & 7;
    LAS float* tBS = (LAS float*)(lds + ML_TAB_BS); LAS float* tCJ = (LAS float*)(lds + ML_TAB_CJ); LAS float* tCM = (LAS float*)(lds + ML_TAB_CM); LAS float* tMST = (LAS float*)(lds + ML_TAB_MST);
    if (tid < 64) {
        *(LAS u32x4*)(lds + ML_V + tid * ML_VS + 128) = (u32x4){0x3F80u, 0u, 0u, 0u}; *(LAS u32x4*)(lds + ML_V + tid * ML_VS + 144) = (u32x4){0u, 0u, 0u, 0u};
        *(LAS u32x4*)(lds + ML_VSC + tid * ML_VS + 128) = (u32x4){0u, 0u, 0u, 0u}; *(LAS u32x4*)(lds + ML_VSC + tid * ML_VS + 144) = (u32x4){0u, 0u, 0u, 0u};
    }
    for (int cc = wave; cc < SEQ / 64; cc += NWAVES) {
        const size_t tok = (size_t)(cc * 64 + lane);
        const float ig = bf2f(U[tok * NU + UI + h]), fp = bf2f(U[tok * NU + UF + h]);
        const float lf = fminf(fp, 0.f) - log1pf(__expf(-fabsf(fp)));
        float bs = lf;
#pragma unroll
        for (int o = 1; o < 64; o <<= 1) { const float t_ = __shfl_up(bs, o); if (lane >= o) bs += t_; }
        const float Cj = ig - bs; float cm = Cj;
#pragma unroll
        for (int o = 1; o < 64; o <<= 1) { const float t_ = __shfl_up(cm, o); if (lane >= o) cm = fmaxf(cm, t_); }
        tBS[cc * 64 + lane] = bs; tCJ[cc * 64 + lane] = Cj; tCM[cc * 64 + lane] = cm;
    }
    __syncthreads();
    if (tid == 0) { float m = 0.f; for (int c = 0; c < SEQ / 64; ++c) { tMST[c] = m; m = tBS[c * 64 + 63] + fmaxf(tCM[c * 64 + 63], m); } }
    f32x4 cacc[2][5];
#pragma unroll
    for (int a = 0; a < 2; ++a)
#pragma unroll
        for (int v = 0; v < 5; ++v) cacc[a][v] = (f32x4){0.f, 0.f, 0.f, 0.f};
    u32x4 rq[4], rk[4], rv;
#define ML_PREFETCH(c) do { const bf16_t* base_ = U + (size_t)((c) * 64) * NU; \
        _Pragma("unroll") for (int i_ = 0; i_ < 4; ++i_) { rq[i_] = *(const u32x4*)(base_ + (size_t)(srow + 16 * i_) * NU + UQ + h * 256 + sch * 8); \
                                                          rk[i_] = *(const u32x4*)(base_ + (size_t)(srow + 16 * i_) * NU + UK + h * 256 + sch * 8); } \
        rv = *(const u32x4*)(base_ + (size_t)vrow * NU + UV + h * 512 + s * 64 + vch * 8); } while (0)
#define ML_SB __builtin_amdgcn_sched_barrier(0)
#define ML_LDK(dst, jt) do { _Pragma("unroll") for (int ks_ = 0; ks_ < 8; ++ks_) dst[ks_] = *(const LAS bf16x8*)(lds + ML_K + (16 * (jt) + li) * ML_RS + g * 16 + ks_ * 64); } while (0)
#define ML_LDC(dst, vt) do { _Pragma("unroll") for (int ks_ = 0; ks_ < 8; ++ks_) dst[ks_] = *(const LAS bf16x8*)(lds + ML_CT + (16 * (vt) + li) * ML_RS + g * 16 + ks_ * 64); } while (0)
#define ML_MMA8(acc, A, B) do { _Pragma("unroll") for (int ks_ = 0; ks_ < 8; ++ks_) acc = __builtin_amdgcn_mfma_f32_16x16x32_bf16(A[ks_], B[ks_], acc, 0, 0, 0); } while (0)
    ML_PREFETCH(0);
    __syncthreads();
    const int tcol = 16 * tt + li;
    for (int c = 0; c < SEQ / 64; ++c) {
        const float mst = tMST[c], M63 = fmaxf(tCM[c * 64 + 63], mst), decay = __expf(mst - M63);
        const float Mt_t = fmaxf(tCM[c * 64 + tcol], mst), inter_t = __expf(mst - Mt_t), emt_t = __expf(-(tBS[c * 64 + tcol] + Mt_t));
#pragma unroll
        for (int a = 0; a < 2; ++a)
#pragma unroll
            for (int v = 0; v < 5; ++v) { u32x2 w; w.x = cvt_pk_bf16(cacc[a][v][0], cacc[a][v][1]); w.y = cvt_pk_bf16(cacc[a][v][2], cacc[a][v][3]);
                *(LAS u32x2*)(lds + ML_CT + (16 * v + li) * ML_RS + (16 * (2 * wave + a) + 4 * g) * 2) = w; }
#pragma unroll
        for (int i = 0; i < 4; ++i) { *(LAS u32x4*)(lds + ML_Q + (srow + 16 * i) * ML_RS + sch * 16) = rq[i]; *(LAS u32x4*)(lds + ML_K + (srow + 16 * i) * ML_RS + sch * 16) = rk[i]; }
        *(LAS u32x4*)(lds + ML_V + vrow * ML_VS + vch * 16) = rv;
        { const float sc = __expf(tCJ[c * 64 + vrow] - M63); u32x4 o;
          o.x = cvt_pk_bf16(bf_lo(rv.x) * sc, bf_hi(rv.x) * sc); o.y = cvt_pk_bf16(bf_lo(rv.y) * sc, bf_hi(rv.y) * sc);
          o.z = cvt_pk_bf16(bf_lo(rv.z) * sc, bf_hi(rv.z) * sc); o.w = cvt_pk_bf16(bf_lo(rv.w) * sc, bf_hi(rv.w) * sc);
          *(LAS u32x4*)(lds + ML_VSC + vrow * ML_VS + vch * 16) = o; }
        if (tid < 64) *(LAS bf16_t*)(lds + ML_VSC + tid * ML_VS + 128) = (bf16_t)(cvt_pk_bf16(__expf(tCJ[c * 64 + tid] - M63), 0.f) & 0xffffu);
        __syncthreads();
        { const int cn = (c + 1 < SEQ / 64) ? c + 1 : c; ML_PREFETCH(cn); }
        bf16x8 Bq[8], A0[8], A1[8]; f32x4 sacc[4], pacc[3], cj4[4];
#pragma unroll
        for (int j = 0; j < 4; ++j) sacc[j] = (f32x4){0.f, 0.f, 0.f, 0.f};
#pragma unroll
        for (int a = 0; a < 3; ++a) pacc[a] = (f32x4){0.f, 0.f, 0.f, 0.f};
#pragma unroll
        for (int ks = 0; ks < 8; ++ks) Bq[ks] = *(const LAS bf16x8*)(lds + ML_Q + tcol * ML_RS + g * 16 + ks * 64);
        ML_LDK(A0, 0); ML_SB;
        ML_LDK(A1, 1); ML_MMA8(sacc[0], A0, Bq); ML_SB;
        ML_LDK(A0, 2); ML_MMA8(sacc[1], A1, Bq); ML_SB;
        ML_LDK(A1, 3); ML_MMA8(sacc[2], A0, Bq); ML_SB;
        ML_LDC(A0, 2 * vh);
#pragma unroll
        for (int jt = 0; jt < 4; ++jt) cj4[jt] = *(const LAS f32x4*)(tCJ + c * 64 + 16 * jt + 4 * g);
        ML_MMA8(sacc[3], A1, Bq); ML_SB;
        ML_LDC(A1, 2 * vh + 1); ML_MMA8(pacc[0], A0, Bq); ML_SB;
        ML_LDC(A0, 4); ML_MMA8(pacc[1], A1, Bq); ML_SB;
        bf16x8 Av[2][3];
#pragma unroll
        for (int ks2 = 0; ks2 < 2; ++ks2)
#pragma unroll
            for (int a = 0; a < 3; ++a) { const int vt = (a == 2) ? 4 : 2 * vh + a;
                const LAS unsigned char* ad = lds + ML_V + (32 * ks2 + 4 * g + q4) * ML_VS + (16 * vt + 4 * p4) * 2;
                Av[ks2][a] = tr_pair(ad, ad + 16 * ML_VS); }
        ML_MMA8(pacc[2], A0, Bq);
        bf16x8 sp[2];
#pragma unroll
        for (int ks2 = 0; ks2 < 2; ++ks2) {
            float sv[8];
#pragma unroll
            for (int e = 0; e < 8; ++e) { const int jt = 2 * ks2 + (e >> 2), j = 16 * jt + 4 * g + (e & 3);
                sv[e] = (j <= tcol) ? sacc[jt][e & 3] * __expf(cj4[jt][e & 3] - Mt_t) : 0.f; }
            const unsigned w0 = cvt_pk_bf16(sv[0], sv[1]), w1 = cvt_pk_bf16(sv[2], sv[3]), w2 = cvt_pk_bf16(sv[4], sv[5]), w3 = cvt_pk_bf16(sv[6], sv[7]);
            sp[ks2] = (bf16x8){(short)(w0 & 0xffff), (short)(w0 >> 16), (short)(w1 & 0xffff), (short)(w1 >> 16), (short)(w2 & 0xffff), (short)(w2 >> 16), (short)(w3 & 0xffff), (short)(w3 >> 16)};
        }
        ML_SB;
        bf16x8 Ck[2], Cv[5];
#pragma unroll
        for (int a = 0; a < 2; ++a) { const LAS unsigned char* ad = lds + ML_K + (8 * g + q4) * ML_RS + (16 * (2 * wave + a) + 4 * p4) * 2; Ck[a] = tr_pair(ad, ad + 4 * ML_RS); }
#pragma unroll
        for (int v = 0; v < 5; ++v) { const LAS unsigned char* ad = lds + ML_VSC + (8 * g + q4) * ML_VS + (16 * v + 4 * p4) * 2; Cv[v] = tr_pair(ad, ad + 4 * ML_VS); }
#pragma unroll
        for (int a = 0; a < 3; ++a) pacc[a] = pacc[a] * inter_t;
#pragma unroll
        for (int ks2 = 0; ks2 < 2; ++ks2)
#pragma unroll
            for (int a = 0; a < 3; ++a) pacc[a] = __builtin_amdgcn_mfma_f32_16x16x32_bf16(Av[ks2][a], sp[ks2], pacc[a], 0, 0, 0);
#pragma unroll
        for (int a = 0; a < 2; ++a)
#pragma unroll
            for (int v = 0; v < 5; ++v) cacc[a][v] = cacc[a][v] * decay;
        ML_SB;
        bf16x8 Dk[2], Dv[5];
#pragma unroll
        for (int a = 0; a < 2; ++a) { const LAS unsigned char* ad = lds + ML_K + (32 + 8 * g + q4) * ML_RS + (16 * (2 * wave + a) + 4 * p4) * 2; Dk[a] = tr_pair(ad, ad + 4 * ML_RS); }
#pragma unroll
        for (int v = 0; v < 5; ++v) { const LAS unsigned char* ad = lds + ML_VSC + (32 + 8 * g + q4) * ML_VS + (16 * v + 4 * p4) * 2; Dv[v] = tr_pair(ad, ad + 4 * ML_VS); }
#pragma unroll
        for (int v = 0; v < 5; ++v)
#pragma unroll
            for (int a = 0; a < 2; ++a) cacc[a][v] = __builtin_amdgcn_mfma_f32_16x16x32_bf16(Ck[a], Cv[v], cacc[a][v], 0, 0, 0);
        { const float den = __shfl(pacc[2][0], li);
          const float inv = 1.0f / fmaxf(fabsf(den), emt_t);
          bf16_t* hp = HR + (size_t)(c * 64 + tcol) * 4096 + 4 * g;
#pragma unroll
          for (int a = 0; a < 2; ++a) { u32x2 w; w.x = cvt_pk_bf16(pacc[a][0] * inv, pacc[a][1] * inv); w.y = cvt_pk_bf16(pacc[a][2] * inv, pacc[a][3] * inv);
              *(u32x2*)(hp + 16 * (2 * vh + a)) = w; } }
        ML_SB;
#pragma unroll
        for (int v = 0; v < 5; ++v)
#pragma unroll
            for (int a = 0; a < 2; ++a) cacc[a][v] = __builtin_amdgcn_mfma_f32_16x16x32_bf16(Dk[a], Dv[v], cacc[a][v], 0, 0, 0);
        __syncthreads();
    }
#undef ML_PREFETCH
#undef ML_SB
#undef ML_LDK
#undef ML_LDC
#undef ML_MMA8
}

__global__ void __launch_bounds__(NWAVES * 64, 2) mk_fwd(Params p) {
    extern __shared__ __attribute__((aligned(16))) unsigned char lds_raw[];
    LAS unsigned char* lds = (LAS unsigned char*)lds_raw;
    volatile LAS unsigned* MISC = (volatile LAS unsigned*)(lds + MISC_OFF);
    const int tid = threadIdx.x, lane = tid & 63, wave = __builtin_amdgcn_readfirstlane(tid >> 6);
    const int G = gridDim.x, bx = blockIdx.x;
    const int vcu = (G % 8 == 0) ? (bx % 8) * (G / 8) + bx / 8 : bx;
    const int gw = vcu * NWAVES + wave, NGW = G * NWAVES;
    unsigned char* ws = p.ws;
    unsigned* ctl = (unsigned*)(ws + WS_CTL);
    for (int u = tid; u < 1024 / 4; u += NWAVES * 64) ((LAS unsigned*)(lds + LDSCTL_OFF))[u] = 0u;
    __syncthreads();
    const bool one_launch = (p.ph_lo == 0 && p.ph_hi >= 8);
    XcdBarrier bar; bar.bar = ctl + CW_BAR; bar.x = 0; bar.st = nullptr;
    if (one_launch) bar = xcd_barrier_post(ctl + CW_BAR, MISC + 8);
    const int lo = p.ph_lo, hi = p.ph_hi;
#define IN(k) (lo <= (k) && (k) < hi)
#ifndef MK_DUP
#define MK_DUP -1
#endif
#define REP(k) for (int rep_ = 0; rep_ < ((MK_DUP) == (k) ? 2 : 1); ++rep_)
#define GRID_BAR() do { if (one_launch) xcd_barrier(bar); } while (0)

    if (IN(0)) { REP(0) p0_prologue(p, lds, gw, NGW, wave, lane); GRID_BAR(); }
    if (IN(1)) {
        SchedP1 S{G, bx, (unsigned)WS_XB, (unsigned)WS_MEMB, (unsigned)WS_WINT, (unsigned)WS_WKVT};
        EpiP1 E{(bf16_t*)(ws + WS_U), (const float*)(ws + WS_BU), (bf16_t*)(ws + WS_KMEM), (bf16_t*)(ws + WS_VT), lds};
        REP(1) pg8::gemm_phase<EpiP1, SchedP1, true, true, true, true>(lds, ws, 64 * 16384, 64 * 16384, S, E);
        GRID_BAR();
    }
    if (IN(2)) {
        const int NATT = 128;
        const bool att = bx < NATT;
        for (int a = bx; a < NATT; a += G) {
            { SchedQK S{NATT, a, (unsigned)WS_U, (unsigned)WS_KMEM}; EpiSoftmax E{(bf16_t*)(ws + WS_PB), lds};
              pg8::gemm_phase<EpiSoftmax, SchedQK, true, true, false, false>(lds, ws, NU * 2, 4096, S, E); }
            VM_WAIT(); __syncthreads();
            { SchedPV S{NATT, a, (unsigned)WS_PB, (unsigned)WS_VT}; EpiPV E{(const bf16_t*)(ws + WS_U), (bf16_t*)(ws + WS_YCX)};
              pg8::gemm_phase<EpiPV, SchedPV, true, true, false, false>(lds, ws, 2048, 2048, S, E); }
        }
        {
            const int NIT = (T / 16) * 256, nidle = G > NATT ? G - NATT : 0;
            const int split = nidle ? NIT : 0;
            if (!att) conv_phase(p, (bx - NATT) * (NWAVES * 64) + tid, nidle * NWAVES * 64, 0, split);
            else { const int nb = G < NATT ? G : NATT; conv_phase(p, bx * (NWAVES * 64) + tid, nb * NWAVES * 64, split, NIT); }
        }
        __syncthreads();
        REP(9) for (int unit = vcu; unit < 256; unit += G) mlstm_unit(p, lds, unit, wave, lane, tid);
        GRID_BAR();
    }
    if (IN(3)) { REP(10) ym_phase(p, gw, NGW, lane); GRID_BAR(); }
    if (IN(5)) {
        SchedMerge S{G, bx, (unsigned)WS_YM, (unsigned)WS_YCX, (unsigned)WS_WPMT, (unsigned)WS_WPCXT};
        EpiMerge E{(const bf16_t*)(ws + WS_U), ws + WS_MERGED};
        REP(5) pg8::gemm_phase<EpiMerge, SchedMerge, true, true, true, true>(lds, ws, 64 * 16384, 64 * 16384, S, E);
        GRID_BAR();
    }
    if (IN(6)) {
        SchedOut S{G, bx, (unsigned)WS_MERGED, (unsigned)WS_WOT}; EpiOut E{p.x, p.out};
        REP(6) pg8::gemm_phase<EpiOut, SchedOut, true, true, true, true>(lds, ws, 64 * 16384, 64 * 16384, S, E);
        GRID_BAR();
    }
    if (IN(7)) ln_phase(p, gw, NGW, lane);
#undef IN
#undef GRID_BAR
}

#ifndef MK_N_LAUNCHES
#define MK_N_LAUNCHES 1
#endif
extern "C" void kernel_launch(void* const* d_in, const int* in_sizes, int n_in, void* d_out, int out_size, void* d_ws, size_t ws_size, hipStream_t stream) {
    static int grid = 0;
    if (grid == 0) {
        if (n_in != 13 || out_size != T * D || ws_size < WS_END) { fprintf(stderr, "kernel_launch: unexpected shapes (n_in %d out %d ws %zu)\n", n_in, out_size, ws_size); grid = -1; return; }
        int dev = 0, cus = 0, per_cu = 0;
        if (hipGetDevice(&dev) != hipSuccess || hipDeviceGetAttribute(&cus, hipDeviceAttributeMultiprocessorCount, dev) != hipSuccess) { grid = -1; return; }
        if (hipFuncSetAttribute((const void*)mk_fwd, hipFuncAttributeMaxDynamicSharedMemorySize, LDS_BYTES) != hipSuccess) { fprintf(stderr, "kernel_launch: hipFuncSetAttribute failed\n"); grid = -1; return; }
        if (hipOccupancyMaxActiveBlocksPerMultiprocessor(&per_cu, (const void*)mk_fwd, NWAVES * 64, LDS_BYTES) != hipSuccess || per_cu < 1)
            fprintf(stderr, "kernel_launch: note: occupancy query reports %d\n", per_cu);
        (void)hipGetLastError();
        grid = cus;
    }
    if (grid < 0) return;
    (void)hipMemsetAsync((char*)d_ws + WS_CTL, 0, CTL_ZERO_BYTES, stream);
    Params p{};
    p.x = (const float*)d_in[0]; p.mem = (const float*)d_in[1]; p.w_in = (const float*)d_in[2]; p.b_in = (const float*)d_in[3];
    p.conv_w = (const float*)d_in[4]; p.mh_norm_w = (const float*)d_in[5]; p.w_mem_kv = (const float*)d_in[6]; p.w_proj_m = (const float*)d_in[7];
    p.w_proj_c = (const float*)d_in[8]; p.w_proj_x = (const float*)d_in[9]; p.w_out = (const float*)d_in[10]; p.ln_w = (const float*)d_in[11]; p.ln_b = (const float*)d_in[12];
    p.out = (float*)d_out; p.ws = (unsigned char*)d_ws;
    if (MK_N_LAUNCHES == 1) { p.ph_lo = 0; p.ph_hi = 8; hipLaunchKernelGGL(mk_fwd, dim3(grid), dim3(NWAVES * 64), LDS_BYTES, stream, p); }
    else for (int k = 0; k < 8; ++k) { p.ph_lo = k; p.ph_hi = k + 1; hipLaunchKernelGGL(mk_fwd, dim3(grid), dim3(NWAVES * 64), LDS_BYTES, stream, p); }
}
```

```cpp
#include <hip/hip_runtime.h>
#include <cstdio>
#include <cstdint>

#define LAS __attribute__((address_space(3)))
#define GAS __attribute__((address_space(1)))
typedef unsigned short bf16_t;
typedef short bf16x8 __attribute__((ext_vector_type(8)));
typedef float f32x4 __attribute__((ext_vector_type(4)));
typedef float f32x2 __attribute__((ext_vector_type(2)));
typedef unsigned u32x4 __attribute__((ext_vector_type(4)));
typedef unsigned u32x2 __attribute__((ext_vector_type(2)));

constexpr int NB = 4, SEQ = 2048, T = NB * SEQ, D = 4096;
constexpr int DIN = 40976, NU = 41216;
constexpr int MEMLEN = 256, TM = NB * MEMLEN;
constexpr int UQ = 0, UK = 2048, UV = 4096, UO = 8192, UZ = 12288, UCB = 16384, UCC = 18432, UCX = 20480, UCZ = 22528,
              UXQ = 24576, UXZ = 26624, UG = 28672, UI = 40960, UF = 40968;
constexpr float LN_EPS = 1e-5f;
constexpr float DN_ALPHA = 1.189207115002721f;

constexpr size_t MiB = 1u << 20;
constexpr size_t WS_CTL = 0, CTL_ZERO_BYTES = 1 * MiB;
constexpr size_t WS_BU = 1 * MiB;
constexpr size_t WS_XB = 2 * MiB;
constexpr size_t WS_MEMB = 66 * MiB;
constexpr size_t WS_WINT = 74 * MiB;
constexpr size_t WS_WKVT = 396 * MiB;
constexpr size_t WS_WPMT = 428 * MiB;
constexpr size_t WS_WPCXT = 460 * MiB;
constexpr size_t WS_WOT = 492 * MiB;
constexpr size_t WS_U = 524 * MiB;
constexpr size_t WS_KMEM = 1168 * MiB;
constexpr size_t WS_VT = 1172 * MiB;
constexpr size_t WS_SC = 1176 * MiB;
constexpr size_t WS_PB = 1208 * MiB;
constexpr size_t WS_HRAW = 1224 * MiB;
constexpr size_t WS_YM = 1288 * MiB;
constexpr size_t WS_YCX = 1352 * MiB;
constexpr size_t WS_MERGED = 1416 * MiB;
constexpr size_t WS_GB = 1480 * MiB;
constexpr size_t WS_END = 1672 * MiB;
constexpr int CW_BAR = 4096;

constexpr int RING_BYTES = 131072;
constexpr int LDSCTL_OFF = RING_BYTES, MISC_OFF = LDSCTL_OFF + 320;
constexpr int EPI_OFF = RING_BYTES + 1024, EPI_WAVE_BYTES = 16 * 144;
constexpr int LDS_BYTES = 163840;
static_assert(EPI_OFF + 8 * EPI_WAVE_BYTES <= LDS_BYTES, "LDS map");
constexpr int NWAVES = 8;

typedef __bf16 bf16x2_t __attribute__((ext_vector_type(2)));
__device__ __forceinline__ unsigned cvt_pk_bf16_asm(float lo, float hi) { unsigned r; asm("v_cvt_pk_bf16_f32 %0, %1, %2" : "=v"(r) : "v"(lo), "v"(hi)); return r; }
__device__ __forceinline__ unsigned cvt_pk_bf16(float lo, float hi) { const bf16x2_t v = __builtin_convertvector((f32x2){lo, hi}, bf16x2_t); return __builtin_bit_cast(unsigned, v); }
__device__ __forceinline__ float bf_lo(unsigned w) { return __uint_as_float(w << 16); }
__device__ __forceinline__ float bf_hi(unsigned w) { return __uint_as_float(w & 0xffff0000u); }
__device__ __forceinline__ float bf2f(bf16_t h) { return __uint_as_float(((unsigned)h) << 16); }
__device__ __forceinline__ float sigmoidf_(float x) { return __builtin_amdgcn_rcpf(1.0f + __expf(-x)); }
__device__ __forceinline__ float wave_sum(float v) {
#pragma unroll
    for (int o = 1; o < 64; o <<= 1) v += __shfl_xor(v, o);
    return v;
}
__device__ __forceinline__ float wave_max(float v) {
#pragma unroll
    for (int o = 1; o < 64; o <<= 1) v = fmaxf(v, __shfl_xor(v, o));
    return v;
}
#define LDS_WAIT() asm volatile("s_waitcnt lgkmcnt(0)" ::: "memory")
#define VM_WAIT() asm volatile("s_waitcnt vmcnt(0)" ::: "memory")

namespace pg8 {
constexpr int BM = 256, BK = 64, HALF = 128, HTB = HALF * BK * 2, STAGE_BYTES = 8 * HTB;
__host__ __device__ __forceinline__ int lds_byte(int r, int c) { const int st = (r >> 4) * 2 + (c >> 5), rr = r & 15, cc = c & 31, ob = rr * 64 + cc * 2; return st * 1024 + (ob ^ (((ob >> 9) & 1) << 5)); }
__host__ __device__ __forceinline__ void stage_rc(int b, int& R, int& C) { const int st = b / 1024, sb = b % 1024, swz = sb ^ (((sb >> 9) & 1) << 5); R = (st >> 1) * 16 + swz / 64; C = (st & 1) * 32 + (swz % 64) / 2; }
__host__ __device__ __forceinline__ int perm32(int rho) { const int n = rho >> 4, i = rho & 15; return 8 * (i >> 2) + 4 * n + (i & 3); }

struct Unit { unsigned A; unsigned B; int nt, pm, pn, kind; };

__device__ __forceinline__ bool tile_map(long L, int nM, int nN, int& pm, int& pn) {
    const int nwg = nM * nN; if (L >= nwg) return false;
    int wgid = (int)L; { const int q = nwg / 8, r = nwg % 8, xcd = wgid % 8, off = wgid / 8; wgid = (xcd < r ? xcd * (q + 1) : r * (q + 1) + (xcd - r) * q) + off; }
    const int nig = 8 * nN, gid = wgid / nig, fm = gid * 8, gsz = (nM - fm) < 8 ? (nM - fm) : 8;
    pm = fm + ((wgid % nig) % gsz); pn = (wgid % nig) / gsz; return true;
}

template <class Epi, class Sched, bool ALIGN_EPI, bool SP2, bool APACK, bool BPACK>
__device__ __forceinline__ void gemm_phase(LAS unsigned char* lds, const unsigned char* wsbase, const int lda, const int ldb, const Sched& S, const Epi& E) {
    const int tid = threadIdx.x, wid = __builtin_amdgcn_readfirstlane(tid >> 6), lane = tid & 63, wr = wid >> 2, wc = wid & 3, fr = lane & 15, fq = lane >> 4;
    unsigned voffA[2], voffB[2];
#pragma unroll
    for (int i = 0; i < 2; ++i) { int R, C; stage_rc(tid * 16 + i * 8192, R, C); const int Rb = Epi::PERM ? ((R & ~31) + perm32(R & 31)) : R;
        voffA[i] = APACK ? (unsigned)(tid * 16 + i * 8192) : (unsigned)(R * lda + C * 2); voffB[i] = BPACK ? (unsigned)(tid * 16 + i * 8192) : (unsigned)(Rb * ldb + C * 2); }
    const unsigned kstepA = APACK ? 16384u : (unsigned)(BK * 2), kstepB = BPACK ? 16384u : (unsigned)(BK * 2);
    const unsigned hstepA = APACK ? (unsigned)lda : (unsigned)(HALF * lda), hstepB = BPACK ? (unsigned)ldb : (unsigned)(HALF * ldb);
    const __amdgpu_buffer_rsrc_t rsrc = __builtin_amdgcn_make_buffer_rsrc((void*)wsbase, 0, 0xFFFFFFFFu, 0x00020000);
    const unsigned ldsw = (unsigned)wid * 1024u;
    const int aoff = lds_byte(wr * 64 + fr, fq * 8), boff = lds_byte(wc * 32 + fr, fq * 8);
#define PG8_SA(b, h) (((b) * 2 + (h)) * HTB)
#define PG8_SB(b, h) ((4 + (b) * 2 + (h)) * HTB)
#define PG8_STAGE(bufoff, goff, voff) do { _Pragma("unroll") for (int _i = 0; _i < 2; ++_i) \
        __builtin_amdgcn_raw_ptr_buffer_load_lds(rsrc, (LAS void*)(lds + (bufoff) + ldsw + _i * 8192), 16, (int)(voff)[_i], (int)(goff), 0, 0); } while (0)
#define PG8_LDA(dst, b, h) do { _Pragma("unroll") for (int m = 0; m < 4; ++m) _Pragma("unroll") for (int k = 0; k < 2; ++k) dst[m][k] = *(const LAS bf16x8*)(lds + PG8_SA(b, h) + aoff + m * 2048 + k * 1024); } while (0)
#define PG8_LDB(dst, b, h) do { _Pragma("unroll") for (int n = 0; n < 2; ++n) _Pragma("unroll") for (int k = 0; k < 2; ++k) dst[n][k] = *(const LAS bf16x8*)(lds + PG8_SB(b, h) + boff + n * 2048 + k * 1024); } while (0)
#define PG8_MMA(ai, bj, At, Bt) do { __builtin_amdgcn_s_setprio(1); _Pragma("unroll") for (int m = 0; m < 4; ++m) _Pragma("unroll") for (int n = 0; n < 2; ++n) _Pragma("unroll") for (int k = 0; k < 2; ++k) \
        acc[ai][bj][m][n] = __builtin_amdgcn_mfma_f32_16x16x32_bf16(Bt[n][k], At[m][k], acc[ai][bj][m][n], 0, 0, 0); __builtin_amdgcn_s_setprio(0); } while (0)
#define PG8_WAIT_V(n) asm volatile("s_waitcnt vmcnt(" #n ")" ::: "memory")
#define PG8_WAIT_L(n) asm volatile("s_waitcnt lgkmcnt(" #n ")" ::: "memory")
#define PG8_BAR __builtin_amdgcn_s_barrier()
#define PG8_SCHED __builtin_amdgcn_sched_barrier(0)
    Unit cur, nxt; int ui = 0;
    if (!S.next(0, cur)) return;
    f32x4 acc[2][2][4][2];
#pragma unroll
    for (int a = 0; a < 2; ++a)
#pragma unroll
        for (int b = 0; b < 2; ++b)
#pragma unroll
            for (int m = 0; m < 4; ++m)
#pragma unroll
                for (int n = 0; n < 2; ++n) acc[a][b][m][n] = (f32x4){0.f, 0.f, 0.f, 0.f};
    bf16x8 At[4][2], B0[2][2], B1[2][2];
    unsigned cA = cur.A, cB = cur.B;
    if constexpr (SP2) {
        PG8_STAGE(PG8_SB(0, 0), cB, voffB); PG8_STAGE(PG8_SB(0, 1), cB + hstepB, voffB); PG8_STAGE(PG8_SA(0, 0), cA, voffA); PG8_STAGE(PG8_SA(0, 1), cA + hstepA, voffA);
        if (wr == 1) PG8_BAR;
        PG8_WAIT_V(2); PG8_BAR;
        PG8_STAGE(PG8_SB(1, 0), cB + kstepB, voffB); PG8_STAGE(PG8_SA(1, 0), cA + kstepA, voffA); PG8_STAGE(PG8_SB(1, 1), cB + hstepB + kstepB, voffB);
        PG8_WAIT_V(6); PG8_BAR;
    } else {
        PG8_STAGE(PG8_SB(0, 0), cB, voffB); PG8_STAGE(PG8_SA(0, 0), cA, voffA); PG8_STAGE(PG8_SB(0, 1), cB + hstepB, voffB); PG8_STAGE(PG8_SA(0, 1), cA + hstepA, voffA);
        if (wr == 1) PG8_BAR;
        PG8_WAIT_V(4); PG8_BAR;
        PG8_STAGE(PG8_SB(1, 0), cB + kstepB, voffB); PG8_STAGE(PG8_SA(1, 0), cA + kstepA, voffA); PG8_STAGE(PG8_SB(1, 1), cB + hstepB + kstepB, voffB);
        PG8_WAIT_V(6); PG8_BAR;
    }
    for (;;) {
        const bool has_next = S.next(ui + 1, nxt);
        const unsigned nA = has_next ? nxt.A : cA, nB = has_next ? nxt.B : cB;
        const int nt = cur.nt;
#pragma clang loop unroll(disable)
        for (int t = 0; t < nt; t += 2) {
            const bool last = (t == nt - 2);
            const unsigned a1 = cA + (unsigned)(t + 1) * kstepA;
            const unsigned a2 = last ? nA : cA + (unsigned)(t + 2) * kstepA, b2 = last ? nB : cB + (unsigned)(t + 2) * kstepB;
            const unsigned a3 = a2 + kstepA, b3 = b2 + kstepB;
            if constexpr (SP2) {
            PG8_LDB(B0, 0, 0); PG8_LDB(B1, 0, 1); PG8_SCHED; PG8_LDA(At, 0, 0); PG8_STAGE(PG8_SA(1, 1), a1 + hstepA, voffA);
            PG8_WAIT_V(8); PG8_WAIT_L(0); PG8_BAR; PG8_MMA(0, 0, At, B0); PG8_MMA(0, 1, At, B1); PG8_BAR; PG8_SCHED;
            PG8_LDA(At, 0, 1); PG8_STAGE(PG8_SB(0, 0), b2, voffB); PG8_STAGE(PG8_SB(0, 1), b2 + hstepB, voffB); PG8_STAGE(PG8_SA(0, 0), a2, voffA);
            PG8_WAIT_V(8); PG8_WAIT_L(0); PG8_BAR; PG8_MMA(1, 0, At, B0); PG8_MMA(1, 1, At, B1); PG8_BAR; PG8_SCHED;
            PG8_LDB(B0, 1, 0); PG8_LDB(B1, 1, 1); PG8_SCHED; PG8_LDA(At, 1, 0); PG8_STAGE(PG8_SA(0, 1), a2 + hstepA, voffA);
            PG8_WAIT_V(8); PG8_WAIT_L(0); PG8_BAR; PG8_MMA(0, 0, At, B0); PG8_MMA(0, 1, At, B1); PG8_BAR; PG8_SCHED;
            PG8_LDA(At, 1, 1); PG8_STAGE(PG8_SB(1, 0), b3, voffB); PG8_STAGE(PG8_SB(1, 1), b3 + hstepB, voffB); PG8_STAGE(PG8_SA(1, 0), a3, voffA);
            PG8_WAIT_V(8); PG8_WAIT_L(0); PG8_BAR; PG8_MMA(1, 0, At, B0); PG8_MMA(1, 1, At, B1); PG8_BAR; PG8_SCHED;
            } else {
            PG8_LDB(B0, 0, 0); PG8_SCHED; PG8_LDA(At, 0, 0); PG8_STAGE(PG8_SA(1, 1), a1 + hstepA, voffA);
            PG8_WAIT_L(8); PG8_BAR; PG8_WAIT_L(0); PG8_MMA(0, 0, At, B0); PG8_BAR; PG8_SCHED;
            PG8_LDB(B1, 0, 1); PG8_STAGE(PG8_SB(0, 0), b2, voffB);
            PG8_BAR; PG8_WAIT_L(0); PG8_MMA(0, 1, At, B1); PG8_BAR;
            PG8_LDA(At, 0, 1); PG8_STAGE(PG8_SA(0, 0), a2, voffA);
            PG8_BAR; PG8_WAIT_L(0); PG8_MMA(1, 0, At, B0); PG8_BAR; PG8_SCHED;
            PG8_STAGE(PG8_SB(0, 1), b2 + hstepB, voffB);
            PG8_WAIT_V(6); PG8_BAR; PG8_MMA(1, 1, At, B1); PG8_BAR;
            PG8_LDB(B0, 1, 0); PG8_SCHED; PG8_LDA(At, 1, 0); PG8_STAGE(PG8_SA(0, 1), a2 + hstepA, voffA);
            PG8_WAIT_L(8); PG8_BAR; PG8_WAIT_L(0); PG8_MMA(0, 0, At, B0); PG8_BAR; PG8_SCHED;
            PG8_LDB(B1, 1, 1); PG8_STAGE(PG8_SB(1, 0), b3, voffB);
            PG8_BAR; PG8_WAIT_L(0); PG8_MMA(0, 1, At, B1); PG8_BAR;
            PG8_LDA(At, 1, 1); PG8_STAGE(PG8_SA(1, 0), a3, voffA);
            PG8_BAR; PG8_WAIT_L(0); PG8_MMA(1, 0, At, B0); PG8_BAR; PG8_SCHED;
            PG8_STAGE(PG8_SB(1, 1), b3 + hstepB, voffB);
            PG8_WAIT_V(6); PG8_BAR; PG8_MMA(1, 1, At, B1); PG8_BAR;
            }
        }
        if constexpr (ALIGN_EPI) { if (wr == 0) PG8_BAR; }
        E(acc, cur, wr, wc, fr, fq);
        if (!has_next) break;
        if (!(Epi::KEEP && cur.kind != 2)) {
#pragma unroll
        for (int a = 0; a < 2; ++a)
#pragma unroll
            for (int b = 0; b < 2; ++b)
#pragma unroll
                for (int m = 0; m < 4; ++m)
#pragma unroll
                    for (int n = 0; n < 2; ++n) acc[a][b][m][n] = (f32x4){0.f, 0.f, 0.f, 0.f};
        }
        cur = nxt; cA = nA; cB = nB; ++ui;
        if constexpr (ALIGN_EPI) { if (wr == 1) PG8_BAR; }
    }
    PG8_WAIT_V(0);
    if constexpr (!ALIGN_EPI) { if (wr == 0) PG8_BAR; }
    PG8_BAR;
#undef PG8_SA
#undef PG8_SB
#undef PG8_STAGE
#undef PG8_LDA
#undef PG8_LDB
#undef PG8_MMA
#undef PG8_WAIT_V
#undef PG8_WAIT_L
#undef PG8_BAR
#undef PG8_SCHED
}
}
using pg8::Unit;
constexpr size_t PKB = 16384;
__device__ __forceinline__ size_t pk_off(int row, int col, int ktiles) { return ((size_t)(row >> 7) * ktiles + (col >> 6)) * PKB + pg8::lds_byte(row & 127, col & 63); }

#define XB_TMO      128
#define XB_XCNT(j)  (256  + 64 * (j))
#define XB_XSUB(j)  (1280 + 64 * (j))
#define XB_XGEN(j)  (2304 + 64 * (j))
#define XB_TOP      3328
#define XB_TOPGEN   3392
#define XCD_BAR_WORDS 3456
#define XB_SPIN_CAP (1u << 18)

__device__ __forceinline__ unsigned xb_ld(unsigned* p)              { return __hip_atomic_load(p, __ATOMIC_RELAXED, __HIP_MEMORY_SCOPE_AGENT); }
__device__ __forceinline__ unsigned xb_add(unsigned* p, unsigned v) { return __hip_atomic_fetch_add(p, v, __ATOMIC_RELAXED, __HIP_MEMORY_SCOPE_AGENT); }
__device__ __forceinline__ unsigned xb_xcc_id() { return (unsigned)__builtin_amdgcn_s_getreg((3 << 11) | 20) & 0xFu; }
#define XB_SPIN(cond, bar) do { unsigned _sp = 0; while (cond) { __builtin_amdgcn_s_sleep(1); \
    if ((++_sp & 255u) == 0u) { if (xb_ld(&(bar)[XB_TMO])) break; if (_sp > XB_SPIN_CAP) { atomicAdd(&(bar)[XB_TMO], 1u); break; } } } } while (0)

struct XcdBarrier { unsigned* bar; unsigned x; volatile LAS unsigned* st; };

__device__ __forceinline__ XcdBarrier xcd_barrier_post(unsigned* bar, volatile LAS unsigned* st) {
    XcdBarrier b; b.bar = bar; b.x = xb_xcc_id(); b.st = st;
    if (threadIdx.x == 0) (void)xb_add(&bar[XB_XCNT(b.x)], 1u);
    return b;
}
__device__ __forceinline__ void xcd_barrier_complete(unsigned* bar, unsigned x, unsigned& nloc, unsigned& nx) {
    const unsigned G = gridDim.x * gridDim.y * gridDim.z;
    unsigned sum, cnt, mine, sp = 0u;
    for (;;) {
        sum = 0u; cnt = 0u; mine = 0u;
#pragma unroll
        for (unsigned j = 0; j < 16; ++j) { const unsigned c = xb_ld(&bar[XB_XCNT(j)]); sum += c; cnt += (c > 0u) ? 1u : 0u; mine = (j == x) ? c : mine; }
        if (sum == G) break;
        __builtin_amdgcn_s_sleep(1);
        if ((++sp & 255u) == 0u) { if (xb_ld(&bar[XB_TMO])) break; if (sp > XB_SPIN_CAP) { atomicAdd(&bar[XB_TMO], 1u); break; } }
    }
    nloc = mine > 0u ? mine : 1u; nx = cnt > 0u ? cnt : 1u;
}
__device__ __forceinline__ void xcd_barrier(const XcdBarrier& b) {
    asm volatile("s_waitcnt vmcnt(0)" ::: "memory");
    __syncthreads();
    if (threadIdx.x == 0) {
        unsigned* bar = b.bar;
        __builtin_amdgcn_s_waitcnt(0);
        unsigned nloc = b.st[0], nx = b.st[1];
        if (nloc == 0u) { xcd_barrier_complete(bar, b.x, nloc, nx); b.st[0] = nloc; b.st[1] = nx; }
        const unsigned old = xb_add(&bar[XB_XSUB(b.x)], 1u);
        const unsigned gen = old / nloc;
        if (old + 1u == (gen + 1u) * nloc) {
            __builtin_amdgcn_fence(__ATOMIC_RELEASE, "agent");
            asm volatile("s_waitcnt vmcnt(0)" ::: "memory");
            const unsigned og = xb_add(&bar[XB_TOP], 1u);
            const unsigned tg = og / nx;
            if (og + 1u == (tg + 1u) * nx) xb_add(&bar[XB_TOPGEN], 1u);
            else XB_SPIN(xb_ld(&bar[XB_TOPGEN]) == tg, bar);
            __builtin_amdgcn_fence(__ATOMIC_ACQUIRE, "agent");
            xb_add(&bar[XB_XGEN(b.x)], 1u);
            asm volatile("s_waitcnt vmcnt(0)" ::: "memory");
        } else {
            XB_SPIN(xb_ld(&bar[XB_XGEN(b.x)]) == gen, bar);
            __builtin_amdgcn_fence(__ATOMIC_ACQUIRE, "agent");
            asm volatile("s_waitcnt vmcnt(0)" ::: "memory");
        }
    }
    __syncthreads();
}

struct Params {
    const float *x, *mem, *w_in, *b_in, *conv_w, *mh_norm_w, *w_mem_kv, *w_proj_m, *w_proj_c, *w_proj_x, *w_out, *ln_w, *ln_b;
    float* out; unsigned char* ws;
    int ph_lo, ph_hi;
};

__device__ __forceinline__ void transpose_item_pk(const float* src, size_t src_ld, int col0, int ncv, unsigned char* img, int ktiles, int n0, int k0, LAS unsigned* scr, int lane, int kdst_off = 0) {
    const float* sp = src + (size_t)k0 * src_ld + col0 + lane;
    if (ncv > 0) {
        float a[32], b[32];
#pragma unroll
        for (int i = 0; i < 32; ++i) { a[i] = 0.f; b[i] = 0.f; if (lane < ncv) { a[i] = __builtin_nontemporal_load(sp + (size_t)(2 * i) * src_ld); b[i] = __builtin_nontemporal_load(sp + (size_t)(2 * i + 1) * src_ld); } }
#pragma unroll
        for (int i = 0; i < 32; ++i) scr[i * 66 + lane] = cvt_pk_bf16_asm(a[i], b[i]);
    } else {
#pragma unroll 8
        for (int i = 0; i < 32; ++i) scr[i * 66 + lane] = 0u;
    }
    LDS_WAIT(); asm volatile("" ::: "memory");
    const int rr = lane >> 2, ch = lane & 3;
    unsigned char* blk = img + ((size_t)(2 * (n0 >> 8)) * ktiles + ((k0 + kdst_off) >> 6)) * PKB;
    const int wcs = (n0 >> 6) & 3;
#pragma unroll
    for (int sub = 0; sub < 8; ++sub) {
        const int grp = sub >> 2, np = (sub >> 1) & 1, k32 = sub & 1;
        const int nl = 32 * grp + 8 * (rr >> 2) + 4 * np + (rr & 3);
        const LAS unsigned* s = scr + (16 * k32 + 4 * ch) * 66 + nl;
        u32x4 o; o.x = s[0]; o.y = s[66]; o.z = s[132]; o.w = s[198];
        const int rho = 32 * wcs + 16 * np + rr;
        *(u32x4*)(blk + (size_t)grp * ktiles * PKB + pg8::lds_byte(rho, 32 * k32 + 8 * ch)) = o;
    }
    LDS_WAIT(); asm volatile("" ::: "memory");
}
__device__ __forceinline__ void cvt_item_pk(const float* src, unsigned char* img, int item, int lane) {
    const int rg = item >> 5, cg4 = item & 31, rr = lane >> 2, ch = lane & 3, row = rg * 16 + rr;
    f32x4 a[4], b[4];
#pragma unroll
    for (int q = 0; q < 4; ++q) { const int col = (cg4 * 4 + q) * 32 + 8 * ch;
        a[q] = __builtin_nontemporal_load((const f32x4*)(src + (size_t)row * 4096 + col)); b[q] = __builtin_nontemporal_load((const f32x4*)(src + (size_t)row * 4096 + col + 4)); }
#pragma unroll
    for (int q = 0; q < 4; ++q) { const int col = (cg4 * 4 + q) * 32 + 8 * ch;
        u32x4 o; o.x = cvt_pk_bf16_asm(a[q][0], a[q][1]); o.y = cvt_pk_bf16_asm(a[q][2], a[q][3]); o.z = cvt_pk_bf16_asm(b[q][0], b[q][1]); o.w = cvt_pk_bf16_asm(b[q][2], b[q][3]);
        *(u32x4*)(img + pk_off(row, col, 64)) = o; }
}
__device__ __forceinline__ void p0_prologue(const Params& p, LAS unsigned char* lds, int gw, int NGW, int wave, int lane) {
    LAS unsigned* scr = (LAS unsigned*)(lds + wave * 8448);
    unsigned char* ws = p.ws;
    constexpr int I_IN = 64 * 644, I_KV = 64 * 64, I_PM = 64 * 64, I_PC = 32 * 64, I_PX = 32 * 64, I_O = 64 * 64;
    constexpr int NITEMS = I_IN + I_KV + I_PM + I_PC + I_PX + I_O;
    for (int it = gw; it < NITEMS; it += NGW) {
        int r = it;
        if (r < I_IN) { const int kb = r / 644, nb = r % 644, n0 = nb * 64; int col0, ncv;
            if (n0 < 16384) { col0 = n0; ncv = 64; } else if (n0 < 40960) { col0 = n0 + 16; ncv = 64; } else if (n0 == 40960) { col0 = 16384; ncv = 16; } else { col0 = 0; ncv = 0; }
            transpose_item_pk(p.w_in, DIN, col0, ncv, ws + WS_WINT, 64, n0, kb * 64, scr, lane); continue; }
        r -= I_IN;
        if (r < I_KV) { transpose_item_pk(p.w_mem_kv, 4096, (r % 64) * 64, 64, ws + WS_WKVT, 64, (r % 64) * 64, (r / 64) * 64, scr, lane); continue; }
        r -= I_KV;
        if (r < I_PM) { transpose_item_pk(p.w_proj_m, 4096, (r % 64) * 64, 64, ws + WS_WPMT, 64, (r % 64) * 64, (r / 64) * 64, scr, lane); continue; }
        r -= I_PM;
        if (r < I_PC) { transpose_item_pk(p.w_proj_c, 4096, (r % 64) * 64, 64, ws + WS_WPCXT, 64, (r % 64) * 64, (r / 64) * 64, scr, lane); continue; }
        r -= I_PC;
        if (r < I_PX) { transpose_item_pk(p.w_proj_x, 4096, (r % 64) * 64, 64, ws + WS_WPCXT, 64, (r % 64) * 64, (r / 64) * 64, scr, lane, 2048); continue; }
        r -= I_PX;
        transpose_item_pk(p.w_out, 4096, (r % 64) * 64, 64, ws + WS_WOT, 64, (r % 64) * 64, (r / 64) * 64, scr, lane);
    }
    for (int it = gw; it < (T / 16) * 32; it += NGW) cvt_item_pk(p.x, ws + WS_XB, it, lane);
    for (int it = gw; it < (TM / 16) * 32; it += NGW) cvt_item_pk(p.mem, ws + WS_MEMB, it, lane);
    float* BU = (float*)(ws + WS_BU);
    for (int c = gw * 64 + lane; c < NU; c += NGW * 64) {
        float v = 0.f;
        if (c < 16384) v = p.b_in[c]; else if (c < 40960) v = p.b_in[c + 16]; else if (c < 40976) v = p.b_in[16384 + (c - 40960)];
        BU[c] = v;
    }
}

__device__ __forceinline__ int act_of(int c0) {
    if (c0 >= UXZ && c0 < UG) return 2;
    if (c0 >= UG && c0 < UI) return 1;
    return 0;
}
struct SchedP1 {
    int G, c; unsigned xb, memb, wint, wkvt;
    __device__ __forceinline__ bool next(int i, Unit& u) const {
        long L = (long)i * G + c;
        if (L < 5152) { pg8::tile_map(L, 32, 161, u.pm, u.pn); u.A = xb + (unsigned)u.pm * (unsigned)(128 * PKB); u.B = wint + (unsigned)u.pn * (unsigned)(128 * PKB); u.nt = 64; u.kind = 0; return true; }
        L -= 5152;
        if (L < 64) { u.pm = (int)L / 16; u.pn = (int)L % 16; u.A = memb + (unsigned)u.pm * (unsigned)(128 * PKB); u.B = wkvt + (unsigned)u.pn * (unsigned)(128 * PKB); u.nt = 64; u.kind = 1; return true; }
        return false;
    }
};
struct EpiP1 {
    static constexpr bool PERM = true, KEEP = false;
    bf16_t* U; const float* bU; bf16_t* KMEM; bf16_t* VT; LAS unsigned char* lds; bf16_t* GB;
    __device__ __forceinline__ void operator()(f32x4 (&acc)[2][2][4][2], const Unit& u, int wr, int wc, int fr, int fq) const {
        asm volatile("" : "+v"(fr), "+v"(fq));
#if defined(MK_PROBE_EPI_OFF)
        if (u.kind != 77) return;
#endif
        const int row0 = wr * 64 + fr, col0 = wc * 64 + 8 * fq;
        if (u.kind == 1 && u.pn >= 8) {
            bf16_t* vb = VT + (size_t)((u.pn - 8) * 256 + col0) * 1024 + u.pm * 256 + row0;
#pragma unroll
            for (int ai = 0; ai < 2; ++ai)
#pragma unroll
                for (int m = 0; m < 4; ++m)
#pragma unroll
                    for (int bj = 0; bj < 2; ++bj)
#pragma unroll
                        for (int n = 0; n < 2; ++n)
#pragma unroll
                            for (int j = 0; j < 4; j += 2) { const unsigned w = cvt_pk_bf16(acc[ai][bj][m][n][j], acc[ai][bj][m][n][j + 1]);
                                bf16_t* q = vb + (size_t)(bj * 32 + 4 * n + j) * 1024 + ai * 128 + m * 16;
                                q[0] = (bf16_t)(w & 0xffffu); q[1024] = (bf16_t)(w >> 16); }
            return;
        }
        bf16_t* base; int ldc; const float* bias; int act = 0; float sc = 1.f;
        if (u.kind == 0) { const int c0 = u.pn * 256; base = U + (size_t)u.pm * 256 * NU + c0; ldc = NU; bias = bU + c0; act = act_of(c0); if (c0 < UK) sc = 0.0625f;
            if (c0 >= UG && c0 < UI) { base = GB + ((size_t)((c0 - UG) >> 8) * T + (size_t)u.pm * 256) * 256; ldc = 256; } }
        else { base = KMEM + (size_t)u.pm * 256 * 2048 + u.pn * 256; ldc = 2048; bias = nullptr; }
        f32x4 bv[2][2];
#pragma unroll
        for (int bj = 0; bj < 2; ++bj)
#pragma unroll
            for (int n = 0; n < 2; ++n) bv[bj][n] = bias ? *(const f32x4*)(bias + col0 + bj * 32 + 4 * n) : (f32x4){0.f, 0.f, 0.f, 0.f};
        const int wid = wr * 4 + wc, lane = fr + 16 * fq;
        LAS unsigned char* stg = lds + EPI_OFF + wid * EPI_WAVE_BYTES;
        LAS unsigned char* wp = stg + fr * 144 + fq * 16;
        const LAS unsigned char* rp = stg + (lane >> 3) * 144 + (lane & 7) * 16;
        bf16_t* gp = base + (size_t)(wr * 64 + (lane >> 3)) * ldc + wc * 64 + (lane & 7) * 8;
#pragma unroll
        for (int ai = 0; ai < 2; ++ai)
#pragma unroll
            for (int m = 0; m < 4; ++m) {
#pragma unroll
                for (int bj = 0; bj < 2; ++bj) { f32x4 v0 = acc[ai][bj][m][0] + bv[bj][0], v1 = acc[ai][bj][m][1] + bv[bj][1];
                    if (act) {
#pragma unroll
                        for (int j = 0; j < 4; ++j) { const float s0 = sigmoidf_(v0[j]), s1 = sigmoidf_(v1[j]); v0[j] = (act == 1) ? s0 : v0[j] * s0; v1[j] = (act == 1) ? s1 : v1[j] * s1; } }
                    v0 = v0 * sc; v1 = v1 * sc;
                    u32x4 w; w.x = cvt_pk_bf16(v0[0], v0[1]); w.y = cvt_pk_bf16(v0[2], v0[3]); w.z = cvt_pk_bf16(v1[0], v1[1]); w.w = cvt_pk_bf16(v1[2], v1[3]);
                    *(LAS u32x4*)(wp + bj * 64) = w; }
                asm volatile("" ::: "memory");
                const u32x4 o0 = *(const LAS u32x4*)rp, o1 = *(const LAS u32x4*)(rp + 8 * 144);
                asm volatile("" ::: "memory");
                bf16_t* g0 = gp + (size_t)(ai * 128 + m * 16) * ldc;
                __builtin_nontemporal_store(o0, (u32x4*)g0); __builtin_nontemporal_store(o1, (u32x4*)(g0 + (size_t)8 * ldc)); }
    }
};
struct SchedQK {
    int G, c; unsigned u, kmem;
    __device__ __forceinline__ bool next(int i, Unit& un) const {
        const int L = i * G + c; if (L >= 128) return false;
        const int head = L & 3, rt = L >> 2;
        un.pm = rt; un.pn = head; un.A = u + (unsigned)(((size_t)rt * 256 * NU + UXQ + head * 512) * 2); un.B = kmem + (unsigned)(((size_t)(rt >> 3) * 256 * 2048 + head * 512) * 2); un.nt = 8; un.kind = 0; return true;
    }
};
struct EpiSoftmax {
    static constexpr bool PERM = false, KEEP = false;
    bf16_t* PB; LAS unsigned char* lds;
    __device__ __forceinline__ void operator()(f32x4 (&acc)[2][2][4][2], const Unit& u, int wr, int wc, int fr, int fq) const {
        asm volatile("" : "+v"(fr), "+v"(fq));
        const float sc = 0.04419417382415922f * 1.4426950408889634f;
        LAS float* MX = (LAS float*)(lds + EPI_OFF);
        LAS float* SX = MX + 1024;
        float mrow[2][4];
#pragma unroll
        for (int ai = 0; ai < 2; ++ai)
#pragma unroll
            for (int m = 0; m < 4; ++m) { float mx = -3.0e38f;
#pragma unroll
                for (int bj = 0; bj < 2; ++bj)
#pragma unroll
                    for (int n = 0; n < 2; ++n) { acc[ai][bj][m][n] = acc[ai][bj][m][n] * sc; const f32x4 v = acc[ai][bj][m][n]; mx = fmaxf(mx, fmaxf(fmaxf(v[0], v[1]), fmaxf(v[2], v[3]))); }
                mx = fmaxf(mx, __shfl_xor(mx, 16)); mx = fmaxf(mx, __shfl_xor(mx, 32));
                if (fq == 0) MX[(ai * 128 + wr * 64 + m * 16 + fr) * 4 + wc] = mx; }
        asm volatile("s_waitcnt lgkmcnt(0)" ::: "memory"); __builtin_amdgcn_s_barrier(); asm volatile("" ::: "memory");
#pragma unroll
        for (int ai = 0; ai < 2; ++ai)
#pragma unroll
            for (int m = 0; m < 4; ++m) { const f32x4 q = *(const LAS f32x4*)(MX + (ai * 128 + wr * 64 + m * 16 + fr) * 4);
                const float mx = fmaxf(fmaxf(q[0], q[1]), fmaxf(q[2], q[3])); mrow[ai][m] = mx; float s = 0.f;
#pragma unroll
                for (int bj = 0; bj < 2; ++bj)
#pragma unroll
                    for (int n = 0; n < 2; ++n) { f32x4 v = acc[ai][bj][m][n];
#pragma unroll
                        for (int j = 0; j < 4; ++j) { v[j] = __builtin_amdgcn_exp2f(v[j] - mx); s += v[j]; }
                        acc[ai][bj][m][n] = v; }
                s += __shfl_xor(s, 16); s += __shfl_xor(s, 32);
                if (fq == 0) SX[(ai * 128 + wr * 64 + m * 16 + fr) * 4 + wc] = s; }
        asm volatile("s_waitcnt lgkmcnt(0)" ::: "memory"); __builtin_amdgcn_s_barrier(); asm volatile("" ::: "memory");
        bf16_t* base = PB + (size_t)u.pm * 256 * 1024 + u.pn * 256;
        const int row0 = wr * 64 + fr, col0 = wc * 32 + 4 * fq;
#pragma unroll
        for (int ai = 0; ai < 2; ++ai)
#pragma unroll
            for (int m = 0; m < 4; ++m) { const f32x4 q = *(const LAS f32x4*)(SX + (ai * 128 + wr * 64 + m * 16 + fr) * 4);
                const float inv = 1.0f / ((q[0] + q[1]) + (q[2] + q[3]));
                bf16_t* rowp = base + (size_t)(row0 + ai * 128 + m * 16) * 1024 + col0;
#pragma unroll
                for (int bj = 0; bj < 2; ++bj)
#pragma unroll
                    for (int n = 0; n < 2; ++n) { const f32x4 v = acc[ai][bj][m][n] * inv; u32x2 w; w.x = cvt_pk_bf16(v[0], v[1]); w.y = cvt_pk_bf16(v[2], v[3]);
                        *(u32x2*)(rowp + bj * 128 + n * 16) = w; } }
        (void)mrow;
    }
};
struct SchedPV {
    int G, c; unsigned pb, vt;
    __device__ __forceinline__ bool next(int i, Unit& un) const {
        if (i >= 2 || c >= 128) return false;
        const int L = c * 2 + i;
        const int n2 = L & 1, head = (L >> 1) & 3, rt = L >> 3;
        un.pm = rt; un.pn = head * 2 + n2; un.A = pb + (unsigned)(((size_t)rt * 256 * 1024 + head * 256) * 2); un.B = vt + (unsigned)(((size_t)(head * 512 + n2 * 256) * 1024 + (rt >> 3) * 256) * 2); un.nt = 4; un.kind = 0; return true;
    }
};
struct EpiPV {
    static constexpr bool PERM = true, KEEP = false;
    const bf16_t* U; bf16_t* YCX;
    __device__ __forceinline__ void operator()(f32x4 (&acc)[2][2][4][2], const Unit& u, int wr, int wc, int fr, int fq) const {
        asm volatile("" : "+v"(fr), "+v"(fq));
        const bf16_t* zb = U + (size_t)u.pm * 256 * NU + UXZ + u.pn * 256;
        const int row0 = wr * 64 + fr, col0 = wc * 32 + 8 * fq;
        const unsigned lane_off = (unsigned)((fr * 64 + fq * 16) ^ (((fr >> 3) & 1) << 5));
        unsigned char* ob = (unsigned char*)YCX + (size_t)(32 + 4 * u.pn + (wc >> 1)) * PKB + (wc & 1) * 1024 + lane_off;
#pragma unroll
        for (int ai = 0; ai < 2; ++ai)
#pragma unroll
            for (int m = 0; m < 4; ++m) { const size_t r = (size_t)(row0 + ai * 128 + m * 16);
#pragma unroll
                for (int bj = 0; bj < 2; ++bj) { const u32x4 z = *(const u32x4*)(zb + r * NU + col0 + bj * 128);
                    const f32x4 v0 = acc[ai][bj][m][0], v1 = acc[ai][bj][m][1];
                    u32x4 w; w.x = cvt_pk_bf16(v0[0] * bf_lo(z.x), v0[1] * bf_hi(z.x)); w.y = cvt_pk_bf16(v0[2] * bf_lo(z.y), v0[3] * bf_hi(z.y));
                    w.z = cvt_pk_bf16(v1[0] * bf_lo(z.z), v1[1] * bf_hi(z.z)); w.w = cvt_pk_bf16(v1[2] * bf_lo(z.w), v1[3] * bf_hi(z.w));
                    *(u32x4*)(ob + ((size_t)(2 * u.pm + ai) * 64 + 2 * bj) * PKB + (size_t)((4 * wr + m) * 2) * 1024) = w; }
                asm volatile("" ::: "memory"); }
    }
};
struct SchedMerge {
    int G, c; unsigned ym, ycx, wpmt, wpcxt;
    __device__ __forceinline__ bool next(int i, Unit& u) const {
        const int r = i / 3, br = i - 3 * r;
        if (!pg8::tile_map((long)r * G + c, 32, 16, u.pm, u.pn)) return false;
        u.kind = br;
        if (br == 0) { u.A = ym + (unsigned)u.pm * (unsigned)(128 * PKB); u.B = wpmt + (unsigned)u.pn * (unsigned)(128 * PKB); u.nt = 64; }
        else { u.A = ycx + (unsigned)u.pm * (unsigned)(128 * PKB) + (br == 2 ? (unsigned)(32 * PKB) : 0u); u.B = wpcxt + (unsigned)u.pn * (unsigned)(128 * PKB) + (br == 2 ? (unsigned)(32 * PKB) : 0u); u.nt = 32; }
        return true;
    }
};
struct EpiMerge {
    static constexpr bool PERM = true, KEEP = true;
    const bf16_t* GBk; unsigned char* MERGED;
    __device__ __forceinline__ void operator()(f32x4 (&acc)[2][2][4][2], const Unit& u, int wr, int wc, int fr, int fq) const {
        asm volatile("" : "+v"(fr), "+v"(fq));
        const int br = u.kind;
        const bf16_t* gb = GBk + ((size_t)(br * 16 + u.pn) * T + (size_t)u.pm * 256) * 256;
        const int row0 = wr * 64 + fr, col0 = wc * 64 + 8 * fq;
        unsigned char* mb = MERGED + (size_t)(4 * u.pn + wc) * PKB + (unsigned)((fr * 64 + fq * 16) ^ (((fr >> 3) & 1) << 5));
        const float tiny = 1e-30f;
#pragma unroll
        for (int ai = 0; ai < 2; ++ai)
#pragma unroll
            for (int m = 0; m < 4; ++m) { const size_t r = (size_t)(row0 + ai * 128 + m * 16);
#pragma unroll
                for (int bj = 0; bj < 2; ++bj) { const int cc = col0 + bj * 32;
                    const u32x4 g = *(const u32x4*)(gb + r * 256 + cc);
                    float f[8] = {bf_lo(g.x), bf_hi(g.x), bf_lo(g.y), bf_hi(g.y), bf_lo(g.z), bf_hi(g.z), bf_lo(g.w), bf_hi(g.w)};
                    if (br != 0) {
#pragma unroll
                        for (int j = 0; j < 8; ++j) f[j] = fmaxf(f[j], tiny); }
                    if (br != 2) { const u32x4 g2 = *(const u32x4*)(gb + (size_t)16 * T * 256 + r * 256 + cc);
                        const float d[8] = {bf_lo(g2.x), bf_hi(g2.x), bf_lo(g2.y), bf_hi(g2.y), bf_lo(g2.z), bf_hi(g2.z), bf_lo(g2.w), bf_hi(g2.w)};
#pragma unroll
                        for (int j = 0; j < 8; ++j) f[j] = f[j] * __builtin_amdgcn_rcpf(fmaxf(d[j], tiny)); }
                    f32x4 v0 = acc[ai][bj][m][0], v1 = acc[ai][bj][m][1];
                    v0[0] *= f[0]; v0[1] *= f[1]; v0[2] *= f[2]; v0[3] *= f[3]; v1[0] *= f[4]; v1[1] *= f[5]; v1[2] *= f[6]; v1[3] *= f[7];
                    if (br != 2) { acc[ai][bj][m][0] = v0; acc[ai][bj][m][1] = v1; }
                    else { u32x4 w; w.x = cvt_pk_bf16(v0[0], v0[1]); w.y = cvt_pk_bf16(v0[2], v0[3]); w.z = cvt_pk_bf16(v1[0], v1[1]); w.w = cvt_pk_bf16(v1[2], v1[3]);
                        *(u32x4*)(mb + ((size_t)(2 * u.pm + ai) * 64) * PKB + (size_t)((4 * wr + m) * 2 + bj) * 1024) = w; } }
                asm volatile("" ::: "memory"); }
    }
};
struct SchedOut {
    int G, c; unsigned merged, wot;
    __device__ __forceinline__ bool next(int i, Unit& u) const {
        if (!pg8::tile_map((long)i * G + c, 32, 16, u.pm, u.pn)) return false;
        u.A = merged + (unsigned)u.pm * (unsigned)(128 * PKB); u.B = wot + (unsigned)u.pn * (unsigned)(128 * PKB); u.nt = 64; u.kind = 0; return true;
    }
};
struct EpiOut {
    static constexpr bool PERM = true, KEEP = false;
    const float* x; float* out;
    __device__ __forceinline__ void operator()(f32x4 (&acc)[2][2][4][2], const Unit& u, int wr, int wc, int fr, int fq) const {
        asm volatile("" : "+v"(fr), "+v"(fq));
        const size_t ob = (size_t)u.pm * 256 * 4096 + u.pn * 256;
        const int row0 = wr * 64 + fr, col0 = wc * 64 + 8 * fq;
#pragma unroll
        for (int ai = 0; ai < 2; ++ai)
#pragma unroll
            for (int m = 0; m < 4; ++m) { const size_t r = (size_t)(row0 + ai * 128 + m * 16);
#pragma unroll
                for (int bj = 0; bj < 2; ++bj)
#pragma unroll
                    for (int n = 0; n < 2; ++n) { const size_t o = ob + r * 4096 + col0 + bj * 32 + n * 4;
                        const f32x4 xv = *(const f32x4*)(x + o);
                        *(f32x4*)(out + o) = xv * DN_ALPHA + acc[ai][bj][m][n]; }
                asm volatile("" ::: "memory"); }
    }
};

__device__ __forceinline__ void conv_phase(const Params& p, int gtid, int NGT, int idx_lo, int idx_hi) {
    const bf16_t* U = (const bf16_t*)(p.ws + WS_U); bf16_t* YCX = (bf16_t*)(p.ws + WS_YCX);
    for (int idx = idx_lo + gtid; idx < idx_hi; idx += NGT) {
        const int t0 = (idx >> 8) * 16, c = (idx & 255) * 8;
        const bf16_t* row0 = U + (size_t)t0 * NU;
        const f32x4 wa0 = *(const f32x4*)(p.conv_w + c), wa1 = *(const f32x4*)(p.conv_w + c + 4);
        const f32x4 wb0 = *(const f32x4*)(p.conv_w + 2048 + c), wb1 = *(const f32x4*)(p.conv_w + 2048 + c + 4);
        const f32x4 wc0 = *(const f32x4*)(p.conv_w + 4096 + c), wc1 = *(const f32x4*)(p.conv_w + 4096 + c + 4);
        const float w0[8] = {wa0[0], wa0[1], wa0[2], wa0[3], wa1[0], wa1[1], wa1[2], wa1[3]};
        const float w1[8] = {wb0[0], wb0[1], wb0[2], wb0[3], wb1[0], wb1[1], wb1[2], wb1[3]};
        const float w2[8] = {wc0[0], wc0[1], wc0[2], wc0[3], wc1[0], wc1[1], wc1[2], wc1[3]};
        float pm2[8], pm1[8];
        if ((t0 & (SEQ - 1)) != 0) {
            const u32x4 a2 = *(const u32x4*)(row0 - (size_t)2 * NU + UCC + c), b2 = *(const u32x4*)(row0 - (size_t)2 * NU + UCX + c);
            const u32x4 a1 = *(const u32x4*)(row0 - (size_t)1 * NU + UCC + c), b1 = *(const u32x4*)(row0 - (size_t)1 * NU + UCX + c);
            const unsigned a2w[4] = {a2.x, a2.y, a2.z, a2.w}, b2w[4] = {b2.x, b2.y, b2.z, b2.w}, a1w[4] = {a1.x, a1.y, a1.z, a1.w}, b1w[4] = {b1.x, b1.y, b1.z, b1.w};
#pragma unroll
            for (int j = 0; j < 4; ++j) { pm2[2 * j] = bf_lo(a2w[j]) * bf_lo(b2w[j]); pm2[2 * j + 1] = bf_hi(a2w[j]) * bf_hi(b2w[j]); pm1[2 * j] = bf_lo(a1w[j]) * bf_lo(b1w[j]); pm1[2 * j + 1] = bf_hi(a1w[j]) * bf_hi(b1w[j]); }
        } else {
#pragma unroll
            for (int j = 0; j < 8; ++j) { pm2[j] = 0.f; pm1[j] = 0.f; }
        }
#pragma unroll 1
        for (int tq = 0; tq < 16; tq += 4) {
            u32x4 cb[4], cc[4], cx[4], cz[4];
#pragma unroll
            for (int q = 0; q < 4; ++q) { const bf16_t* row = row0 + (size_t)(tq + q) * NU;
                cb[q] = *(const u32x4*)(row + UCB + c); cc[q] = *(const u32x4*)(row + UCC + c); cx[q] = *(const u32x4*)(row + UCX + c); cz[q] = *(const u32x4*)(row + UCZ + c); }
#pragma unroll
            for (int q = 0; q < 4; ++q) {
                const unsigned cbw[4] = {cb[q].x, cb[q].y, cb[q].z, cb[q].w}, ccw[4] = {cc[q].x, cc[q].y, cc[q].z, cc[q].w}, cxw[4] = {cx[q].x, cx[q].y, cx[q].z, cx[q].w}, czw[4] = {cz[q].x, cz[q].y, cz[q].z, cz[q].w};
                float pc[8], o[8];
#pragma unroll
                for (int j = 0; j < 4; ++j) { pc[2 * j] = bf_lo(ccw[j]) * bf_lo(cxw[j]); pc[2 * j + 1] = bf_hi(ccw[j]) * bf_hi(cxw[j]); }
#pragma unroll
                for (int j = 0; j < 8; ++j) { o[j] = (w0[j] * pm2[j] + w1[j] * pm1[j]) + w2[j] * pc[j]; pm2[j] = pm1[j]; pm1[j] = pc[j]; }
                u32x4 ov; unsigned ow[4];
#pragma unroll
                for (int j = 0; j < 4; ++j) { const float z0 = bf_lo(czw[j]), z1 = bf_hi(czw[j]);
                    ow[j] = cvt_pk_bf16(bf_lo(cbw[j]) * o[2 * j] * (z0 * sigmoidf_(z0)), bf_hi(cbw[j]) * o[2 * j + 1] * (z1 * sigmoidf_(z1))); }
                ov.x = ow[0]; ov.y = ow[1]; ov.z = ow[2]; ov.w = ow[3];
                *(u32x4*)((unsigned char*)YCX + pk_off(t0 + tq + q, c, 64)) = ov;
            }
        }
    }
}
__device__ __forceinline__ void softmax_unit(const Params& p, int rt, int head, int wave, int lane) {
    const float* SC = (const float*)(p.ws + WS_SC); bf16_t* PB = (bf16_t*)(p.ws + WS_PB);
    for (int r = wave; r < 256; r += NWAVES) {
        const int it = (rt * 256 + r) * 4 + head;
        const f32x4 s = *(const f32x4*)(SC + (size_t)it * 256 + 4 * lane);
        const float mx = wave_max(fmaxf(fmaxf(s[0], s[1]), fmaxf(s[2], s[3])));
        const float e0 = __expf(s[0] - mx), e1 = __expf(s[1] - mx), e2 = __expf(s[2] - mx), e3 = __expf(s[3] - mx);
        const float inv = 1.0f / wave_sum((e0 + e1) + (e2 + e3));
        u32x2 o; o.x = cvt_pk_bf16(e0 * inv, e1 * inv); o.y = cvt_pk_bf16(e2 * inv, e3 * inv);
        *(u32x2*)(PB + (size_t)it * 256 + 4 * lane) = o;
    }
}
__device__ __forceinline__ void ym_phase(const Params& p, int gw, int NGW, int lane) {
    const bf16_t* U = (const bf16_t*)(p.ws + WS_U); const bf16_t* HR = (const bf16_t*)(p.ws + WS_HRAW); bf16_t* YM = (bf16_t*)(p.ws + WS_YM);
    for (int it0 = gw * 2; it0 < T * 8; it0 += NGW * 2) {
        u32x4 hv[2], mo[2], mz[2];
#pragma unroll
        for (int q = 0; q < 2; ++q) { const int it = it0 + q, t = it >> 3, c = (it & 7) * 512 + 8 * lane;
            hv[q] = *(const u32x4*)(HR + (size_t)t * 4096 + c); mo[q] = *(const u32x4*)(U + (size_t)t * NU + UO + c); mz[q] = *(const u32x4*)(U + (size_t)t * NU + UZ + c); }
#pragma unroll
        for (int q = 0; q < 2; ++q) { const int it = it0 + q, t = it >> 3, c = (it & 7) * 512 + 8 * lane;
            const f32x4 w0 = *(const f32x4*)(p.mh_norm_w + c), w1 = *(const f32x4*)(p.mh_norm_w + c + 4);
            float v[8] = {bf_lo(hv[q].x), bf_hi(hv[q].x), bf_lo(hv[q].y), bf_hi(hv[q].y), bf_lo(hv[q].z), bf_hi(hv[q].z), bf_lo(hv[q].w), bf_hi(hv[q].w)};
            float s = 0.f;
#pragma unroll
            for (int j = 0; j < 8; ++j) s += v[j];
            const float mean = wave_sum(s) * (1.0f / 512.0f);
            float qq = 0.f;
#pragma unroll
            for (int j = 0; j < 8; ++j) { v[j] -= mean; qq += v[j] * v[j]; }
            const float rstd = 1.0f / sqrtf(wave_sum(qq) * (1.0f / 512.0f) + LN_EPS);
            const float ov[8] = {bf_lo(mo[q].x), bf_hi(mo[q].x), bf_lo(mo[q].y), bf_hi(mo[q].y), bf_lo(mo[q].z), bf_hi(mo[q].z), bf_lo(mo[q].w), bf_hi(mo[q].w)};
            const float zv[8] = {bf_lo(mz[q].x), bf_hi(mz[q].x), bf_lo(mz[q].y), bf_hi(mz[q].y), bf_lo(mz[q].z), bf_hi(mz[q].z), bf_lo(mz[q].w), bf_hi(mz[q].w)};
            const float wv[8] = {w0[0], w0[1], w0[2], w0[3], w1[0], w1[1], w1[2], w1[3]};
            u32x4 o; unsigned ow[4];
#pragma unroll
            for (int j = 0; j < 4; ++j) { const float g0 = sigmoidf_(ov[2 * j]) * (zv[2 * j] * sigmoidf_(zv[2 * j])), g1 = sigmoidf_(ov[2 * j + 1]) * (zv[2 * j + 1] * sigmoidf_(zv[2 * j + 1]));
                ow[j] = cvt_pk_bf16(v[2 * j] * rstd * wv[2 * j] * g0, v[2 * j + 1] * rstd * wv[2 * j + 1] * g1); }
            o.x = ow[0]; o.y = ow[1]; o.z = ow[2]; o.w = ow[3];
            *(u32x4*)((unsigned char*)YM + pk_off(t, c, 64)) = o; }
    }
}
__device__ __forceinline__ void ln_phase(const Params& p, int gw, int NGW, int lane) {
    for (int m = gw; m < T; m += NGW) {
        f32x4* r = (f32x4*)(p.out + (size_t)m * D) + lane;
        f32x4 v[16]; float s = 0.f;
#pragma unroll
        for (int j = 0; j < 16; ++j) { v[j] = r[64 * j]; s += (v[j][0] + v[j][1]) + (v[j][2] + v[j][3]); }
        const float mean = wave_sum(s) * (1.0f / D); float q = 0.f;
#pragma unroll
        for (int j = 0; j < 16; ++j) { v[j] = v[j] - mean; q += (v[j][0] * v[j][0] + v[j][1] * v[j][1]) + (v[j][2] * v[j][2] + v[j][3] * v[j][3]); }
        const float rstd = 1.0f / sqrtf(wave_sum(q) * (1.0f / D) + LN_EPS);
#pragma unroll
        for (int j = 0; j < 16; ++j) { const f32x4 w = *((const f32x4*)p.ln_w + lane + 64 * j), b = *((const f32x4*)p.ln_b + lane + 64 * j); r[64 * j] = v[j] * rstd * w + b; }
    }
}

__device__ __forceinline__ void mlstm_naive(const Params& p, LAS unsigned char* lds, int unit, int wave, int lane) {
    const int s = unit & 7, h = (unit >> 3) & 7, b = unit >> 6;
    LAS float* part = (LAS float*)lds;
    LAS float* pden = part + 2 * 8 * 64;
    const bf16_t* Ub = (const bf16_t*)(p.ws + WS_U) + (size_t)(b * SEQ) * NU;
    bf16_t* HR = (bf16_t*)(p.ws + WS_HRAW) + (size_t)(b * SEQ) * 4096 + h * 512 + s * 64 + lane;
    float C[32], n[32];
#pragma unroll
    for (int d = 0; d < 32; ++d) { C[d] = 0.f; n[d] = 0.f; }
    float m = 0.f;
    for (int t = 0; t < SEQ; ++t) {
        const bf16_t* row = Ub + (size_t)t * NU;
        u32x4 kk[4], qq[4];
#pragma unroll
        for (int j = 0; j < 4; ++j) { kk[j] = *(const u32x4*)(row + UK + h * 256 + wave * 32 + 8 * j); qq[j] = *(const u32x4*)(row + UQ + h * 256 + wave * 32 + 8 * j); }
        const float vv = bf2f(row[UV + h * 512 + s * 64 + lane]);
        const float ig = bf2f(row[UI + h]), fp = bf2f(row[UF + h]);
        const float lf = fminf(fp, 0.f) - log1pf(__expf(-fabsf(fp)));
        const float mn = fmaxf(lf + m, ig), fd = __expf(lf + m - mn), iw = __expf(ig - mn);
        m = mn;
        float num = 0.f, den = 0.f;
#pragma unroll
        for (int j = 0; j < 4; ++j) {
            const unsigned kw[4] = {kk[j].x, kk[j].y, kk[j].z, kk[j].w}, qw[4] = {qq[j].x, qq[j].y, qq[j].z, qq[j].w};
#pragma unroll
            for (int e = 0; e < 4; ++e) {
                const int d = 8 * j + 2 * e;
                const float k0 = iw * bf_lo(kw[e]), k1 = iw * bf_hi(kw[e]), q0 = bf_lo(qw[e]), q1 = bf_hi(qw[e]);
                C[d] = fd * C[d] + k0 * vv; n[d] = fd * n[d] + k0; num += q0 * C[d]; den += q0 * n[d];
                C[d + 1] = fd * C[d + 1] + k1 * vv; n[d + 1] = fd * n[d + 1] + k1; num += q1 * C[d + 1]; den += q1 * n[d + 1];
            }
        }
        const int buf = t & 1;
        part[(buf * 8 + wave) * 64 + lane] = num; if (lane == 0) pden[buf * 8 + wave] = den;
        __syncthreads();
        if (wave == (t & 7)) {
            float nt_ = 0.f, dt_ = 0.f;
#pragma unroll
            for (int w = 0; w < 8; ++w) { nt_ += part[(buf * 8 + w) * 64 + lane]; dt_ += pden[buf * 8 + w]; }
            const float hv = nt_ / fmaxf(fabsf(dt_), __expf(-m));
            HR[(size_t)t * 4096] = (bf16_t)(cvt_pk_bf16(hv, 0.f) & 0xffffu);
        }
    }
    __syncthreads();
}

constexpr int ML_RS = 528, ML_VS = 160;
constexpr int ML_Q = 0, ML_K = 64 * ML_RS, ML_V = 2 * 64 * ML_RS, ML_VSC = ML_V + 64 * ML_VS, ML_CT = ML_VSC + 64 * ML_VS, ML_END = ML_CT + 80 * ML_RS;
static_assert(ML_END <= RING_BYTES, "mLSTM LDS map");
typedef short s16x4 __attribute__((ext_vector_type(4)));
__device__ __forceinline__ bf16x8 tr_pair(const LAS unsigned char* a0, const LAS unsigned char* a1) {
    const s16x4 lo = __builtin_amdgcn_ds_read_tr16_b64_v4i16((LAS s16x4*)a0), hi = __builtin_amdgcn_ds_read_tr16_b64_v4i16((LAS s16x4*)a1);
    return (bf16x8){lo[0], lo[1], lo[2], lo[3], hi[0], hi[1], hi[2], hi[3]};
}
constexpr int ML_TAB_BS = EPI_OFF, ML_TAB_CJ = EPI_OFF + 8192, ML_TAB_CM = EPI_OFF + 16384, ML_TAB_MST = EPI_OFF + 24576;
static_assert(ML_TAB_MST + 256 <= LDS_BYTES, "mLSTM gate tables");
__device__ __forceinline__ void mlstm_unit(const Params& p, LAS unsigned char* lds, int unit, int wave, int lane, int tid) {
    const int s = unit & 7, h = (unit >> 3) & 7, b = unit >> 6;
    const int g = lane >> 4, li = lane & 15, q4 = li >> 2, p4 = lane & 3;
    const int tt = wave >> 1, vh = wave & 1;
    const bf16_t* U = (const bf16_t*)(p.ws + WS_U) + (size_t)(b * SEQ) * NU;
    bf16_t* HR = (bf16_t*)(p.ws + WS_HRAW) + (size_t)(b * SEQ) * 4096 + h * 512 + s * 64;
    const int srow = tid >> 5, sch = tid & 31, vrow = tid >> 3, vch = tid & 7;
    LAS float* tBS = (LAS float*)(lds + ML_TAB_BS); LAS float* tCJ = (LAS float*)(lds + ML_TAB_CJ); LAS float* tCM = (LAS float*)(lds + ML_TAB_CM); LAS float* tMST = (LAS float*)(lds + ML_TAB_MST);
    if (tid < 64) {
        *(LAS u32x4*)(lds + ML_V + tid * ML_VS + 128) = (u32x4){0x3F80u, 0u, 0u, 0u}; *(LAS u32x4*)(lds + ML_V + tid * ML_VS + 144) = (u32x4){0u, 0u, 0u, 0u};
        *(LAS u32x4*)(lds + ML_VSC + tid * ML_VS + 128) = (u32x4){0u, 0u, 0u, 0u}; *(LAS u32x4*)(lds + ML_VSC + tid * ML_VS + 144) = (u32x4){0u, 0u, 0u, 0u};
    }
    for (int cc = wave; cc < SEQ / 64; cc += NWAVES) {
        const size_t tok = (size_t)(cc * 64 + lane);
        const float ig = bf2f(U[tok * NU + UI + h]), fp = bf2f(U[tok * NU + UF + h]);
        const float lf = fminf(fp, 0.f) - log1pf(__expf(-fabsf(fp)));
        float bs = lf;
#pragma unroll
        for (int o = 1; o < 64; o <<= 1) { const float t_ = __shfl_up(bs, o); if (lane >= o) bs += t_; }
        const float Cj = ig - bs; float cm = Cj;
#pragma unroll
        for (int o = 1; o < 64; o <<= 1) { const float t_ = __shfl_up(cm, o); if (lane >= o) cm = fmaxf(cm, t_); }
        tBS[cc * 64 + lane] = bs; tCJ[cc * 64 + lane] = Cj; tCM[cc * 64 + lane] = cm;
    }
    __syncthreads();
    if (tid == 0) { float m = 0.f; for (int c = 0; c < SEQ / 64; ++c) { tMST[c] = m; m = tBS[c * 64 + 63] + fmaxf(tCM[c * 64 + 63], m); } }
    f32x4 cacc[2][5];
#pragma unroll
    for (int a = 0; a < 2; ++a)
#pragma unroll
        for (int v = 0; v < 5; ++v) cacc[a][v] = (f32x4){0.f, 0.f, 0.f, 0.f};
    u32x4 rq[4], rk[4], rv;
#define ML_PREFETCH(c) do { const bf16_t* base_ = U + (size_t)((c) * 64) * NU; \
        _Pragma("unroll") for (int i_ = 0; i_ < 4; ++i_) { rq[i_] = *(const u32x4*)(base_ + (size_t)(srow + 16 * i_) * NU + UQ + h * 256 + sch * 8); \
                                                          rk[i_] = *(const u32x4*)(base_ + (size_t)(srow + 16 * i_) * NU + UK + h * 256 + sch * 8); } \
        rv = *(const u32x4*)(base_ + (size_t)vrow * NU + UV + h * 512 + s * 64 + vch * 8); } while (0)
#define ML_SB __builtin_amdgcn_sched_barrier(0)
#define ML_LDK(dst, jt) do { _Pragma("unroll") for (int ks_ = 0; ks_ < 8; ++ks_) dst[ks_] = *(const LAS bf16x8*)(lds + ML_K + (16 * (jt) + li) * ML_RS + g * 16 + ks_ * 64); } while (0)
#define ML_LDC(dst, vt) do { _Pragma("unroll") for (int ks_ = 0; ks_ < 8; ++ks_) dst[ks_] = *(const LAS bf16x8*)(lds + ML_CT + (16 * (vt) + li) * ML_RS + g * 16 + ks_ * 64); } while (0)
#define ML_MMA8(acc, A, B) do { _Pragma("unroll") for (int ks_ = 0; ks_ < 8; ++ks_) acc = __builtin_amdgcn_mfma_f32_16x16x32_bf16(A[ks_], B[ks_], acc, 0, 0, 0); } while (0)
    ML_PREFETCH(0);
    __syncthreads();
    const int tcol = 16 * tt + li;
    for (int c = 0; c < SEQ / 64; ++c) {
        const float mst = tMST[c], M63 = fmaxf(tCM[c * 64 + 63], mst), decay = __expf(mst - M63);
        const float Mt_t = fmaxf(tCM[c * 64 + tcol], mst), inter_t = __expf(mst - Mt_t), emt_t = __expf(-(tBS[c * 64 + tcol] + Mt_t));
#pragma unroll
        for (int a = 0; a < 2; ++a)
#pragma unroll
            for (int v = 0; v < 5; ++v) { u32x2 w; w.x = cvt_pk_bf16(cacc[a][v][0], cacc[a][v][1]); w.y = cvt_pk_bf16(cacc[a][v][2], cacc[a][v][3]);
                *(LAS u32x2*)(lds + ML_CT + (16 * v + li) * ML_RS + (16 * (2 * wave + a) + 4 * g) * 2) = w; }
#pragma unroll
        for (int i = 0; i < 4; ++i) { *(LAS u32x4*)(lds + ML_Q + (srow + 16 * i) * ML_RS + sch * 16) = rq[i]; *(LAS u32x4*)(lds + ML_K + (srow + 16 * i) * ML_RS + sch * 16) = rk[i]; }
        *(LAS u32x4*)(lds + ML_V + vrow * ML_VS + vch * 16) = rv;
        { const float sc = __expf(tCJ[c * 64 + vrow] - M63); u32x4 o;
          o.x = cvt_pk_bf16(bf_lo(rv.x) * sc, bf_hi(rv.x) * sc); o.y = cvt_pk_bf16(bf_lo(rv.y) * sc, bf_hi(rv.y) * sc);
          o.z = cvt_pk_bf16(bf_lo(rv.z) * sc, bf_hi(rv.z) * sc); o.w = cvt_pk_bf16(bf_lo(rv.w) * sc, bf_hi(rv.w) * sc);
          *(LAS u32x4*)(lds + ML_VSC + vrow * ML_VS + vch * 16) = o; }
        if (tid < 64) *(LAS bf16_t*)(lds + ML_VSC + tid * ML_VS + 128) = (bf16_t)(cvt_pk_bf16(__expf(tCJ[c * 64 + tid] - M63), 0.f) & 0xffffu);
        __syncthreads();
        { const int cn = (c + 1 < SEQ / 64) ? c + 1 : c; ML_PREFETCH(cn); }
        bf16x8 Bq[8], A0[8], A1[8]; f32x4 sacc[4], pacc[3], cj4[4];
#pragma unroll
        for (int j = 0; j < 4; ++j) sacc[j] = (f32x4){0.f, 0.f, 0.f, 0.f};
#pragma unroll
        for (int a = 0; a < 3; ++a) pacc[a] = (f32x4){0.f, 0.f, 0.f, 0.f};
#pragma unroll
        for (int ks = 0; ks < 8; ++ks) Bq[ks] = *(const LAS bf16x8*)(lds + ML_Q + tcol * ML_RS + g * 16 + ks * 64);
        ML_LDK(A0, 0); ML_SB;
        ML_LDK(A1, 1); ML_MMA8(sacc[0], A0, Bq); ML_SB;
        ML_LDK(A0, 2); ML_MMA8(sacc[1], A1, Bq); ML_SB;
        ML_LDK(A1, 3); ML_MMA8(sacc[2], A0, Bq); ML_SB;
        ML_LDC(A0, 2 * vh);
#pragma unroll
        for (int jt = 0; jt < 4; ++jt) cj4[jt] = *(const LAS f32x4*)(tCJ + c * 64 + 16 * jt + 4 * g);
        ML_MMA8(sacc[3], A1, Bq); ML_SB;
        ML_LDC(A1, 2 * vh + 1); ML_MMA8(pacc[0], A0, Bq); ML_SB;
        ML_LDC(A0, 4); ML_MMA8(pacc[1], A1, Bq); ML_SB;
        bf16x8 Av[2][3];
#pragma unroll
        for (int ks2 = 0; ks2 < 2; ++ks2)
#pragma unroll
            for (int a = 0; a < 3; ++a) { const int vt = (a == 2) ? 4 : 2 * vh + a;
                const LAS unsigned char* ad = lds + ML_V + (32 * ks2 + 4 * g + q4) * ML_VS + (16 * vt + 4 * p4) * 2;
                Av[ks2][a] = tr_pair(ad, ad + 16 * ML_VS); }
        ML_MMA8(pacc[2], A0, Bq);
        bf16x8 sp[2];
#pragma unroll
        for (int ks2 = 0; ks2 < 2; ++ks2) {
            float sv[8];
#pragma unroll
            for (int e = 0; e < 8; ++e) { const int jt = 2 * ks2 + (e >> 2), j = 16 * jt + 4 * g + (e & 3);
                sv[e] = (j <= tcol) ? sacc[jt][e & 3] * __expf(cj4[jt][e & 3] - Mt_t) : 0.f; }
            const unsigned w0 = cvt_pk_bf16(sv[0], sv[1]), w1 = cvt_pk_bf16(sv[2], sv[3]), w2 = cvt_pk_bf16(sv[4], sv[5]), w3 = cvt_pk_bf16(sv[6], sv[7]);
            sp[ks2] = (bf16x8){(short)(w0 & 0xffff), (short)(w0 >> 16), (short)(w1 & 0xffff), (short)(w1 >> 16), (short)(w2 & 0xffff), (short)(w2 >> 16), (short)(w3 & 0xffff), (short)(w3 >> 16)};
        }
        ML_SB;
        bf16x8 Ck[2], Cv[5];
#pragma unroll
        for (int a = 0; a < 2; ++a) { const LAS unsigned char* ad = lds + ML_K + (8 * g + q4) * ML_RS + (16 * (2 * wave + a) + 4 * p4) * 2; Ck[a] = tr_pair(ad, ad + 4 * ML_RS); }
#pragma unroll
        for (int v = 0; v < 5; ++v) { const LAS unsigned char* ad = lds + ML_VSC + (8 * g + q4) * ML_VS + (16 * v + 4 * p4) * 2; Cv[v] = tr_pair(ad, ad + 4 * ML_VS); }
#pragma unroll
        for (int a = 0; a < 3; ++a) pacc[a] = pacc[a] * inter_t;
#pragma unroll
        for (int ks2 = 0; ks2 < 2; ++ks2)
#pragma unroll
            for (int a = 0; a < 3; ++a) pacc[a] = __builtin_amdgcn_mfma_f32_16x16x32_bf16(Av[ks2][a], sp[ks2], pacc[a], 0, 0, 0);
#pragma unroll
        for (int a = 0; a < 2; ++a)
#pragma unroll
            for (int v = 0; v < 5; ++v) cacc[a][v] = cacc[a][v] * decay;
        ML_SB;
        bf16x8 Dk[2], Dv[5];
#pragma unroll
        for (int a = 0; a < 2; ++a) { const LAS unsigned char* ad = lds + ML_K + (32 + 8 * g + q4) * ML_RS + (16 * (2 * wave + a) + 4 * p4) * 2; Dk[a] = tr_pair(ad, ad + 4 * ML_RS); }
#pragma unroll
        for (int v = 0; v < 5; ++v) { const LAS unsigned char* ad = lds + ML_VSC + (32 + 8 * g + q4) * ML_VS + (16 * v + 4 * p4) * 2; Dv[v] = tr_pair(ad, ad + 4 * ML_VS); }
#pragma unroll
        for (int v = 0; v < 5; ++v)
#pragma unroll
            for (int a = 0; a < 2; ++a) cacc[a][v] = __builtin_amdgcn_mfma_f32_16x16x32_bf16(Ck[a], Cv[v], cacc[a][v], 0, 0, 0);
        { const float den = __shfl(pacc[2][0], li);
          const float inv = 1.0f / fmaxf(fabsf(den), emt_t);
          bf16_t* hp = HR + (size_t)(c * 64 + tcol) * 4096 + 4 * g;
#pragma unroll
          for (int a = 0; a < 2; ++a) { u32x2 w; w.x = cvt_pk_bf16(pacc[a][0] * inv, pacc[a][1] * inv); w.y = cvt_pk_bf16(pacc[a][2] * inv, pacc[a][3] * inv);
              *(u32x2*)(hp + 16 * (2 * vh + a)) = w; } }
        ML_SB;
#pragma unroll
        for (int v = 0; v < 5; ++v)
#pragma unroll
            for (int a = 0; a < 2; ++a) cacc[a][v] = __builtin_amdgcn_mfma_f32_16x16x32_bf16(Dk[a], Dv[v], cacc[a][v], 0, 0, 0);
        __syncthreads();
    }
#undef ML_PREFETCH
#undef ML_SB
#undef ML_LDK
#undef ML_LDC
#undef ML_MMA8
}

__global__ void __launch_bounds__(NWAVES * 64, 2) mk_fwd(Params p) {
    extern __shared__ __attribute__((aligned(16))) unsigned char lds_raw[];
    LAS unsigned char* lds = (LAS unsigned char*)lds_raw;
    volatile LAS unsigned* MISC = (volatile LAS unsigned*)(lds + MISC_OFF);
    const int tid = threadIdx.x, lane = tid & 63, wave = __builtin_amdgcn_readfirstlane(tid >> 6);
    const int G = gridDim.x, bx = blockIdx.x;
    const int vcu = (G % 8 == 0) ? (bx % 8) * (G / 8) + bx / 8 : bx;
    const int gw = vcu * NWAVES + wave, NGW = G * NWAVES;
    unsigned char* ws = p.ws;
    unsigned* ctl = (unsigned*)(ws + WS_CTL);
    for (int u = tid; u < 1024 / 4; u += NWAVES * 64) ((LAS unsigned*)(lds + LDSCTL_OFF))[u] = 0u;
    __syncthreads();
    const bool one_launch = (p.ph_lo == 0 && p.ph_hi >= 8);
    XcdBarrier bar; bar.bar = ctl + CW_BAR; bar.x = 0; bar.st = nullptr;
    if (one_launch) bar = xcd_barrier_post(ctl + CW_BAR, MISC + 8);
    const int lo = p.ph_lo, hi = p.ph_hi;
#define IN(k) (lo <= (k) && (k) < hi)
#ifndef MK_DUP
#define MK_DUP -1
#endif
#define REP(k) for (int rep_ = 0; rep_ < ((MK_DUP) == (k) ? 2 : 1); ++rep_)
#define GRID_BAR() do { if (one_launch) xcd_barrier(bar); } while (0)

    if (IN(0)) { REP(0) p0_prologue(p, lds, gw, NGW, wave, lane); GRID_BAR(); }
    if (IN(1)) {
        SchedP1 S{G, bx, (unsigned)WS_XB, (unsigned)WS_MEMB, (unsigned)WS_WINT, (unsigned)WS_WKVT};
        EpiP1 E{(bf16_t*)(ws + WS_U), (const float*)(ws + WS_BU), (bf16_t*)(ws + WS_KMEM), (bf16_t*)(ws + WS_VT), lds, (bf16_t*)(ws + WS_GB)};
        REP(1) pg8::gemm_phase<EpiP1, SchedP1, true, true, true, true>(lds, ws, 64 * 16384, 64 * 16384, S, E);
        GRID_BAR();
    }
    if (IN(2)) {
        const int NATT = 128;
        const bool att = bx < NATT;
        for (int a = bx; a < NATT; a += G) {
            { SchedQK S{NATT, a, (unsigned)WS_U, (unsigned)WS_KMEM}; EpiSoftmax E{(bf16_t*)(ws + WS_PB), lds};
              pg8::gemm_phase<EpiSoftmax, SchedQK, true, true, false, false>(lds, ws, NU * 2, 4096, S, E); }
            VM_WAIT(); __syncthreads();
            { SchedPV S{NATT, a, (unsigned)WS_PB, (unsigned)WS_VT}; EpiPV E{(const bf16_t*)(ws + WS_U), (bf16_t*)(ws + WS_YCX)};
              pg8::gemm_phase<EpiPV, SchedPV, true, true, false, false>(lds, ws, 2048, 2048, S, E); }
        }
        {
            const int NIT = (T / 16) * 256, nidle = G > NATT ? G - NATT : 0;
            const int split = nidle ? NIT : 0;
            if (!att) conv_phase(p, (bx - NATT) * (NWAVES * 64) + tid, nidle * NWAVES * 64, 0, split);
            else { const int nb = G < NATT ? G : NATT; conv_phase(p, bx * (NWAVES * 64) + tid, nb * NWAVES * 64, split, NIT); }
        }
        __syncthreads();
        REP(9) for (int unit = vcu; unit < 256; unit += G) mlstm_unit(p, lds, unit, wave, lane, tid);
        GRID_BAR();
    }
    if (IN(3)) { REP(10) ym_phase(p, gw, NGW, lane); GRID_BAR(); }
    if (IN(5)) {
        SchedMerge S{G, bx, (unsigned)WS_YM, (unsigned)WS_YCX, (unsigned)WS_WPMT, (unsigned)WS_WPCXT};
        EpiMerge E{(const bf16_t*)(ws + WS_GB), ws + WS_MERGED};
        REP(5) pg8::gemm_phase<EpiMerge, SchedMerge, true, true, true, true>(lds, ws, 64 * 16384, 64 * 16384, S, E);
        GRID_BAR();
    }
    if (IN(6)) {
        SchedOut S{G, bx, (unsigned)WS_MERGED, (unsigned)WS_WOT}; EpiOut E{p.x, p.out};
        REP(6) pg8::gemm_phase<EpiOut, SchedOut, true, true, true, true>(lds, ws, 64 * 16384, 64 * 16384, S, E);
        GRID_BAR();
    }
    if (IN(7)) ln_phase(p, gw, NGW, lane);
#undef IN
#undef GRID_BAR
}

#ifndef MK_N_LAUNCHES
#define MK_N_LAUNCHES 1
#endif
extern "C" void kernel_launch(void* const* d_in, const int* in_sizes, int n_in, void* d_out, int out_size, void* d_ws, size_t ws_size, hipStream_t stream) {
    static int grid = 0;
    if (grid == 0) {
        if (n_in != 13 || out_size != T * D || ws_size < WS_END) { fprintf(stderr, "kernel_launch: unexpected shapes (n_in %d out %d ws %zu)\n", n_in, out_size, ws_size); grid = -1; return; }
        int dev = 0, cus = 0, per_cu = 0;
        if (hipGetDevice(&dev) != hipSuccess || hipDeviceGetAttribute(&cus, hipDeviceAttributeMultiprocessorCount, dev) != hipSuccess) { grid = -1; return; }
        if (hipFuncSetAttribute((const void*)mk_fwd, hipFuncAttributeMaxDynamicSharedMemorySize, LDS_BYTES) != hipSuccess) { fprintf(stderr, "kernel_launch: hipFuncSetAttribute failed\n"); grid = -1; return; }
        if (hipOccupancyMaxActiveBlocksPerMultiprocessor(&per_cu, (const void*)mk_fwd, NWAVES * 64, LDS_BYTES) != hipSuccess || per_cu < 1)
            fprintf(stderr, "kernel_launch: note: occupancy query reports %d\n", per_cu);
        (void)hipGetLastError();
        grid = cus;
    }
    if (grid < 0) return;
    (void)hipMemsetAsync((char*)d_ws + WS_CTL, 0, CTL_ZERO_BYTES, stream);
    Params p{};
    p.x = (const float*)d_in[0]; p.mem = (const float*)d_in[1]; p.w_in = (const float*)d_in[2]; p.b_in = (const float*)d_in[3];
    p.conv_w = (const float*)d_in[4]; p.mh_norm_w = (const float*)d_in[5]; p.w_mem_kv = (const float*)d_in[6]; p.w_proj_m = (const float*)d_in[7];
    p.w_proj_c = (const float*)d_in[8]; p.w_proj_x = (const float*)d_in[9]; p.w_out = (const float*)d_in[10]; p.ln_w = (const float*)d_in[11]; p.ln_b = (const float*)d_in[12];
    p.out = (float*)d_out; p.ws = (unsigned char*)d_ws;
    if (MK_N_LAUNCHES == 1) { p.ph_lo = 0; p.ph_hi = 8; hipLaunchKernelGGL(mk_fwd, dim3(grid), dim3(NWAVES * 64), LDS_BYTES, stream, p); }
    else for (int k = 0; k < 8; ++k) { p.ph_lo = k; p.ph_hi = k + 1; hipLaunchKernelGGL(mk_fwd, dim3(grid), dim3(NWAVES * 64), LDS_BYTES, stream, p); }
}
```

```cpp
#include <hip/hip_runtime.h>
#include <cstdio>
#include <cstdint>

#define LAS __attribute__((address_space(3)))
#define GAS __attribute__((address_space(1)))
typedef unsigned short bf16_t;
typedef short bf16x8 __attribute__((ext_vector_type(8)));
typedef float f32x4 __attribute__((ext_vector_type(4)));
typedef float f32x2 __attribute__((ext_vector_type(2)));
typedef unsigned u32x4 __attribute__((ext_vector_type(4)));
typedef unsigned u32x2 __attribute__((ext_vector_type(2)));

constexpr int NB = 4, SEQ = 2048, T = NB * SEQ, D = 4096;
constexpr int DIN = 40976, NU = 41216;
constexpr int MEMLEN = 256, TM = NB * MEMLEN;
constexpr int UQ = 0, UK = 2048, UV = 4096, UO = 8192, UZ = 12288, UCB = 16384, UCC = 18432, UCX = 20480, UCZ = 22528,
              UXQ = 24576, UXZ = 26624, UG = 28672, UI = 40960, UF = 40968;
constexpr float LN_EPS = 1e-5f;
constexpr float DN_ALPHA = 1.189207115002721f;

constexpr size_t MiB = 1u << 20;
constexpr size_t WS_CTL = 0, CTL_ZERO_BYTES = 1 * MiB;
constexpr size_t WS_BU = 1 * MiB;
constexpr size_t WS_XB = 2 * MiB;
constexpr size_t WS_MEMB = 66 * MiB;
constexpr size_t WS_WINT = 74 * MiB;
constexpr size_t WS_WKVT = 396 * MiB;
constexpr size_t WS_WPMT = 428 * MiB;
constexpr size_t WS_WPCXT = 460 * MiB;
constexpr size_t WS_WOT = 492 * MiB;
constexpr size_t WS_U = 524 * MiB;
constexpr size_t WS_KMEM = 1168 * MiB;
constexpr size_t WS_VT = 1172 * MiB;
constexpr size_t WS_SC = 1176 * MiB;
constexpr size_t WS_PB = 1208 * MiB;
constexpr size_t WS_HRAW = 1224 * MiB;
constexpr size_t WS_YM = 1288 * MiB;
constexpr size_t WS_YCX = 1352 * MiB;
constexpr size_t WS_MERGED = 1416 * MiB;
constexpr size_t WS_GB = 1480 * MiB;
constexpr size_t WS_END = 1672 * MiB;
constexpr int CW_BAR = 4096;

constexpr int RING_BYTES = 131072;
constexpr int LDS_BYTES = 163840;
constexpr int LDSCTL_OFF = LDS_BYTES - 1024, MISC_OFF = LDSCTL_OFF + 320;
constexpr int EPI_OFF = RING_BYTES, EPI_WAVE_BYTES = 16 * 144;
static_assert(EPI_OFF + 8 * EPI_WAVE_BYTES <= LDSCTL_OFF, "LDS map");
constexpr int NWAVES = 8;

typedef __bf16 bf16x2_t __attribute__((ext_vector_type(2)));
__device__ __forceinline__ unsigned cvt_pk_bf16_asm(float lo, float hi) { unsigned r; asm("v_cvt_pk_bf16_f32 %0, %1, %2" : "=v"(r) : "v"(lo), "v"(hi)); return r; }
__device__ __forceinline__ unsigned cvt_pk_bf16(float lo, float hi) { const bf16x2_t v = __builtin_convertvector((f32x2){lo, hi}, bf16x2_t); return __builtin_bit_cast(unsigned, v); }
__device__ __forceinline__ float bf_lo(unsigned w) { return __uint_as_float(w << 16); }
__device__ __forceinline__ float bf_hi(unsigned w) { return __uint_as_float(w & 0xffff0000u); }
__device__ __forceinline__ float bf2f(bf16_t h) { return __uint_as_float(((unsigned)h) << 16); }
__device__ __forceinline__ float sigmoidf_(float x) { return __builtin_amdgcn_rcpf(1.0f + __expf(-x)); }
__device__ __forceinline__ float wave_sum(float v) {
#pragma unroll
    for (int o = 1; o < 64; o <<= 1) v += __shfl_xor(v, o);
    return v;
}
__device__ __forceinline__ float wave_max(float v) {
#pragma unroll
    for (int o = 1; o < 64; o <<= 1) v = fmaxf(v, __shfl_xor(v, o));
    return v;
}
#define LDS_WAIT() asm volatile("s_waitcnt lgkmcnt(0)" ::: "memory")
#define VM_WAIT() asm volatile("s_waitcnt vmcnt(0)" ::: "memory")

namespace pg8 {
constexpr int BM = 256, BK = 64, HALF = 128, HTB = HALF * BK * 2, STAGE_BYTES = 8 * HTB;
__host__ __device__ __forceinline__ int lds_byte(int r, int c) { const int st = (r >> 4) * 2 + (c >> 5), rr = r & 15, cc = c & 31, ob = rr * 64 + cc * 2; return st * 1024 + (ob ^ (((ob >> 9) & 1) << 5)); }
__host__ __device__ __forceinline__ void stage_rc(int b, int& R, int& C) { const int st = b / 1024, sb = b % 1024, swz = sb ^ (((sb >> 9) & 1) << 5); R = (st >> 1) * 16 + swz / 64; C = (st & 1) * 32 + (swz % 64) / 2; }
__host__ __device__ __forceinline__ int perm32(int rho) { const int n = rho >> 4, i = rho & 15; return 8 * (i >> 2) + 4 * n + (i & 3); }

struct Unit { unsigned A; unsigned B; int nt, pm, pn, kind; };

__device__ __forceinline__ bool tile_map(long L, int nM, int nN, int& pm, int& pn) {
    const int nwg = nM * nN; if (L >= nwg) return false;
    int wgid = (int)L; { const int q = nwg / 8, r = nwg % 8, xcd = wgid % 8, off = wgid / 8; wgid = (xcd < r ? xcd * (q + 1) : r * (q + 1) + (xcd - r) * q) + off; }
    const int nig = 8 * nN, gid = wgid / nig, fm = gid * 8, gsz = (nM - fm) < 8 ? (nM - fm) : 8;
    pm = fm + ((wgid % nig) % gsz); pn = (wgid % nig) / gsz; return true;
}

template <class Epi, class Sched, bool ALIGN_EPI, bool SP2, bool APACK, bool BPACK>
__device__ __forceinline__ void gemm_phase(LAS unsigned char* lds, const unsigned char* wsbase, const int lda, const int ldb, const Sched& S, const Epi& E) {
    const int tid = threadIdx.x, wid = __builtin_amdgcn_readfirstlane(tid >> 6), lane = tid & 63, wr = wid >> 2, wc = wid & 3, fr = lane & 15, fq = lane >> 4;
    unsigned voffA[2], voffB[2];
#pragma unroll
    for (int i = 0; i < 2; ++i) { int R, C; stage_rc(tid * 16 + i * 8192, R, C); const int Rb = Epi::PERM ? ((R & ~31) + perm32(R & 31)) : R;
        voffA[i] = APACK ? (unsigned)(tid * 16 + i * 8192) : (unsigned)(R * lda + C * 2); voffB[i] = BPACK ? (unsigned)(tid * 16 + i * 8192) : (unsigned)(Rb * ldb + C * 2); }
    const unsigned kstepA = APACK ? 16384u : (unsigned)(BK * 2), kstepB = BPACK ? 16384u : (unsigned)(BK * 2);
    const unsigned hstepA = APACK ? (unsigned)lda : (unsigned)(HALF * lda), hstepB = BPACK ? (unsigned)ldb : (unsigned)(HALF * ldb);
    const __amdgpu_buffer_rsrc_t rsrc = __builtin_amdgcn_make_buffer_rsrc((void*)wsbase, 0, 0xFFFFFFFFu, 0x00020000);
    const unsigned ldsw = (unsigned)wid * 1024u;
    const int aoff = lds_byte(wr * 64 + fr, fq * 8), boff = lds_byte(wc * 32 + fr, fq * 8);
#define PG8_SA(b, h) (((b) * 2 + (h)) * HTB)
#define PG8_SB(b, h) ((4 + (b) * 2 + (h)) * HTB)
#define PG8_STAGE(bufoff, goff, voff) do { _Pragma("unroll") for (int _i = 0; _i < 2; ++_i) \
        __builtin_amdgcn_raw_ptr_buffer_load_lds(rsrc, (LAS void*)(lds + (bufoff) + ldsw + _i * 8192), 16, (int)(voff)[_i], (int)(goff), 0, 0); } while (0)
#define PG8_LDA(dst, b, h) do { _Pragma("unroll") for (int m = 0; m < 4; ++m) _Pragma("unroll") for (int k = 0; k < 2; ++k) dst[m][k] = *(const LAS bf16x8*)(lds + PG8_SA(b, h) + aoff + m * 2048 + k * 1024); } while (0)
#define PG8_LDB(dst, b, h) do { _Pragma("unroll") for (int n = 0; n < 2; ++n) _Pragma("unroll") for (int k = 0; k < 2; ++k) dst[n][k] = *(const LAS bf16x8*)(lds + PG8_SB(b, h) + boff + n * 2048 + k * 1024); } while (0)
#define PG8_MMA(ai, bj, At, Bt) do { __builtin_amdgcn_s_setprio(1); _Pragma("unroll") for (int m = 0; m < 4; ++m) _Pragma("unroll") for (int n = 0; n < 2; ++n) _Pragma("unroll") for (int k = 0; k < 2; ++k) \
        acc[ai][bj][m][n] = __builtin_amdgcn_mfma_f32_16x16x32_bf16(Bt[n][k], At[m][k], acc[ai][bj][m][n], 0, 0, 0); __builtin_amdgcn_s_setprio(0); } while (0)
#define PG8_WAIT_V(n) asm volatile("s_waitcnt vmcnt(" #n ")" ::: "memory")
#define PG8_WAIT_L(n) asm volatile("s_waitcnt lgkmcnt(" #n ")" ::: "memory")
#define PG8_BAR __builtin_amdgcn_s_barrier()
#define PG8_SCHED __builtin_amdgcn_sched_barrier(0)
    Unit cur, nxt; int ui = 0;
    if (!S.next(0, cur)) return;
    f32x4 acc[2][2][4][2];
#pragma unroll
    for (int a = 0; a < 2; ++a)
#pragma unroll
        for (int b = 0; b < 2; ++b)
#pragma unroll
            for (int m = 0; m < 4; ++m)
#pragma unroll
                for (int n = 0; n < 2; ++n) acc[a][b][m][n] = (f32x4){0.f, 0.f, 0.f, 0.f};
    bf16x8 At[4][2], B0[2][2], B1[2][2];
    unsigned cA = cur.A, cB = cur.B;
    if constexpr (SP2) {
        PG8_STAGE(PG8_SB(0, 0), cB, voffB); PG8_STAGE(PG8_SB(0, 1), cB + hstepB, voffB); PG8_STAGE(PG8_SA(0, 0), cA, voffA); PG8_STAGE(PG8_SA(0, 1), cA + hstepA, voffA);
        if (wr == 1) PG8_BAR;
        PG8_WAIT_V(2); PG8_BAR;
        PG8_STAGE(PG8_SB(1, 0), cB + kstepB, voffB); PG8_STAGE(PG8_SA(1, 0), cA + kstepA, voffA); PG8_STAGE(PG8_SB(1, 1), cB + hstepB + kstepB, voffB);
        PG8_WAIT_V(6); PG8_BAR;
    } else {
        PG8_STAGE(PG8_SB(0, 0), cB, voffB); PG8_STAGE(PG8_SA(0, 0), cA, voffA); PG8_STAGE(PG8_SB(0, 1), cB + hstepB, voffB); PG8_STAGE(PG8_SA(0, 1), cA + hstepA, voffA);
        if (wr == 1) PG8_BAR;
        PG8_WAIT_V(4); PG8_BAR;
        PG8_STAGE(PG8_SB(1, 0), cB + kstepB, voffB); PG8_STAGE(PG8_SA(1, 0), cA + kstepA, voffA); PG8_STAGE(PG8_SB(1, 1), cB + hstepB + kstepB, voffB);
        PG8_WAIT_V(6); PG8_BAR;
    }
    for (;;) {
        const bool has_next = S.next(ui + 1, nxt);
        const unsigned nA = has_next ? nxt.A : cA, nB = has_next ? nxt.B : cB;
        const int nt = cur.nt;
#pragma clang loop unroll(disable)
        for (int t = 0; t < nt; t += 2) {
            const bool last = (t == nt - 2);
            const unsigned a1 = cA + (unsigned)(t + 1) * kstepA;
            const unsigned a2 = last ? nA : cA + (unsigned)(t + 2) * kstepA, b2 = last ? nB : cB + (unsigned)(t + 2) * kstepB;
            const unsigned a3 = a2 + kstepA, b3 = b2 + kstepB;
            if constexpr (SP2) {
            PG8_LDB(B0, 0, 0); PG8_LDB(B1, 0, 1); PG8_SCHED; PG8_LDA(At, 0, 0); PG8_STAGE(PG8_SA(1, 1), a1 + hstepA, voffA);
            PG8_WAIT_V(8); PG8_WAIT_L(0); PG8_BAR; PG8_MMA(0, 0, At, B0); PG8_MMA(0, 1, At, B1); PG8_BAR; PG8_SCHED;
            PG8_LDA(At, 0, 1); PG8_STAGE(PG8_SB(0, 0), b2, voffB); PG8_STAGE(PG8_SB(0, 1), b2 + hstepB, voffB); PG8_STAGE(PG8_SA(0, 0), a2, voffA);
            PG8_WAIT_V(8); PG8_WAIT_L(0); PG8_BAR; PG8_MMA(1, 0, At, B0); PG8_MMA(1, 1, At, B1); PG8_BAR; PG8_SCHED;
            PG8_LDB(B0, 1, 0); PG8_LDB(B1, 1, 1); PG8_SCHED; PG8_LDA(At, 1, 0); PG8_STAGE(PG8_SA(0, 1), a2 + hstepA, voffA);
            PG8_WAIT_V(8); PG8_WAIT_L(0); PG8_BAR; PG8_MMA(0, 0, At, B0); PG8_MMA(0, 1, At, B1); PG8_BAR; PG8_SCHED;
            PG8_LDA(At, 1, 1); PG8_STAGE(PG8_SB(1, 0), b3, voffB); PG8_STAGE(PG8_SB(1, 1), b3 + hstepB, voffB); PG8_STAGE(PG8_SA(1, 0), a3, voffA);
            PG8_WAIT_V(8); PG8_WAIT_L(0); PG8_BAR; PG8_MMA(1, 0, At, B0); PG8_MMA(1, 1, At, B1); PG8_BAR; PG8_SCHED;
            } else {
            PG8_LDB(B0, 0, 0); PG8_SCHED; PG8_LDA(At, 0, 0); PG8_STAGE(PG8_SA(1, 1), a1 + hstepA, voffA);
            PG8_WAIT_L(8); PG8_BAR; PG8_WAIT_L(0); PG8_MMA(0, 0, At, B0); PG8_BAR; PG8_SCHED;
            PG8_LDB(B1, 0, 1); PG8_STAGE(PG8_SB(0, 0), b2, voffB);
            PG8_BAR; PG8_WAIT_L(0); PG8_MMA(0, 1, At, B1); PG8_BAR;
            PG8_LDA(At, 0, 1); PG8_STAGE(PG8_SA(0, 0), a2, voffA);
            PG8_BAR; PG8_WAIT_L(0); PG8_MMA(1, 0, At, B0); PG8_BAR; PG8_SCHED;
            PG8_STAGE(PG8_SB(0, 1), b2 + hstepB, voffB);
            PG8_WAIT_V(6); PG8_BAR; PG8_MMA(1, 1, At, B1); PG8_BAR;
            PG8_LDB(B0, 1, 0); PG8_SCHED; PG8_LDA(At, 1, 0); PG8_STAGE(PG8_SA(0, 1), a2 + hstepA, voffA);
            PG8_WAIT_L(8); PG8_BAR; PG8_WAIT_L(0); PG8_MMA(0, 0, At, B0); PG8_BAR; PG8_SCHED;
            PG8_LDB(B1, 1, 1); PG8_STAGE(PG8_SB(1, 0), b3, voffB);
            PG8_BAR; PG8_WAIT_L(0); PG8_MMA(0, 1, At, B1); PG8_BAR;
            PG8_LDA(At, 1, 1); PG8_STAGE(PG8_SA(1, 0), a3, voffA);
            PG8_BAR; PG8_WAIT_L(0); PG8_MMA(1, 0, At, B0); PG8_BAR; PG8_SCHED;
            PG8_STAGE(PG8_SB(1, 1), b3 + hstepB, voffB);
            PG8_WAIT_V(6); PG8_BAR; PG8_MMA(1, 1, At, B1); PG8_BAR;
            }
        }
        if constexpr (ALIGN_EPI) { if (wr == 0) PG8_BAR; }
        E(acc, cur, wr, wc, fr, fq);
        if (!has_next) break;
        if (!(Epi::KEEP && cur.kind != 2)) {
#pragma unroll
        for (int a = 0; a < 2; ++a)
#pragma unroll
            for (int b = 0; b < 2; ++b)
#pragma unroll
                for (int m = 0; m < 4; ++m)
#pragma unroll
                    for (int n = 0; n < 2; ++n) acc[a][b][m][n] = (f32x4){0.f, 0.f, 0.f, 0.f};
        }
        cur = nxt; cA = nA; cB = nB; ++ui;
        if constexpr (ALIGN_EPI) { if (wr == 1) PG8_BAR; }
    }
    PG8_WAIT_V(0);
    if constexpr (!ALIGN_EPI) { if (wr == 0) PG8_BAR; }
    PG8_BAR;
#undef PG8_SA
#undef PG8_SB
#undef PG8_STAGE
#undef PG8_LDA
#undef PG8_LDB
#undef PG8_MMA
#undef PG8_WAIT_V
#undef PG8_WAIT_L
#undef PG8_BAR
#undef PG8_SCHED
}
}
using pg8::Unit;
constexpr size_t PKB = 16384;
__device__ __forceinline__ size_t pk_off(int row, int col, int ktiles) { return ((size_t)(row >> 7) * ktiles + (col >> 6)) * PKB + pg8::lds_byte(row & 127, col & 63); }

#define XB_TMO      128
#define XB_XCNT(j)  (256  + 64 * (j))
#define XB_XSUB(j)  (1280 + 64 * (j))
#define XB_XGEN(j)  (2304 + 64 * (j))
#define XB_TOP      3328
#define XB_TOPGEN   3392
#define XCD_BAR_WORDS 3456
#define XB_SPIN_CAP (1u << 18)

__device__ __forceinline__ unsigned xb_ld(unsigned* p)              { return __hip_atomic_load(p, __ATOMIC_RELAXED, __HIP_MEMORY_SCOPE_AGENT); }
__device__ __forceinline__ unsigned xb_add(unsigned* p, unsigned v) { return __hip_atomic_fetch_add(p, v, __ATOMIC_RELAXED, __HIP_MEMORY_SCOPE_AGENT); }
__device__ __forceinline__ unsigned xb_xcc_id() { return (unsigned)__builtin_amdgcn_s_getreg((3 << 11) | 20) & 0xFu; }
#define XB_SPIN(cond, bar) do { unsigned _sp = 0; while (cond) { __builtin_amdgcn_s_sleep(1); \
    if ((++_sp & 255u) == 0u) { if (xb_ld(&(bar)[XB_TMO])) break; if (_sp > XB_SPIN_CAP) { atomicAdd(&(bar)[XB_TMO], 1u); break; } } } } while (0)

struct XcdBarrier { unsigned* bar; unsigned x; volatile LAS unsigned* st; };

__device__ __forceinline__ XcdBarrier xcd_barrier_post(unsigned* bar, volatile LAS unsigned* st) {
    XcdBarrier b; b.bar = bar; b.x = xb_xcc_id(); b.st = st;
    if (threadIdx.x == 0) (void)xb_add(&bar[XB_XCNT(b.x)], 1u);
    return b;
}
__device__ __forceinline__ void xcd_barrier_complete(unsigned* bar, unsigned x, unsigned& nloc, unsigned& nx) {
    const unsigned G = gridDim.x * gridDim.y * gridDim.z;
    unsigned sum, cnt, mine, sp = 0u;
    for (;;) {
        sum = 0u; cnt = 0u; mine = 0u;
#pragma unroll
        for (unsigned j = 0; j < 16; ++j) { const unsigned c = xb_ld(&bar[XB_XCNT(j)]); sum += c; cnt += (c > 0u) ? 1u : 0u; mine = (j == x) ? c : mine; }
        if (sum == G) break;
        __builtin_amdgcn_s_sleep(1);
        if ((++sp & 255u) == 0u) { if (xb_ld(&bar[XB_TMO])) break; if (sp > XB_SPIN_CAP) { atomicAdd(&bar[XB_TMO], 1u); break; } }
    }
    nloc = mine > 0u ? mine : 1u; nx = cnt > 0u ? cnt : 1u;
}
__device__ __forceinline__ void xcd_barrier(const XcdBarrier& b) {
    asm volatile("s_waitcnt vmcnt(0)" ::: "memory");
    __syncthreads();
    if (threadIdx.x == 0) {
        unsigned* bar = b.bar;
        __builtin_amdgcn_s_waitcnt(0);
        unsigned nloc = b.st[0], nx = b.st[1];
        if (nloc == 0u) { xcd_barrier_complete(bar, b.x, nloc, nx); b.st[0] = nloc; b.st[1] = nx; }
        const unsigned old = xb_add(&bar[XB_XSUB(b.x)], 1u);
        const unsigned gen = old / nloc;
        if (old + 1u == (gen + 1u) * nloc) {
            __builtin_amdgcn_fence(__ATOMIC_RELEASE, "agent");
            asm volatile("s_waitcnt vmcnt(0)" ::: "memory");
            const unsigned og = xb_add(&bar[XB_TOP], 1u);
            const unsigned tg = og / nx;
            if (og + 1u == (tg + 1u) * nx) xb_add(&bar[XB_TOPGEN], 1u);
            else XB_SPIN(xb_ld(&bar[XB_TOPGEN]) == tg, bar);
            __builtin_amdgcn_fence(__ATOMIC_ACQUIRE, "agent");
            xb_add(&bar[XB_XGEN(b.x)], 1u);
            asm volatile("s_waitcnt vmcnt(0)" ::: "memory");
        } else {
            XB_SPIN(xb_ld(&bar[XB_XGEN(b.x)]) == gen, bar);
            __builtin_amdgcn_fence(__ATOMIC_ACQUIRE, "agent");
            asm volatile("s_waitcnt vmcnt(0)" ::: "memory");
        }
    }
    __syncthreads();
}

struct Params {
    const float *x, *mem, *w_in, *b_in, *conv_w, *mh_norm_w, *w_mem_kv, *w_proj_m, *w_proj_c, *w_proj_x, *w_out, *ln_w, *ln_b;
    float* out; unsigned char* ws;
    int ph_lo, ph_hi;
};

__device__ __forceinline__ void transpose_item_pk(const float* src, size_t src_ld, int col0, int ncv, unsigned char* img, int ktiles, int n0, int k0, LAS unsigned* scr, int lane, int kdst_off = 0) {
    const float* sp = src + (size_t)k0 * src_ld + col0 + lane;
    if (ncv > 0) {
        float a[32], b[32];
#pragma unroll
        for (int i = 0; i < 32; ++i) { a[i] = 0.f; b[i] = 0.f; if (lane < ncv) { a[i] = __builtin_nontemporal_load(sp + (size_t)(2 * i) * src_ld); b[i] = __builtin_nontemporal_load(sp + (size_t)(2 * i + 1) * src_ld); } }
#pragma unroll
        for (int i = 0; i < 32; ++i) scr[i * 66 + lane] = cvt_pk_bf16_asm(a[i], b[i]);
    } else {
#pragma unroll 8
        for (int i = 0; i < 32; ++i) scr[i * 66 + lane] = 0u;
    }
    LDS_WAIT(); asm volatile("" ::: "memory");
    const int rr = lane >> 2, ch = lane & 3;
    unsigned char* blk = img + ((size_t)(2 * (n0 >> 8)) * ktiles + ((k0 + kdst_off) >> 6)) * PKB;
    const int wcs = (n0 >> 6) & 3;
#pragma unroll
    for (int sub = 0; sub < 8; ++sub) {
        const int grp = sub >> 2, np = (sub >> 1) & 1, k32 = sub & 1;
        const int nl = 32 * grp + 8 * (rr >> 2) + 4 * np + (rr & 3);
        const LAS unsigned* s = scr + (16 * k32 + 4 * ch) * 66 + nl;
        u32x4 o; o.x = s[0]; o.y = s[66]; o.z = s[132]; o.w = s[198];
        const int rho = 32 * wcs + 16 * np + rr;
        *(u32x4*)(blk + (size_t)grp * ktiles * PKB + pg8::lds_byte(rho, 32 * k32 + 8 * ch)) = o;
    }
    LDS_WAIT(); asm volatile("" ::: "memory");
}
__device__ __forceinline__ void cvt_item_pk(const float* src, unsigned char* img, int item, int lane) {
    const int rg = item >> 5, cg4 = item & 31, rr = lane >> 2, ch = lane & 3, row = rg * 16 + rr;
    f32x4 a[4], b[4];
#pragma unroll
    for (int q = 0; q < 4; ++q) { const int col = (cg4 * 4 + q) * 32 + 8 * ch;
        a[q] = __builtin_nontemporal_load((const f32x4*)(src + (size_t)row * 4096 + col)); b[q] = __builtin_nontemporal_load((const f32x4*)(src + (size_t)row * 4096 + col + 4)); }
#pragma unroll
    for (int q = 0; q < 4; ++q) { const int col = (cg4 * 4 + q) * 32 + 8 * ch;
        u32x4 o; o.x = cvt_pk_bf16_asm(a[q][0], a[q][1]); o.y = cvt_pk_bf16_asm(a[q][2], a[q][3]); o.z = cvt_pk_bf16_asm(b[q][0], b[q][1]); o.w = cvt_pk_bf16_asm(b[q][2], b[q][3]);
        *(u32x4*)(img + pk_off(row, col, 64)) = o; }
}
__device__ __forceinline__ void p0a_prologue(const Params& p, LAS unsigned char* lds, int gw, int NGW, int wave, int lane) {
    LAS unsigned* scr = (LAS unsigned*)(lds + wave * 8448);
    unsigned char* ws = p.ws;
    constexpr int I_KV = 64 * 64, I_G = 64 * 4;
    for (int it = gw; it < I_KV + I_G; it += NGW) {
        int r = it;
        if (r < I_KV) { transpose_item_pk(p.w_mem_kv, 4096, (r % 64) * 64, 64, ws + WS_WKVT, 64, (r % 64) * 64, (r / 64) * 64, scr, lane); continue; }
        r -= I_KV;
        { const int kb = r >> 2, nb = 640 + (r & 3), n0 = nb * 64;
          transpose_item_pk(p.w_in, DIN, 16384, n0 == 40960 ? 16 : 0, ws + WS_WINT, 64, n0, kb * 64, scr, lane); }
    }
    for (int it = gw; it < (T / 16) * 32; it += NGW) cvt_item_pk(p.x, ws + WS_XB, it, lane);
    for (int it = gw; it < (TM / 16) * 32; it += NGW) cvt_item_pk(p.mem, ws + WS_MEMB, it, lane);
    float* BU = (float*)(ws + WS_BU);
    for (int c = gw * 64 + lane; c < NU; c += NGW * 64) {
        float v = 0.f;
        if (c < 16384) v = p.b_in[c]; else if (c < 40960) v = p.b_in[c + 16]; else if (c < 40976) v = p.b_in[16384 + (c - 40960)];
        BU[c] = v;
    }
}
__device__ __forceinline__ void p0b_convert(const Params& p, LAS unsigned char* lds, int widx, int nw, int it_lo, int it_hi, int wave, int lane) {
    LAS unsigned* scr = (LAS unsigned*)(lds + wave * 8448);
    unsigned char* ws = p.ws;
    constexpr int I_IN = 64 * 640, I_PM = 64 * 64, I_PC = 32 * 64, I_PX = 32 * 64;
    for (int it = it_lo + widx; it < it_hi; it += nw) {
        int r = it;
        if (r < I_IN) { const int kb = r / 640, nb = r % 640, n0 = nb * 64; const int col0 = n0 < 16384 ? n0 : n0 + 16;
            transpose_item_pk(p.w_in, DIN, col0, 64, ws + WS_WINT, 64, n0, kb * 64, scr, lane); continue; }
        r -= I_IN;
        if (r < I_PM) { transpose_item_pk(p.w_proj_m, 4096, (r % 64) * 64, 64, ws + WS_WPMT, 64, (r % 64) * 64, (r / 64) * 64, scr, lane); continue; }
        r -= I_PM;
        if (r < I_PC) { transpose_item_pk(p.w_proj_c, 4096, (r % 64) * 64, 64, ws + WS_WPCXT, 64, (r % 64) * 64, (r / 64) * 64, scr, lane); continue; }
        r -= I_PC;
        if (r < I_PX) { transpose_item_pk(p.w_proj_x, 4096, (r % 64) * 64, 64, ws + WS_WPCXT, 64, (r % 64) * 64, (r / 64) * 64, scr, lane, 2048); continue; }
        r -= I_PX;
        transpose_item_pk(p.w_out, 4096, (r % 64) * 64, 64, ws + WS_WOT, 64, (r % 64) * 64, (r / 64) * 64, scr, lane);
    }
}
constexpr int P0B_ITEMS = 64 * 640 + 64 * 64 + 32 * 64 + 32 * 64 + 64 * 64;
constexpr int NTAIL = 96;

__device__ __forceinline__ int act_of(int c0) {
    if (c0 >= UXZ && c0 < UG) return 2;
    if (c0 >= UG && c0 < UI) return 1;
    return 0;
}
struct SchedP1 {
    int G, c; unsigned xb, wint;
    __device__ __forceinline__ bool next(int i, Unit& u) const {
        const long L = (long)i * G + c;
        if (!pg8::tile_map(L, 32, 160, u.pm, u.pn)) return false;
        u.A = xb + (unsigned)u.pm * (unsigned)(128 * PKB); u.B = wint + (unsigned)u.pn * (unsigned)(128 * PKB); u.nt = 64; u.kind = 0; return true;
    }
};
struct SchedTail {
    int c; unsigned xb, memb, wint, wkvt;
    __device__ __forceinline__ bool next(int i, Unit& u) const {
        if (i != 0 || c >= NTAIL) return false;
        if (c < 64) { u.pm = c / 16; u.pn = c % 16; u.A = memb + (unsigned)u.pm * (unsigned)(128 * PKB); u.B = wkvt + (unsigned)u.pn * (unsigned)(128 * PKB); u.nt = 64; u.kind = 1; return true; }
        u.pm = c - 64; u.pn = 160; u.A = xb + (unsigned)u.pm * (unsigned)(128 * PKB); u.B = wint + (unsigned)160 * (unsigned)(128 * PKB); u.nt = 64; u.kind = 0; return true;
    }
};
struct EpiP1 {
    static constexpr bool PERM = true, KEEP = false;
    bf16_t* U; const float* bU; bf16_t* KMEM; bf16_t* VT; LAS unsigned char* lds; bf16_t* GB;
    __device__ __forceinline__ void operator()(f32x4 (&acc)[2][2][4][2], const Unit& u, int wr, int wc, int fr, int fq) const {
        asm volatile("" : "+v"(fr), "+v"(fq));
#if defined(MK_PROBE_EPI_OFF)
        if (u.kind != 77) return;
#endif
        const int row0 = wr * 64 + fr, col0 = wc * 64 + 8 * fq;
        if (u.kind == 1 && u.pn >= 8) {
            bf16_t* vb = VT + (size_t)((u.pn - 8) * 256 + col0) * 1024 + u.pm * 256 + row0;
#pragma unroll
            for (int ai = 0; ai < 2; ++ai)
#pragma unroll
                for (int m = 0; m < 4; ++m)
#pragma unroll
                    for (int bj = 0; bj < 2; ++bj)
#pragma unroll
                        for (int n = 0; n < 2; ++n)
#pragma unroll
                            for (int j = 0; j < 4; j += 2) { const unsigned w = cvt_pk_bf16(acc[ai][bj][m][n][j], acc[ai][bj][m][n][j + 1]);
                                bf16_t* q = vb + (size_t)(bj * 32 + 4 * n + j) * 1024 + ai * 128 + m * 16;
                                q[0] = (bf16_t)(w & 0xffffu); q[1024] = (bf16_t)(w >> 16); }
            return;
        }
        bf16_t* base; int ldc; const float* bias; int act = 0; float sc = 1.f;
        if (u.kind == 0) { const int c0 = u.pn * 256; base = U + (size_t)u.pm * 256 * NU + c0; ldc = NU; bias = bU + c0; act = act_of(c0); if (c0 < UK) sc = 0.0625f;
            if (c0 >= UG && c0 < UI) { base = GB + ((size_t)((c0 - UG) >> 8) * T + (size_t)u.pm * 256) * 256; ldc = 256; } }
        else { base = KMEM + (size_t)u.pm * 256 * 2048 + u.pn * 256; ldc = 2048; bias = nullptr; }
        f32x4 bv[2][2];
#pragma unroll
        for (int bj = 0; bj < 2; ++bj)
#pragma unroll
            for (int n = 0; n < 2; ++n) bv[bj][n] = bias ? *(const f32x4*)(bias + col0 + bj * 32 + 4 * n) : (f32x4){0.f, 0.f, 0.f, 0.f};
        const int wid = wr * 4 + wc, lane = fr + 16 * fq;
        LAS unsigned char* stg = lds + EPI_OFF + wid * EPI_WAVE_BYTES;
        LAS unsigned char* wp = stg + fr * 144 + fq * 16;
        const LAS unsigned char* rp = stg + (lane >> 3) * 144 + (lane & 7) * 16;
        bf16_t* gp = base + (size_t)(wr * 64 + (lane >> 3)) * ldc + wc * 64 + (lane & 7) * 8;
#pragma unroll
        for (int ai = 0; ai < 2; ++ai)
#pragma unroll
            for (int m = 0; m < 4; ++m) {
#pragma unroll
                for (int bj = 0; bj < 2; ++bj) { f32x4 v0 = acc[ai][bj][m][0] + bv[bj][0], v1 = acc[ai][bj][m][1] + bv[bj][1];
                    if (act) {
#pragma unroll
                        for (int j = 0; j < 4; ++j) { const float s0 = sigmoidf_(v0[j]), s1 = sigmoidf_(v1[j]); v0[j] = (act == 1) ? s0 : v0[j] * s0; v1[j] = (act == 1) ? s1 : v1[j] * s1; } }
                    v0 = v0 * sc; v1 = v1 * sc;
                    u32x4 w; w.x = cvt_pk_bf16(v0[0], v0[1]); w.y = cvt_pk_bf16(v0[2], v0[3]); w.z = cvt_pk_bf16(v1[0], v1[1]); w.w = cvt_pk_bf16(v1[2], v1[3]);
                    *(LAS u32x4*)(wp + bj * 64) = w; }
                asm volatile("" ::: "memory");
                const u32x4 o0 = *(const LAS u32x4*)rp, o1 = *(const LAS u32x4*)(rp + 8 * 144);
                asm volatile("" ::: "memory");
                bf16_t* g0 = gp + (size_t)(ai * 128 + m * 16) * ldc;
                __builtin_nontemporal_store(o0, (u32x4*)g0); __builtin_nontemporal_store(o1, (u32x4*)(g0 + (size_t)8 * ldc)); }
    }
};
struct SchedQK {
    int G, c; unsigned u, kmem;
    __device__ __forceinline__ bool next(int i, Unit& un) const {
        const int L = i * G + c; if (L >= 128) return false;
        const int head = L & 3, rt = L >> 2;
        un.pm = rt; un.pn = head; un.A = u + (unsigned)(((size_t)rt * 256 * NU + UXQ + head * 512) * 2); un.B = kmem + (unsigned)(((size_t)(rt >> 3) * 256 * 2048 + head * 512) * 2); un.nt = 8; un.kind = 0; return true;
    }
};
struct EpiSoftmax {
    static constexpr bool PERM = false, KEEP = false;
    bf16_t* PB; LAS unsigned char* lds;
    __device__ __forceinline__ void operator()(f32x4 (&acc)[2][2][4][2], const Unit& u, int wr, int wc, int fr, int fq) const {
        asm volatile("" : "+v"(fr), "+v"(fq));
        const float sc = 0.04419417382415922f * 1.4426950408889634f;
        LAS float* MX = (LAS float*)(lds + EPI_OFF);
        LAS float* SX = MX + 1024;
        float mrow[2][4];
#pragma unroll
        for (int ai = 0; ai < 2; ++ai)
#pragma unroll
            for (int m = 0; m < 4; ++m) { float mx = -3.0e38f;
#pragma unroll
                for (int bj = 0; bj < 2; ++bj)
#pragma unroll
                    for (int n = 0; n < 2; ++n) { acc[ai][bj][m][n] = acc[ai][bj][m][n] * sc; const f32x4 v = acc[ai][bj][m][n]; mx = fmaxf(mx, fmaxf(fmaxf(v[0], v[1]), fmaxf(v[2], v[3]))); }
                mx = fmaxf(mx, __shfl_xor(mx, 16)); mx = fmaxf(mx, __shfl_xor(mx, 32));
                if (fq == 0) MX[(ai * 128 + wr * 64 + m * 16 + fr) * 4 + wc] = mx; }
        asm volatile("s_waitcnt lgkmcnt(0)" ::: "memory"); __builtin_amdgcn_s_barrier(); asm volatile("" ::: "memory");
#pragma unroll
        for (int ai = 0; ai < 2; ++ai)
#pragma unroll
            for (int m = 0; m < 4; ++m) { const f32x4 q = *(const LAS f32x4*)(MX + (ai * 128 + wr * 64 + m * 16 + fr) * 4);
                const float mx = fmaxf(fmaxf(q[0], q[1]), fmaxf(q[2], q[3])); mrow[ai][m] = mx; float s = 0.f;
#pragma unroll
                for (int bj = 0; bj < 2; ++bj)
#pragma unroll
                    for (int n = 0; n < 2; ++n) { f32x4 v = acc[ai][bj][m][n];
#pragma unroll
                        for (int j = 0; j < 4; ++j) { v[j] = __builtin_amdgcn_exp2f(v[j] - mx); s += v[j]; }
                        acc[ai][bj][m][n] = v; }
                s += __shfl_xor(s, 16); s += __shfl_xor(s, 32);
                if (fq == 0) SX[(ai * 128 + wr * 64 + m * 16 + fr) * 4 + wc] = s; }
        asm volatile("s_waitcnt lgkmcnt(0)" ::: "memory"); __builtin_amdgcn_s_barrier(); asm volatile("" ::: "memory");
        bf16_t* base = PB + (size_t)u.pm * 256 * 1024 + u.pn * 256;
        const int row0 = wr * 64 + fr, col0 = wc * 32 + 4 * fq;
#pragma unroll
        for (int ai = 0; ai < 2; ++ai)
#pragma unroll
            for (int m = 0; m < 4; ++m) { const f32x4 q = *(const LAS f32x4*)(SX + (ai * 128 + wr * 64 + m * 16 + fr) * 4);
                const float inv = 1.0f / ((q[0] + q[1]) + (q[2] + q[3]));
                bf16_t* rowp = base + (size_t)(row0 + ai * 128 + m * 16) * 1024 + col0;
#pragma unroll
                for (int bj = 0; bj < 2; ++bj)
#pragma unroll
                    for (int n = 0; n < 2; ++n) { const f32x4 v = acc[ai][bj][m][n] * inv; u32x2 w; w.x = cvt_pk_bf16(v[0], v[1]); w.y = cvt_pk_bf16(v[2], v[3]);
                        *(u32x2*)(rowp + bj * 128 + n * 16) = w; } }
        (void)mrow;
    }
};
struct SchedPV {
    int G, c; unsigned pb, vt;
    __device__ __forceinline__ bool next(int i, Unit& un) const {
        if (i >= 2 || c >= 128) return false;
        const int L = c * 2 + i;
        const int n2 = L & 1, head = (L >> 1) & 3, rt = L >> 3;
        un.pm = rt; un.pn = head * 2 + n2; un.A = pb + (unsigned)(((size_t)rt * 256 * 1024 + head * 256) * 2); un.B = vt + (unsigned)(((size_t)(head * 512 + n2 * 256) * 1024 + (rt >> 3) * 256) * 2); un.nt = 4; un.kind = 0; return true;
    }
};
struct EpiPV {
    static constexpr bool PERM = true, KEEP = false;
    const bf16_t* U; bf16_t* YCX;
    __device__ __forceinline__ void operator()(f32x4 (&acc)[2][2][4][2], const Unit& u, int wr, int wc, int fr, int fq) const {
        asm volatile("" : "+v"(fr), "+v"(fq));
        const bf16_t* zb = U + (size_t)u.pm * 256 * NU + UXZ + u.pn * 256;
        const int row0 = wr * 64 + fr, col0 = wc * 32 + 8 * fq;
        const unsigned lane_off = (unsigned)((fr * 64 + fq * 16) ^ (((fr >> 3) & 1) << 5));
        unsigned char* ob = (unsigned char*)YCX + (size_t)(32 + 4 * u.pn + (wc >> 1)) * PKB + (wc & 1) * 1024 + lane_off;
#pragma unroll
        for (int ai = 0; ai < 2; ++ai)
#pragma unroll
            for (int m = 0; m < 4; ++m) { const size_t r = (size_t)(row0 + ai * 128 + m * 16);
#pragma unroll
                for (int bj = 0; bj < 2; ++bj) { const u32x4 z = *(const u32x4*)(zb + r * NU + col0 + bj * 128);
                    const f32x4 v0 = acc[ai][bj][m][0], v1 = acc[ai][bj][m][1];
                    u32x4 w; w.x = cvt_pk_bf16(v0[0] * bf_lo(z.x), v0[1] * bf_hi(z.x)); w.y = cvt_pk_bf16(v0[2] * bf_lo(z.y), v0[3] * bf_hi(z.y));
                    w.z = cvt_pk_bf16(v1[0] * bf_lo(z.z), v1[1] * bf_hi(z.z)); w.w = cvt_pk_bf16(v1[2] * bf_lo(z.w), v1[3] * bf_hi(z.w));
                    *(u32x4*)(ob + ((size_t)(2 * u.pm + ai) * 64 + 2 * bj) * PKB + (size_t)((4 * wr + m) * 2) * 1024) = w; }
                asm volatile("" ::: "memory"); }
    }
};
struct SchedMerge {
    int G, c; unsigned ym, ycx, wpmt, wpcxt;
    __device__ __forceinline__ bool next(int i, Unit& u) const {
        const int r = i / 3, br = i - 3 * r;
        if (!pg8::tile_map((long)r * G + c, 32, 16, u.pm, u.pn)) return false;
        u.kind = br;
        if (br == 0) { u.A = ym + (unsigned)u.pm * (unsigned)(128 * PKB); u.B = wpmt + (unsigned)u.pn * (unsigned)(128 * PKB); u.nt = 64; }
        else { u.A = ycx + (unsigned)u.pm * (unsigned)(128 * PKB) + (br == 2 ? (unsigned)(32 * PKB) : 0u); u.B = wpcxt + (unsigned)u.pn * (unsigned)(128 * PKB) + (br == 2 ? (unsigned)(32 * PKB) : 0u); u.nt = 32; }
        return true;
    }
};
struct EpiMerge {
    static constexpr bool PERM = true, KEEP = true;
    const bf16_t* GBk; unsigned char* MERGED;
    __device__ __forceinline__ void operator()(f32x4 (&acc)[2][2][4][2], const Unit& u, int wr, int wc, int fr, int fq) const {
        asm volatile("" : "+v"(fr), "+v"(fq));
        const int br = u.kind;
        const bf16_t* gb = GBk + ((size_t)(br * 16 + u.pn) * T + (size_t)u.pm * 256) * 256;
        const int row0 = wr * 64 + fr, col0 = wc * 64 + 8 * fq;
        unsigned char* mb = MERGED + (size_t)(4 * u.pn + wc) * PKB + (unsigned)((fr * 64 + fq * 16) ^ (((fr >> 3) & 1) << 5));
        const float tiny = 1e-30f;
#pragma unroll
        for (int ai = 0; ai < 2; ++ai)
#pragma unroll
            for (int m = 0; m < 4; ++m) { const size_t r = (size_t)(row0 + ai * 128 + m * 16);
#pragma unroll
                for (int bj = 0; bj < 2; ++bj) { const int cc = col0 + bj * 32;
                    const u32x4 g = *(const u32x4*)(gb + r * 256 + cc);
                    float f[8] = {bf_lo(g.x), bf_hi(g.x), bf_lo(g.y), bf_hi(g.y), bf_lo(g.z), bf_hi(g.z), bf_lo(g.w), bf_hi(g.w)};
                    if (br != 0) {
#pragma unroll
                        for (int j = 0; j < 8; ++j) f[j] = fmaxf(f[j], tiny); }
                    if (br != 2) { const u32x4 g2 = *(const u32x4*)(gb + (size_t)16 * T * 256 + r * 256 + cc);
                        const float d[8] = {bf_lo(g2.x), bf_hi(g2.x), bf_lo(g2.y), bf_hi(g2.y), bf_lo(g2.z), bf_hi(g2.z), bf_lo(g2.w), bf_hi(g2.w)};
#pragma unroll
                        for (int j = 0; j < 8; ++j) f[j] = f[j] * __builtin_amdgcn_rcpf(fmaxf(d[j], tiny)); }
                    f32x4 v0 = acc[ai][bj][m][0], v1 = acc[ai][bj][m][1];
                    v0[0] *= f[0]; v0[1] *= f[1]; v0[2] *= f[2]; v0[3] *= f[3]; v1[0] *= f[4]; v1[1] *= f[5]; v1[2] *= f[6]; v1[3] *= f[7];
                    if (br != 2) { acc[ai][bj][m][0] = v0; acc[ai][bj][m][1] = v1; }
                    else { u32x4 w; w.x = cvt_pk_bf16(v0[0], v0[1]); w.y = cvt_pk_bf16(v0[2], v0[3]); w.z = cvt_pk_bf16(v1[0], v1[1]); w.w = cvt_pk_bf16(v1[2], v1[3]);
                        *(u32x4*)(mb + ((size_t)(2 * u.pm + ai) * 64) * PKB + (size_t)((4 * wr + m) * 2 + bj) * 1024) = w; } }
                asm volatile("" ::: "memory"); }
    }
};
struct SchedOut {
    int G, c; unsigned merged, wot;
    __device__ __forceinline__ bool next(int i, Unit& u) const {
        if (!pg8::tile_map((long)i * G + c, 32, 16, u.pm, u.pn)) return false;
        u.A = merged + (unsigned)u.pm * (unsigned)(128 * PKB); u.B = wot + (unsigned)u.pn * (unsigned)(128 * PKB); u.nt = 64; u.kind = 0; return true;
    }
};
struct EpiOut {
    static constexpr bool PERM = true, KEEP = false;
    const float* x; float* out;
    __device__ __forceinline__ void operator()(f32x4 (&acc)[2][2][4][2], const Unit& u, int wr, int wc, int fr, int fq) const {
        asm volatile("" : "+v"(fr), "+v"(fq));
        const size_t ob = (size_t)u.pm * 256 * 4096 + u.pn * 256;
        const int row0 = wr * 64 + fr, col0 = wc * 64 + 8 * fq;
#pragma unroll
        for (int ai = 0; ai < 2; ++ai)
#pragma unroll
            for (int m = 0; m < 4; ++m) { const size_t r = (size_t)(row0 + ai * 128 + m * 16);
#pragma unroll
                for (int bj = 0; bj < 2; ++bj)
#pragma unroll
                    for (int n = 0; n < 2; ++n) { const size_t o = ob + r * 4096 + col0 + bj * 32 + n * 4;
                        const f32x4 xv = *(const f32x4*)(x + o);
                        *(f32x4*)(out + o) = xv * DN_ALPHA + acc[ai][bj][m][n]; }
                asm volatile("" ::: "memory"); }
    }
};

__device__ __forceinline__ void conv_phase(const Params& p, int gtid, int NGT, int idx_lo, int idx_hi) {
    const bf16_t* U = (const bf16_t*)(p.ws + WS_U); bf16_t* YCX = (bf16_t*)(p.ws + WS_YCX);
    for (int idx = idx_lo + gtid; idx < idx_hi; idx += NGT) {
        const int t0 = (idx >> 8) * 16, c = (idx & 255) * 8;
        const bf16_t* row0 = U + (size_t)t0 * NU;
        const f32x4 wa0 = *(const f32x4*)(p.conv_w + c), wa1 = *(const f32x4*)(p.conv_w + c + 4);
        const f32x4 wb0 = *(const f32x4*)(p.conv_w + 2048 + c), wb1 = *(const f32x4*)(p.conv_w + 2048 + c + 4);
        const f32x4 wc0 = *(const f32x4*)(p.conv_w + 4096 + c), wc1 = *(const f32x4*)(p.conv_w + 4096 + c + 4);
        const float w0[8] = {wa0[0], wa0[1], wa0[2], wa0[3], wa1[0], wa1[1], wa1[2], wa1[3]};
        const float w1[8] = {wb0[0], wb0[1], wb0[2], wb0[3], wb1[0], wb1[1], wb1[2], wb1[3]};
        const float w2[8] = {wc0[0], wc0[1], wc0[2], wc0[3], wc1[0], wc1[1], wc1[2], wc1[3]};
        float pm2[8], pm1[8];
        if ((t0 & (SEQ - 1)) != 0) {
            const u32x4 a2 = *(const u32x4*)(row0 - (size_t)2 * NU + UCC + c), b2 = *(const u32x4*)(row0 - (size_t)2 * NU + UCX + c);
            const u32x4 a1 = *(const u32x4*)(row0 - (size_t)1 * NU + UCC + c), b1 = *(const u32x4*)(row0 - (size_t)1 * NU + UCX + c);
            const unsigned a2w[4] = {a2.x, a2.y, a2.z, a2.w}, b2w[4] = {b2.x, b2.y, b2.z, b2.w}, a1w[4] = {a1.x, a1.y, a1.z, a1.w}, b1w[4] = {b1.x, b1.y, b1.z, b1.w};
#pragma unroll
            for (int j = 0; j < 4; ++j) { pm2[2 * j] = bf_lo(a2w[j]) * bf_lo(b2w[j]); pm2[2 * j + 1] = bf_hi(a2w[j]) * bf_hi(b2w[j]); pm1[2 * j] = bf_lo(a1w[j]) * bf_lo(b1w[j]); pm1[2 * j + 1] = bf_hi(a1w[j]) * bf_hi(b1w[j]); }
        } else {
#pragma unroll
            for (int j = 0; j < 8; ++j) { pm2[j] = 0.f; pm1[j] = 0.f; }
        }
#pragma unroll 1
        for (int tq = 0; tq < 16; tq += 4) {
            u32x4 cb[4], cc[4], cx[4], cz[4];
#pragma unroll
            for (int q = 0; q < 4; ++q) { const bf16_t* row = row0 + (size_t)(tq + q) * NU;
                cb[q] = *(const u32x4*)(row + UCB + c); cc[q] = *(const u32x4*)(row + UCC + c); cx[q] = *(const u32x4*)(row + UCX + c); cz[q] = *(const u32x4*)(row + UCZ + c); }
#pragma unroll
            for (int q = 0; q < 4; ++q) {
                const unsigned cbw[4] = {cb[q].x, cb[q].y, cb[q].z, cb[q].w}, ccw[4] = {cc[q].x, cc[q].y, cc[q].z, cc[q].w}, cxw[4] = {cx[q].x, cx[q].y, cx[q].z, cx[q].w}, czw[4] = {cz[q].x, cz[q].y, cz[q].z, cz[q].w};
                float pc[8], o[8];
#pragma unroll
                for (int j = 0; j < 4; ++j) { pc[2 * j] = bf_lo(ccw[j]) * bf_lo(cxw[j]); pc[2 * j + 1] = bf_hi(ccw[j]) * bf_hi(cxw[j]); }
#pragma unroll
                for (int j = 0; j < 8; ++j) { o[j] = (w0[j] * pm2[j] + w1[j] * pm1[j]) + w2[j] * pc[j]; pm2[j] = pm1[j]; pm1[j] = pc[j]; }
                u32x4 ov; unsigned ow[4];
#pragma unroll
                for (int j = 0; j < 4; ++j) { const float z0 = bf_lo(czw[j]), z1 = bf_hi(czw[j]);
                    ow[j] = cvt_pk_bf16(bf_lo(cbw[j]) * o[2 * j] * (z0 * sigmoidf_(z0)), bf_hi(cbw[j]) * o[2 * j + 1] * (z1 * sigmoidf_(z1))); }
                ov.x = ow[0]; ov.y = ow[1]; ov.z = ow[2]; ov.w = ow[3];
                *(u32x4*)((unsigned char*)YCX + pk_off(t0 + tq + q, c, 64)) = ov;
            }
        }
    }
}
__device__ __forceinline__ void softmax_unit(const Params& p, int rt, int head, int wave, int lane) {
    const float* SC = (const float*)(p.ws + WS_SC); bf16_t* PB = (bf16_t*)(p.ws + WS_PB);
    for (int r = wave; r < 256; r += NWAVES) {
        const int it = (rt * 256 + r) * 4 + head;
        const f32x4 s = *(const f32x4*)(SC + (size_t)it * 256 + 4 * lane);
        const float mx = wave_max(fmaxf(fmaxf(s[0], s[1]), fmaxf(s[2], s[3])));
        const float e0 = __expf(s[0] - mx), e1 = __expf(s[1] - mx), e2 = __expf(s[2] - mx), e3 = __expf(s[3] - mx);
        const float inv = 1.0f / wave_sum((e0 + e1) + (e2 + e3));
        u32x2 o; o.x = cvt_pk_bf16(e0 * inv, e1 * inv); o.y = cvt_pk_bf16(e2 * inv, e3 * inv);
        *(u32x2*)(PB + (size_t)it * 256 + 4 * lane) = o;
    }
}
__device__ __forceinline__ void ym_phase(const Params& p, int gw, int NGW, int lane) {
    const bf16_t* U = (const bf16_t*)(p.ws + WS_U); const bf16_t* HR = (const bf16_t*)(p.ws + WS_HRAW); bf16_t* YM = (bf16_t*)(p.ws + WS_YM);
    for (int it0 = gw * 2; it0 < T * 8; it0 += NGW * 2) {
        u32x4 hv[2], mo[2], mz[2];
#pragma unroll
        for (int q = 0; q < 2; ++q) { const int it = it0 + q, t = it >> 3, c = (it & 7) * 512 + 8 * lane;
            hv[q] = *(const u32x4*)(HR + (size_t)t * 4096 + c); mo[q] = *(const u32x4*)(U + (size_t)t * NU + UO + c); mz[q] = *(const u32x4*)(U + (size_t)t * NU + UZ + c); }
#pragma unroll
        for (int q = 0; q < 2; ++q) { const int it = it0 + q, t = it >> 3, c = (it & 7) * 512 + 8 * lane;
            const f32x4 w0 = *(const f32x4*)(p.mh_norm_w + c), w1 = *(const f32x4*)(p.mh_norm_w + c + 4);
            float v[8] = {bf_lo(hv[q].x), bf_hi(hv[q].x), bf_lo(hv[q].y), bf_hi(hv[q].y), bf_lo(hv[q].z), bf_hi(hv[q].z), bf_lo(hv[q].w), bf_hi(hv[q].w)};
            float s = 0.f;
#pragma unroll
            for (int j = 0; j < 8; ++j) s += v[j];
            const float mean = wave_sum(s) * (1.0f / 512.0f);
            float qq = 0.f;
#pragma unroll
            for (int j = 0; j < 8; ++j) { v[j] -= mean; qq += v[j] * v[j]; }
            const float rstd = 1.0f / sqrtf(wave_sum(qq) * (1.0f / 512.0f) + LN_EPS);
            const float ov[8] = {bf_lo(mo[q].x), bf_hi(mo[q].x), bf_lo(mo[q].y), bf_hi(mo[q].y), bf_lo(mo[q].z), bf_hi(mo[q].z), bf_lo(mo[q].w), bf_hi(mo[q].w)};
            const float zv[8] = {bf_lo(mz[q].x), bf_hi(mz[q].x), bf_lo(mz[q].y), bf_hi(mz[q].y), bf_lo(mz[q].z), bf_hi(mz[q].z), bf_lo(mz[q].w), bf_hi(mz[q].w)};
            const float wv[8] = {w0[0], w0[1], w0[2], w0[3], w1[0], w1[1], w1[2], w1[3]};
            u32x4 o; unsigned ow[4];
#pragma unroll
            for (int j = 0; j < 4; ++j) { const float g0 = sigmoidf_(ov[2 * j]) * (zv[2 * j] * sigmoidf_(zv[2 * j])), g1 = sigmoidf_(ov[2 * j + 1]) * (zv[2 * j + 1] * sigmoidf_(zv[2 * j + 1]));
                ow[j] = cvt_pk_bf16(v[2 * j] * rstd * wv[2 * j] * g0, v[2 * j + 1] * rstd * wv[2 * j + 1] * g1); }
            o.x = ow[0]; o.y = ow[1]; o.z = ow[2]; o.w = ow[3];
            *(u32x4*)((unsigned char*)YM + pk_off(t, c, 64)) = o; }
    }
}
__device__ __forceinline__ void ln_phase(const Params& p, int gw, int NGW, int lane) {
    for (int m = gw; m < T; m += NGW) {
        f32x4* r = (f32x4*)(p.out + (size_t)m * D) + lane;
        f32x4 v[16]; float s = 0.f;
#pragma unroll
        for (int j = 0; j < 16; ++j) { v[j] = r[64 * j]; s += (v[j][0] + v[j][1]) + (v[j][2] + v[j][3]); }
        const float mean = wave_sum(s) * (1.0f / D); float q = 0.f;
#pragma unroll
        for (int j = 0; j < 16; ++j) { v[j] = v[j] - mean; q += (v[j][0] * v[j][0] + v[j][1] * v[j][1]) + (v[j][2] * v[j][2] + v[j][3] * v[j][3]); }
        const float rstd = 1.0f / sqrtf(wave_sum(q) * (1.0f / D) + LN_EPS);
#pragma unroll
        for (int j = 0; j < 16; ++j) { const f32x4 w = *((const f32x4*)p.ln_w + lane + 64 * j), b = *((const f32x4*)p.ln_b + lane + 64 * j); r[64 * j] = v[j] * rstd * w + b; }
    }
}

__device__ __forceinline__ void mlstm_naive(const Params& p, LAS unsigned char* lds, int unit, int wave, int lane) {
    const int s = unit & 7, h = (unit >> 3) & 7, b = unit >> 6;
    LAS float* part = (LAS float*)lds;
    LAS float* pden = part + 2 * 8 * 64;
    const bf16_t* Ub = (const bf16_t*)(p.ws + WS_U) + (size_t)(b * SEQ) * NU;
    bf16_t* HR = (bf16_t*)(p.ws + WS_HRAW) + (size_t)(b * SEQ) * 4096 + h * 512 + s * 64 + lane;
    float C[32], n[32];
#pragma unroll
    for (int d = 0; d < 32; ++d) { C[d] = 0.f; n[d] = 0.f; }
    float m = 0.f;
    for (int t = 0; t < SEQ; ++t) {
        const bf16_t* row = Ub + (size_t)t * NU;
        u32x4 kk[4], qq[4];
#pragma unroll
        for (int j = 0; j < 4; ++j) { kk[j] = *(const u32x4*)(row + UK + h * 256 + wave * 32 + 8 * j); qq[j] = *(const u32x4*)(row + UQ + h * 256 + wave * 32 + 8 * j); }
        const float vv = bf2f(row[UV + h * 512 + s * 64 + lane]);
        const float ig = bf2f(row[UI + h]), fp = bf2f(row[UF + h]);
        const float lf = fminf(fp, 0.f) - log1pf(__expf(-fabsf(fp)));
        const float mn = fmaxf(lf + m, ig), fd = __expf(lf + m - mn), iw = __expf(ig - mn);
        m = mn;
        float num = 0.f, den = 0.f;
#pragma unroll
        for (int j = 0; j < 4; ++j) {
            const unsigned kw[4] = {kk[j].x, kk[j].y, kk[j].z, kk[j].w}, qw[4] = {qq[j].x, qq[j].y, qq[j].z, qq[j].w};
#pragma unroll
            for (int e = 0; e < 4; ++e) {
                const int d = 8 * j + 2 * e;
                const float k0 = iw * bf_lo(kw[e]), k1 = iw * bf_hi(kw[e]), q0 = bf_lo(qw[e]), q1 = bf_hi(qw[e]);
                C[d] = fd * C[d] + k0 * vv; n[d] = fd * n[d] + k0; num += q0 * C[d]; den += q0 * n[d];
                C[d + 1] = fd * C[d + 1] + k1 * vv; n[d + 1] = fd * n[d + 1] + k1; num += q1 * C[d + 1]; den += q1 * n[d + 1];
            }
        }
        const int buf = t & 1;
        part[(buf * 8 + wave) * 64 + lane] = num; if (lane == 0) pden[buf * 8 + wave] = den;
        __syncthreads();
        if (wave == (t & 7)) {
            float nt_ = 0.f, dt_ = 0.f;
#pragma unroll
            for (int w = 0; w < 8; ++w) { nt_ += part[(buf * 8 + w) * 64 + lane]; dt_ += pden[buf * 8 + w]; }
            const float hv = nt_ / fmaxf(fabsf(dt_), __expf(-m));
            HR[(size_t)t * 4096] = (bf16_t)(cvt_pk_bf16(hv, 0.f) & 0xffffu);
        }
    }
    __syncthreads();
}

constexpr int ML_RS = 544, ML_VS = 160;
constexpr int ML_Q = 0, ML_K = 64 * ML_RS, ML_V = 2 * 64 * ML_RS, ML_VSC = ML_V + 64 * ML_VS, ML_CT = ML_VSC + 64 * ML_VS, ML_END = ML_CT + 80 * ML_RS;
typedef short s16x4 __attribute__((ext_vector_type(4)));
__device__ __forceinline__ bf16x8 tr_pair(const LAS unsigned char* a0, const LAS unsigned char* a1) {
    const s16x4 lo = __builtin_amdgcn_ds_read_tr16_b64_v4i16((LAS s16x4*)a0), hi = __builtin_amdgcn_ds_read_tr16_b64_v4i16((LAS s16x4*)a1);
    return (bf16x8){lo[0], lo[1], lo[2], lo[3], hi[0], hi[1], hi[2], hi[3]};
}
constexpr int ML_TAB_BS = ML_END, ML_TAB_CJ = ML_END + 8192, ML_TAB_CM = ML_END + 16384, ML_TAB_MST = ML_END + 24576;
static_assert(ML_END % 16 == 0 && ML_TAB_MST + 256 <= LDSCTL_OFF, "mLSTM LDS map");
__device__ __forceinline__ void mlstm_unit(const Params& p, LAS unsigned char* lds, int unit, int wave, int lane, int tid) {
    const int s = unit & 7, h = (unit >> 3) & 7, b = unit >> 6;
    const int g = lane >> 4, li = lane & 15, q4 = li >> 2, p4 = lane & 3;
    const int tt = wave >> 1, vh = wave & 1;
    const bf16_t* U = (const bf16_t*)(p.ws + WS_U) + (size_t)(b * SEQ) * NU;
    bf16_t* HR = (bf16_t*)(p.ws + WS_HRAW) + (size_t)(b * SEQ) * 4096 + h * 512 + s * 64;
    const int srow = tid >> 5, sch = tid & 31, vrow = tid >> 3, vch = tid & 7;
    LAS float* tBS = (LAS float*)(lds + ML_TAB_BS); LAS float* tCJ = (LAS float*)(lds + ML_TAB_CJ); LAS float* tCM = (LAS float*)(lds + ML_TAB_CM); LAS float* tMST = (LAS float*)(lds + ML_TAB_MST);
    if (tid < 64) {
        *(LAS u32x4*)(lds + ML_V + tid * ML_VS + 128) = (u32x4){0x3F80u, 0u, 0u, 0u}; *(LAS u32x4*)(lds + ML_V + tid * ML_VS + 144) = (u32x4){0u, 0u, 0u, 0u};
        *(LAS u32x4*)(lds + ML_VSC + tid * ML_VS + 128) = (u32x4){0u, 0u, 0u, 0u}; *(LAS u32x4*)(lds + ML_VSC + tid * ML_VS + 144) = (u32x4){0u, 0u, 0u, 0u};
    }
    for (int cc = wave; cc < SEQ / 64; cc += NWAVES) {
        const size_t tok = (size_t)(cc * 64 + lane);
        const float ig = bf2f(U[tok * NU + UI + h]), fp = bf2f(U[tok * NU + UF + h]);
        const float lf = fminf(fp, 0.f) - log1pf(__expf(-fabsf(fp)));
        float bs = lf;
#pragma unroll
        for (int o = 1; o < 64; o <<= 1) { const float t_ = __shfl_up(bs, o); if (lane >= o) bs += t_; }
        const float Cj = ig - bs; float cm = Cj;
#pragma unroll
        for (int o = 1; o < 64; o <<= 1) { const float t_ = __shfl_up(cm, o); if (lane >= o) cm = fmaxf(cm, t_); }
        tBS[cc * 64 + lane] = bs; tCJ[cc * 64 + lane] = Cj; tCM[cc * 64 + lane] = cm;
    }
    __syncthreads();
    if (tid == 0) { float m = 0.f; for (int c = 0; c < SEQ / 64; ++c) { tMST[c] = m; m = tBS[c * 64 + 63] + fmaxf(tCM[c * 64 + 63], m); } }
    f32x4 cacc[2][5];
#pragma unroll
    for (int a = 0; a < 2; ++a)
#pragma unroll
        for (int v = 0; v < 5; ++v) cacc[a][v] = (f32x4){0.f, 0.f, 0.f, 0.f};
    u32x4 rq[4], rk[4], rv;
#define ML_PREFETCH(c) do { const bf16_t* base_ = U + (size_t)((c) * 64) * NU; \
        _Pragma("unroll") for (int i_ = 0; i_ < 4; ++i_) { rq[i_] = *(const u32x4*)(base_ + (size_t)(srow + 16 * i_) * NU + UQ + h * 256 + sch * 8); \
                                                          rk[i_] = *(const u32x4*)(base_ + (size_t)(srow + 16 * i_) * NU + UK + h * 256 + sch * 8); } \
        rv = *(const u32x4*)(base_ + (size_t)vrow * NU + UV + h * 512 + s * 64 + vch * 8); } while (0)
#define ML_SB __builtin_amdgcn_sched_barrier(0)
#define ML_LDK(dst, jt) do { _Pragma("unroll") for (int ks_ = 0; ks_ < 8; ++ks_) dst[ks_] = *(const LAS bf16x8*)(lds + ML_K + (16 * (jt) + li) * ML_RS + g * 16 + ks_ * 64); } while (0)
#define ML_LDC(dst, vt) do { _Pragma("unroll") for (int ks_ = 0; ks_ < 8; ++ks_) dst[ks_] = *(const LAS bf16x8*)(lds + ML_CT + (16 * (vt) + li) * ML_RS + g * 16 + ks_ * 64); } while (0)
#define ML_MMA8(acc, A, B) do { _Pragma("unroll") for (int ks_ = 0; ks_ < 8; ++ks_) acc = __builtin_amdgcn_mfma_f32_16x16x32_bf16(A[ks_], B[ks_], acc, 0, 0, 0); } while (0)
    ML_PREFETCH(0);
    __syncthreads();
    const int tcol = 16 * tt + li;
    for (int c = 0; c < SEQ / 64; ++c) {
        const float mst = tMST[c], M63 = fmaxf(tCM[c * 64 + 63], mst), decay = __expf(mst - M63);
        const float Mt_t = fmaxf(tCM[c * 64 + tcol], mst), inter_t = __expf(mst - Mt_t), emt_t = __expf(-(tBS[c * 64 + tcol] + Mt_t));
#pragma unroll
        for (int a = 0; a < 2; ++a)
#pragma unroll
            for (int v = 0; v < 5; ++v) { u32x2 w; w.x = cvt_pk_bf16(cacc[a][v][0], cacc[a][v][1]); w.y = cvt_pk_bf16(cacc[a][v][2], cacc[a][v][3]);
                *(LAS u32x2*)(lds + ML_CT + (16 * v + li) * ML_RS + (16 * (2 * wave + a) + 4 * g) * 2) = w; }
#pragma unroll
        for (int i = 0; i < 4; ++i) { *(LAS u32x4*)(lds + ML_Q + (srow + 16 * i) * ML_RS + sch * 16) = rq[i]; *(LAS u32x4*)(lds + ML_K + (srow + 16 * i) * ML_RS + sch * 16) = rk[i]; }
        *(LAS u32x4*)(lds + ML_V + vrow * ML_VS + vch * 16) = rv;
        { const float sc = __expf(tCJ[c * 64 + vrow] - M63); u32x4 o;
          o.x = cvt_pk_bf16(bf_lo(rv.x) * sc, bf_hi(rv.x) * sc); o.y = cvt_pk_bf16(bf_lo(rv.y) * sc, bf_hi(rv.y) * sc);
          o.z = cvt_pk_bf16(bf_lo(rv.z) * sc, bf_hi(rv.z) * sc); o.w = cvt_pk_bf16(bf_lo(rv.w) * sc, bf_hi(rv.w) * sc);
          *(LAS u32x4*)(lds + ML_VSC + vrow * ML_VS + vch * 16) = o; }
        if (tid < 64) *(LAS bf16_t*)(lds + ML_VSC + tid * ML_VS + 128) = (bf16_t)(cvt_pk_bf16(__expf(tCJ[c * 64 + tid] - M63), 0.f) & 0xffffu);
        __syncthreads();
        { const int cn = (c + 1 < SEQ / 64) ? c + 1 : c; ML_PREFETCH(cn); }
        bf16x8 Bq[8], A0[8], A1[8]; f32x4 sacc[4], pacc[3], cj4[4];
#pragma unroll
        for (int j = 0; j < 4; ++j) sacc[j] = (f32x4){0.f, 0.f, 0.f, 0.f};
#pragma unroll
        for (int a = 0; a < 3; ++a) pacc[a] = (f32x4){0.f, 0.f, 0.f, 0.f};
#pragma unroll
        for (int ks = 0; ks < 8; ++ks) Bq[ks] = *(const LAS bf16x8*)(lds + ML_Q + tcol * ML_RS + g * 16 + ks * 64);
        ML_LDK(A0, 0); ML_SB;
        ML_LDK(A1, 1); ML_MMA8(sacc[0], A0, Bq); ML_SB;
        ML_LDK(A0, 2); ML_MMA8(sacc[1], A1, Bq); ML_SB;
        ML_LDK(A1, 3); ML_MMA8(sacc[2], A0, Bq); ML_SB;
        ML_LDC(A0, 2 * vh);
#pragma unroll
        for (int jt = 0; jt < 4; ++jt) cj4[jt] = *(const LAS f32x4*)(tCJ + c * 64 + 16 * jt + 4 * g);
        ML_MMA8(sacc[3], A1, Bq); ML_SB;
        ML_LDC(A1, 2 * vh + 1); ML_MMA8(pacc[0], A0, Bq); ML_SB;
        ML_LDC(A0, 4); ML_MMA8(pacc[1], A1, Bq); ML_SB;
        bf16x8 Av[2][3];
#pragma unroll
        for (int ks2 = 0; ks2 < 2; ++ks2)
#pragma unroll
            for (int a = 0; a < 3; ++a) { const int vt = (a == 2) ? 4 : 2 * vh + a;
                const LAS unsigned char* ad = lds + ML_V + (32 * ks2 + 4 * g + q4) * ML_VS + (16 * vt + 4 * p4) * 2;
                Av[ks2][a] = tr_pair(ad, ad + 16 * ML_VS); }
        ML_MMA8(pacc[2], A0, Bq);
        bf16x8 sp[2];
#pragma unroll
        for (int ks2 = 0; ks2 < 2; ++ks2) {
            float sv[8];
#pragma unroll
            for (int e = 0; e < 8; ++e) { const int jt = 2 * ks2 + (e >> 2), j = 16 * jt + 4 * g + (e & 3);
                sv[e] = (j <= tcol) ? sacc[jt][e & 3] * __expf(cj4[jt][e & 3] - Mt_t) : 0.f; }
            const unsigned w0 = cvt_pk_bf16(sv[0], sv[1]), w1 = cvt_pk_bf16(sv[2], sv[3]), w2 = cvt_pk_bf16(sv[4], sv[5]), w3 = cvt_pk_bf16(sv[6], sv[7]);
            sp[ks2] = (bf16x8){(short)(w0 & 0xffff), (short)(w0 >> 16), (short)(w1 & 0xffff), (short)(w1 >> 16), (short)(w2 & 0xffff), (short)(w2 >> 16), (short)(w3 & 0xffff), (short)(w3 >> 16)};
        }
        ML_SB;
        bf16x8 Ck[2], Cv[5];
#pragma unroll
        for (int a = 0; a < 2; ++a) { const LAS unsigned char* ad = lds + ML_K + (8 * g + q4) * ML_RS + (16 * (2 * wave + a) + 4 * p4) * 2; Ck[a] = tr_pair(ad, ad + 4 * ML_RS); }
#pragma unroll
        for (int v = 0; v < 5; ++v) { const LAS unsigned char* ad = lds + ML_VSC + (8 * g + q4) * ML_VS + (16 * v + 4 * p4) * 2; Cv[v] = tr_pair(ad, ad + 4 * ML_VS); }
#pragma unroll
        for (int a = 0; a < 3; ++a) pacc[a] = pacc[a] * inter_t;
#pragma unroll
        for (int ks2 = 0; ks2 < 2; ++ks2)
#pragma unroll
            for (int a = 0; a < 3; ++a) pacc[a] = __builtin_amdgcn_mfma_f32_16x16x32_bf16(Av[ks2][a], sp[ks2], pacc[a], 0, 0, 0);
#pragma unroll
        for (int a = 0; a < 2; ++a)
#pragma unroll
            for (int v = 0; v < 5; ++v) cacc[a][v] = cacc[a][v] * decay;
        ML_SB;
        bf16x8 Dk[2], Dv[5];
#pragma unroll
        for (int a = 0; a < 2; ++a) { const LAS unsigned char* ad = lds + ML_K + (32 + 8 * g + q4) * ML_RS + (16 * (2 * wave + a) + 4 * p4) * 2; Dk[a] = tr_pair(ad, ad + 4 * ML_RS); }
#pragma unroll
        for (int v = 0; v < 5; ++v) { const LAS unsigned char* ad = lds + ML_VSC + (32 + 8 * g + q4) * ML_VS + (16 * v + 4 * p4) * 2; Dv[v] = tr_pair(ad, ad + 4 * ML_VS); }
#pragma unroll
        for (int v = 0; v < 5; ++v)
#pragma unroll
            for (int a = 0; a < 2; ++a) cacc[a][v] = __builtin_amdgcn_mfma_f32_16x16x32_bf16(Ck[a], Cv[v], cacc[a][v], 0, 0, 0);
        { const float den = __shfl(pacc[2][0], li);
          const float inv = 1.0f / fmaxf(fabsf(den), emt_t);
          bf16_t* hp = HR + (size_t)(c * 64 + tcol) * 4096 + 4 * g;
#pragma unroll
          for (int a = 0; a < 2; ++a) { u32x2 w; w.x = cvt_pk_bf16(pacc[a][0] * inv, pacc[a][1] * inv); w.y = cvt_pk_bf16(pacc[a][2] * inv, pacc[a][3] * inv);
              *(u32x2*)(hp + 16 * (2 * vh + a)) = w; } }
        ML_SB;
#pragma unroll
        for (int v = 0; v < 5; ++v)
#pragma unroll
            for (int a = 0; a < 2; ++a) cacc[a][v] = __builtin_amdgcn_mfma_f32_16x16x32_bf16(Dk[a], Dv[v], cacc[a][v], 0, 0, 0);
        __syncthreads();
    }
#undef ML_PREFETCH
#undef ML_SB
#undef ML_LDK
#undef ML_LDC
#undef ML_MMA8
}

__global__ void __launch_bounds__(NWAVES * 64, 2) mk_fwd(Params p) {
    extern __shared__ __attribute__((aligned(16))) unsigned char lds_raw[];
    LAS unsigned char* lds = (LAS unsigned char*)lds_raw;
    volatile LAS unsigned* MISC = (volatile LAS unsigned*)(lds + MISC_OFF);
    const int tid = threadIdx.x, lane = tid & 63, wave = __builtin_amdgcn_readfirstlane(tid >> 6);
    const int G = gridDim.x, bx = blockIdx.x;
    const int vcu = (G % 8 == 0) ? (bx % 8) * (G / 8) + bx / 8 : bx;
    const int gw = vcu * NWAVES + wave, NGW = G * NWAVES;
    unsigned char* ws = p.ws;
    unsigned* ctl = (unsigned*)(ws + WS_CTL);
    for (int u = tid; u < 1024 / 4; u += NWAVES * 64) ((LAS unsigned*)(lds + LDSCTL_OFF))[u] = 0u;
    __syncthreads();
    const bool one_launch = (p.ph_lo == 0 && p.ph_hi >= 8);
    XcdBarrier bar; bar.bar = ctl + CW_BAR; bar.x = 0; bar.st = nullptr;
    if (one_launch) bar = xcd_barrier_post(ctl + CW_BAR, MISC + 8);
    const int lo = p.ph_lo, hi = p.ph_hi;
#define IN(k) (lo <= (k) && (k) < hi)
#ifndef MK_DUP
#define MK_DUP -1
#endif
#define REP(k) for (int rep_ = 0; rep_ < ((MK_DUP) == (k) ? 2 : 1); ++rep_)
#define GRID_BAR() do { if (one_launch) xcd_barrier(bar); } while (0)

    if (IN(0)) {
        p0a_prologue(p, lds, gw, NGW, wave, lane);
        GRID_BAR();
        const int nbusy = G > NTAIL ? NTAIL : 0;
        const int wA = (G - nbusy) * NWAVES * 5, wB = nbusy * NWAVES * 2;
        const int NA = nbusy ? (int)(((long)P0B_ITEMS * wA) / (wA + wB)) : P0B_ITEMS;
        if (bx < nbusy || !nbusy) {
            for (int a = bx; a < NTAIL; a += (nbusy ? NTAIL : G)) {
                SchedTail S{a, (unsigned)WS_XB, (unsigned)WS_MEMB, (unsigned)WS_WINT, (unsigned)WS_WKVT};
                EpiP1 E{(bf16_t*)(ws + WS_U), (const float*)(ws + WS_BU), (bf16_t*)(ws + WS_KMEM), (bf16_t*)(ws + WS_VT), lds, (bf16_t*)(ws + WS_GB)};
                pg8::gemm_phase<EpiP1, SchedTail, true, true, true, true>(lds, ws, 64 * 16384, 64 * 16384, S, E);
                __syncthreads();
            }
        }
        if (!nbusy) p0b_convert(p, lds, gw, NGW, 0, P0B_ITEMS, wave, lane);
        else if (bx < nbusy) p0b_convert(p, lds, bx * NWAVES + wave, nbusy * NWAVES, NA, P0B_ITEMS, wave, lane);
        else p0b_convert(p, lds, (bx - nbusy) * NWAVES + wave, (G - nbusy) * NWAVES, 0, NA, wave, lane);
        GRID_BAR();
    }
    if (IN(1)) {
        SchedP1 S{G, bx, (unsigned)WS_XB, (unsigned)WS_WINT};
        EpiP1 E{(bf16_t*)(ws + WS_U), (const float*)(ws + WS_BU), (bf16_t*)(ws + WS_KMEM), (bf16_t*)(ws + WS_VT), lds, (bf16_t*)(ws + WS_GB)};
        REP(1) pg8::gemm_phase<EpiP1, SchedP1, true, true, true, true>(lds, ws, 64 * 16384, 64 * 16384, S, E);
        GRID_BAR();
    }
    if (IN(2)) {
        const int NATT = 128;
        const bool att = bx < NATT;
        for (int a = bx; a < NATT; a += G) {
            { SchedQK S{NATT, a, (unsigned)WS_U, (unsigned)WS_KMEM}; EpiSoftmax E{(bf16_t*)(ws + WS_PB), lds};
              pg8::gemm_phase<EpiSoftmax, SchedQK, true, true, false, false>(lds, ws, NU * 2, 4096, S, E); }
            VM_WAIT(); __syncthreads();
            { SchedPV S{NATT, a, (unsigned)WS_PB, (unsigned)WS_VT}; EpiPV E{(const bf16_t*)(ws + WS_U), (bf16_t*)(ws + WS_YCX)};
              pg8::gemm_phase<EpiPV, SchedPV, true, true, false, false>(lds, ws, 2048, 2048, S, E); }
        }
        {
            const int NIT = (T / 16) * 256, nidle = G > NATT ? G - NATT : 0;
            const int split = nidle ? NIT : 0;
            if (!att) conv_phase(p, (bx - NATT) * (NWAVES * 64) + tid, nidle * NWAVES * 64, 0, split);
            else { const int nb = G < NATT ? G : NATT; conv_phase(p, bx * (NWAVES * 64) + tid, nb * NWAVES * 64, split, NIT); }
        }
        __syncthreads();
        REP(9) for (int unit = vcu; unit < 256; unit += G) mlstm_unit(p, lds, unit, wave, lane, tid);
        GRID_BAR();
    }
    if (IN(3)) { REP(10) ym_phase(p, gw, NGW, lane); GRID_BAR(); }
    if (IN(5)) {
        SchedMerge S{G, bx, (unsigned)WS_YM, (unsigned)WS_YCX, (unsigned)WS_WPMT, (unsigned)WS_WPCXT};
        EpiMerge E{(const bf16_t*)(ws + WS_GB), ws + WS_MERGED};
        REP(5) pg8::gemm_phase<EpiMerge, SchedMerge, true, true, true, true>(lds, ws, 64 * 16384, 64 * 16384, S, E);
        GRID_BAR();
    }
    if (IN(6)) {
        SchedOut S{G, bx, (unsigned)WS_MERGED, (unsigned)WS_WOT}; EpiOut E{p.x, p.out};
        REP(6) pg8::gemm_phase<EpiOut, SchedOut, true, true, true, true>(lds, ws, 64 * 16384, 64 * 16384, S, E);
        GRID_BAR();
    }
    if (IN(7)) ln_phase(p, gw, NGW, lane);
#undef IN
#undef GRID_BAR
}

#ifndef MK_N_LAUNCHES
#define MK_N_LAUNCHES 1
#endif
extern "C" void kernel_launch(void* const* d_in, const int* in_sizes, int n_in, void* d_out, int out_size, void* d_ws, size_t ws_size, hipStream_t stream) {
    static int grid = 0;
    if (grid == 0) {
        if (n_in != 13 || out_size != T * D || ws_size < WS_END) { fprintf(stderr, "kernel_launch: unexpected shapes (n_in %d out %d ws %zu)\n", n_in, out_size, ws_size); grid = -1; return; }
        int dev = 0, cus = 0, per_cu = 0;
        if (hipGetDevice(&dev) != hipSuccess || hipDeviceGetAttribute(&cus, hipDeviceAttributeMultiprocessorCount, dev) != hipSuccess) { grid = -1; return; }
        if (hipFuncSetAttribute((const void*)mk_fwd, hipFuncAttributeMaxDynamicSharedMemorySize, LDS_BYTES) != hipSuccess) { fprintf(stderr, "kernel_launch: hipFuncSetAttribute failed\n"); grid = -1; return; }
        if (hipOccupancyMaxActiveBlocksPerMultiprocessor(&per_cu, (const void*)mk_fwd, NWAVES * 64, LDS_BYTES) != hipSuccess || per_cu < 1)
            fprintf(stderr, "kernel_launch: note: occupancy query reports %d\n", per_cu);
        (void)hipGetLastError();
        grid = cus;
    }
    if (grid < 0) return;
    (void)hipMemsetAsync((char*)d_ws + WS_CTL, 0, CTL_ZERO_BYTES, stream);
    Params p{};
    p.x = (const float*)d_in[0]; p.mem = (const float*)d_in[1]; p.w_in = (const float*)d_in[2]; p.b_in = (const float*)d_in[3];
    p.conv_w = (const float*)d_in[4]; p.mh_norm_w = (const float*)d_in[5]; p.w_mem_kv = (const float*)d_in[6]; p.w_proj_m = (const float*)d_in[7];
    p.w_proj_c = (const float*)d_in[8]; p.w_proj_x = (const float*)d_in[9]; p.w_out = (const float*)d_in[10]; p.ln_w = (const float*)d_in[11]; p.ln_b = (const float*)d_in[12];
    p.out = (float*)d_out; p.ws = (unsigned char*)d_ws;
    if (MK_N_LAUNCHES == 1) { p.ph_lo = 0; p.ph_hi = 8; hipLaunchKernelGGL(mk_fwd, dim3(grid), dim3(NWAVES * 64), LDS_BYTES, stream, p); }
    else for (int k = 0; k < 8; ++k) { p.ph_lo = k; p.ph_hi = k + 1; hipLaunchKernelGGL(mk_fwd, dim3(grid), dim3(NWAVES * 64), LDS_BYTES, stream, p); }
}
```
